# Optimizing an MI355X kernel written in HIP

```python
import jax, jax.numpy as jnp
from jax import lax
import numpy as np

D_MODEL = 1024
BATCH = 8
SEQ = 8192
DEPTH = 2
DEC_BATCH = 4
DEC_SEQ = 4096
PAST_LEN = 128

HEAD_DIM = 64
N_HEADS_A = 4
DILATED_PATTERNS = ((128, 1), (512, 4), (2048, 16))
N_HEADS_B = 8
N_KV_B = 2
GQA_GROUP = N_HEADS_B // N_KV_B
N_GROUPS_C = 4
D_A = N_HEADS_A * HEAD_DIM
D_B = N_HEADS_B * HEAD_DIM
D_KV_B = N_KV_B * HEAD_DIM
D_C = N_GROUPS_C * HEAD_DIM
D_MIX = D_A + D_B + D_C
N_MIX_HEADS = D_MIX // HEAD_DIM
D_IN = 3 * D_A + D_B + 2 * D_KV_B + D_C
IN_SPLITS = (D_A, 2 * D_A, 3 * D_A, 3 * D_A + D_B, 3 * D_A + D_B + D_KV_B, 3 * D_A + D_B + 2 * D_KV_B)
D_FF = 4 * D_MODEL
CONV_W = 3
ROPE_THETA_PARTIAL = 500000.0
ROT_DIM_PARTIAL = HEAD_DIM // 4
ROPE_THETA_AXIAL = 10000.0
GRID_W = 64
Q_BLOCK = 128
RMS_EPS = 1e-6
NEG_INF = -1e30

kernel_name = "hybrid_dilated_grid_fourier_encoder"


def _rms_norm(x, g):
    xf = x.astype(jnp.float32)
    y = xf * lax.rsqrt(jnp.mean(xf * xf, axis=-1, keepdims=True) + RMS_EPS)
    return (y * g.astype(jnp.float32)).astype(x.dtype)


def _rope_tables(pos, rot_dim, theta):
    half = rot_dim // 2
    inv = jnp.power(jnp.float32(theta), -jnp.arange(half, dtype=jnp.float32) / half)
    ang = pos.astype(jnp.float32)[:, None] * inv[None, :]
    return jnp.cos(ang), jnp.sin(ang)


def _apply_rope(x, cos, sin):
    half = x.shape[-1] // 2
    x1 = x[..., :half].astype(jnp.float32)
    x2 = x[..., half:].astype(jnp.float32)
    c = cos[:, None, :]
    s = sin[:, None, :]
    return jnp.concatenate([x1 * c - x2 * s, x2 * c + x1 * s], axis=-1).astype(x.dtype)


def _partial_rope(x, cos, sin):
    return jnp.concatenate([_apply_rope(x[..., :ROT_DIM_PARTIAL], cos, sin), x[..., ROT_DIM_PARTIAL:]], axis=-1)


def _axial_rope(x, cos_r, sin_r, cos_c, sin_c):
    half = HEAD_DIM // 2
    return jnp.concatenate([_apply_rope(x[..., :half], cos_r, sin_r),
                            _apply_rope(x[..., half:], cos_c, sin_c)], axis=-1)


def _position_tables(seq_len):
    rows = seq_len // GRID_W
    t = jnp.arange(seq_len, dtype=jnp.int32)
    row = jnp.broadcast_to(jnp.arange(rows, dtype=jnp.int32)[:, None], (rows, GRID_W)).reshape(-1)
    col = jnp.broadcast_to(jnp.arange(GRID_W, dtype=jnp.int32)[None, :], (rows, GRID_W)).reshape(-1)
    cos_t, sin_t = _rope_tables(t, ROT_DIM_PARTIAL, ROPE_THETA_PARTIAL)
    cos_r, sin_r = _rope_tables(row, HEAD_DIM // 2, ROPE_THETA_AXIAL)
    cos_c, sin_c = _rope_tables(col, HEAD_DIM // 2, ROPE_THETA_AXIAL)
    return (cos_t, sin_t, cos_r, sin_r, cos_c, sin_c)


def _dilated_attention(q, k, v):
    B, S, H, Dh = q.shape
    scale = Dh ** -0.5
    n_blocks = S // Q_BLOCK

    def block(i):
        q0 = i * Q_BLOCK
        qb = lax.dynamic_slice_in_dim(q, q0, Q_BLOCK, axis=1)
        qpos = q0 + jnp.arange(Q_BLOCK, dtype=jnp.int32)
        scores, idxs, n_keys = [], [], []
        for window, dil in DILATED_PATTERNS:
            side = window // (2 * dil)
            offs = jnp.arange(-side, side + 1, dtype=jnp.int32) * dil
            pos = qpos[:, None] + offs[None, :]
            valid = (pos >= 0) & (pos < S)
            idx = jnp.clip(pos, 0, S - 1)
            kg = jnp.take(k, idx.reshape(-1), axis=1).reshape(B, Q_BLOCK, offs.shape[0], H, Dh)
            s = jnp.einsum("bqhd,bqkhd->bhqk", qb, kg, preferred_element_type=jnp.float32) * scale
            scores.append(jnp.where(valid[None, None], s, NEG_INF))
            idxs.append(idx)
            n_keys.append(offs.shape[0])
        p = jax.nn.softmax(jnp.concatenate(scores, axis=-1), axis=-1)
        out = jnp.zeros((B, Q_BLOCK, H, Dh), jnp.float32)
        start = 0
        for idx, nk in zip(idxs, n_keys):
            vg = jnp.take(v, idx.reshape(-1), axis=1).reshape(B, Q_BLOCK, nk, H, Dh)
            out = out + jnp.einsum("bhqk,bqkhd->bqhd", p[..., start:start + nk],
                                   vg.astype(jnp.float32))
            start += nk
        return out.astype(v.dtype)

    o = lax.map(block, jnp.arange(n_blocks, dtype=jnp.int32))
    return o.transpose(1, 0, 2, 3, 4).reshape(B, S, H, Dh)


def _grid_attention(q, k, v):
    B, S, HQ, Dh = q.shape
    scale = Dh ** -0.5
    qg = q.reshape(B, S, N_KV_B, GQA_GROUP, Dh)

    def block(i):
        qb = lax.dynamic_slice_in_dim(qg, i * Q_BLOCK, Q_BLOCK, axis=1)
        s = jnp.einsum("bqgrd,bkgd->bgrqk", qb, k, preferred_element_type=jnp.float32) * scale
        p = jax.nn.softmax(s, axis=-1)
        return jnp.einsum("bgrqk,bkgd->bqgrd", p.astype(v.dtype), v)

    o = lax.map(block, jnp.arange(S // Q_BLOCK, dtype=jnp.int32))
    return o.transpose(1, 0, 2, 3, 4, 5).reshape(B, S, HQ, Dh)


def _fourier_mix(u):
    return jnp.real(jnp.fft.fft2(u.astype(jnp.float32), axes=(1, 3))).astype(u.dtype)


def _token_mixer(h, w_in, g_q, g_k, g_heads, w_out, tables):
    cos_t, sin_t, cos_r, sin_r, cos_c, sin_c = tables
    B, S, _ = h.shape
    proj = h @ w_in
    qa, ka, va, qb, kb, vb, uc = jnp.split(proj, IN_SPLITS, axis=-1)

    def heads(u, n):
        return u.reshape(B, S, n, HEAD_DIM)

    qa = _partial_rope(heads(qa, N_HEADS_A), cos_t, sin_t)
    ka = _partial_rope(heads(ka, N_HEADS_A), cos_t, sin_t)
    oa = _dilated_attention(qa, ka, heads(va, N_HEADS_A))
    qb = _axial_rope(_rms_norm(heads(qb, N_HEADS_B), g_q), cos_r, sin_r, cos_c, sin_c)
    kb = _axial_rope(_rms_norm(heads(kb, N_KV_B), g_k), cos_r, sin_r, cos_c, sin_c)
    ob = _grid_attention(qb, kb, heads(vb, N_KV_B))
    oc = _fourier_mix(heads(uc, N_GROUPS_C))
    o = jnp.concatenate([oa, ob, oc], axis=2)
    o = _rms_norm(o, g_heads.reshape(N_MIX_HEADS, HEAD_DIM))
    return o.reshape(B, S, D_MIX) @ w_out


def _conv_glu_ffn(h, w_gate, w_up, conv_w, conv_b, w_down):
    g = h @ w_gate
    gp = jnp.pad(g, ((0, 0), (1, 1), (0, 0)))
    g = gp[:, :-2] * conv_w[0] + gp[:, 1:-1] * conv_w[1] + gp[:, 2:] * conv_w[2] + conv_b
    return (jax.nn.gelu(g, approximate=True) * (h @ w_up)) @ w_down


def _trunk(x, g_mix_pre, g_mix_post, w_in, g_q, g_k, g_heads, w_out,
           g_ffn_pre, g_ffn_post, w_gate, w_up, conv_w, conv_b, w_down):
    tables = _position_tables(x.shape[1])
    for l in range(DEPTH):
        mix = _token_mixer(_rms_norm(x, g_mix_pre[l]), w_in[l], g_q[l], g_k[l], g_heads[l], w_out[l], tables)
        x = x + _rms_norm(mix, g_mix_post[l])
        ff = _conv_glu_ffn(_rms_norm(x, g_ffn_pre[l]), w_gate[l], w_up[l], conv_w[l], conv_b[l], w_down[l])
        x = x + _rms_norm(ff, g_ffn_post[l])
    return x


def setup_inputs(seed: int = 0) -> dict:
    key = jax.random.key(seed)
    ks = jax.random.split(key, 16)

    def nrm(k, shape, scale):
        return scale * jax.random.normal(k, shape, jnp.float32)

    def gain(k, shape):
        return 1.0 + 0.02 * jax.random.normal(k, shape, jnp.float32)

    return {
        "x_prompt": nrm(ks[0], (BATCH, SEQ, D_MODEL), 1.0),
        "x_sample": nrm(ks[1], (DEC_BATCH, DEC_SEQ, D_MODEL), 1.0),
        "g_mix_pre": gain(ks[2], (DEPTH, D_MODEL)),
        "g_mix_post": gain(ks[3], (DEPTH, D_MODEL)),
        "w_in": nrm(ks[4], (DEPTH, D_MODEL, D_IN), D_MODEL ** -0.5),
        "g_q": gain(ks[5], (DEPTH, HEAD_DIM)),
        "g_k": gain(ks[6], (DEPTH, HEAD_DIM)),
        "g_heads": gain(ks[7], (DEPTH, D_MIX)),
        "w_out": nrm(ks[8], (DEPTH, D_MIX, D_MODEL), D_MIX ** -0.5),
        "g_ffn_pre": gain(ks[9], (DEPTH, D_MODEL)),
        "g_ffn_post": gain(ks[10], (DEPTH, D_MODEL)),
        "w_gate": nrm(ks[11], (DEPTH, D_MODEL, D_FF), D_MODEL ** -0.5),
        "w_up": nrm(ks[12], (DEPTH, D_MODEL, D_FF), D_MODEL ** -0.5),
        "conv_w": nrm(ks[13], (DEPTH, CONV_W, D_FF), CONV_W ** -0.5),
        "conv_b": nrm(ks[14], (DEPTH, D_FF), 0.01),
        "w_down": nrm(ks[15], (DEPTH, D_FF, D_MODEL), D_FF ** -0.5),
    }


def reference(x_prompt, x_sample, g_mix_pre, g_mix_post, w_in, g_q, g_k, g_heads, w_out,
              g_ffn_pre, g_ffn_post, w_gate, w_up, conv_w, conv_b, w_down):
    y_prompt = _trunk(x_prompt, g_mix_pre, g_mix_post, w_in, g_q, g_k, g_heads, w_out,
                      g_ffn_pre, g_ffn_post, w_gate, w_up, conv_w, conv_b, w_down)
    y_sample = _trunk(x_sample, g_mix_pre, g_mix_post, w_in, g_q, g_k, g_heads, w_out,
                      g_ffn_pre, g_ffn_post, w_gate, w_up, conv_w, conv_b, w_down)
    return (y_prompt, y_sample)
```

```cpp
#include <hip/hip_runtime.h>
#include <hip/hip_cooperative_groups.h>
#include <cstdio>
#include <cstdint>
namespace cg = cooperative_groups;

#define DI __device__ __forceinline__
typedef unsigned short bf16_t;
typedef short bf16x8 __attribute__((ext_vector_type(8)));
typedef short s16x4 __attribute__((ext_vector_type(4)));
typedef float f32x16 __attribute__((ext_vector_type(16)));
typedef float f32x4 __attribute__((ext_vector_type(4)));
typedef float f32x2 __attribute__((ext_vector_type(2)));
typedef unsigned u32x4 __attribute__((ext_vector_type(4)));
typedef unsigned u32x2 __attribute__((ext_vector_type(2)));
typedef __bf16 bf16x2_t __attribute__((ext_vector_type(2)));
typedef short v4i16_t __attribute__((ext_vector_type(4)));

#ifndef USE_TR
#define USE_TR 1
#endif
#ifndef PHMASK
#define PHMASK 0x1ff
#endif
#define PHEN(b) ((PHMASK>>(b))&1)
#ifndef DUPSUB
#define DUPSUB -1
#endif
#ifndef DUPPH
#define DUPPH -1
#endif
#ifndef MULTI_LAUNCH
#define MULTI_LAUNCH 0
#endif

constexpr int DM = 1024, DFF = 4096;
constexpr int MP = 65536, MS = 16384, MT = MP + MS;
constexpr int NIN = 2048;
constexpr float EPS = 1e-6f;
constexpr float QSCALE = 0.125f * 1.4426950408889634f;
constexpr int NTHREADS = 512;
constexpr int CST = 260;
constexpr int LDS_BYTES = 129 * CST * 4;

constexpr size_t MiB = 1ull << 20;
constexpr size_t WS_CTL = 0;
constexpr size_t WS_TAB = 1 * MiB;
constexpr size_t WS_W = 4 * MiB;
constexpr size_t W_LAYER = 30 * MiB, W_IN = 0, W_OUT = 4 * MiB, W_GU = 6 * MiB, W_DOWN = 22 * MiB;
constexpr size_t WS_XN = 64 * MiB;
constexpr size_t WS_O = 224 * MiB;
constexpr size_t WS_QA = 384 * MiB, WS_KA = 424 * MiB, WS_VA = 464 * MiB, WS_QB = 504 * MiB, WS_KB = 584 * MiB, WS_VB = 604 * MiB;
constexpr size_t WS_ZC = 624 * MiB, WS_BF = 704 * MiB, WS_PART = 784 * MiB, WS_LSE = 904 * MiB;
constexpr size_t WS_MIX = 384 * MiB;
constexpr size_t WS_ACT = 224 * MiB;
constexpr size_t WS_FF = 864 * MiB;
constexpr size_t WS_RS = 3 * MiB;
constexpr size_t WS_END = 1024 * MiB;
constexpr size_t T_ROPET_C = 0, T_ROPET_S = 256 * 1024;
constexpr size_t T_ROPER_C = 512 * 1024, T_ROPER_S = T_ROPER_C + 8192;
constexpr size_t T_ROPEC_C = T_ROPER_S + 8192, T_ROPEC_S = T_ROPEC_C + 4096;
constexpr size_t T_TW_C = 640 * 1024, T_TW_S = T_TW_C + 32768;
constexpr size_t T_C128 = 768 * 1024, T_S128 = T_C128 + 32768;
constexpr size_t T_C64 = T_S128 + 32768, T_S64 = T_C64 + 8192;
constexpr size_t T_C32 = T_S64 + 8192, T_S32 = T_C32 + 2048;

struct Params {
  const float* x_prompt; const float* x_sample;
  const float* g_mix_pre; const float* g_mix_post; const float* w_in; const float* g_q; const float* g_k; const float* g_heads; const float* w_out;
  const float* g_ffn_pre; const float* g_ffn_post; const float* w_gate; const float* w_up; const float* conv_w; const float* conv_b; const float* w_down;
  float* out; char* ws;
  int plo, phi;
  int seq[30];
};

DI unsigned cvtpk(float lo, float hi) { f32x2 v = {lo, hi}; bf16x2_t b = __builtin_convertvector(v, bf16x2_t); return __builtin_bit_cast(unsigned, b); }
DI float bflo(unsigned u) { return __uint_as_float(u << 16); }
DI float bfhi(unsigned u) { return __uint_as_float(u & 0xffff0000u); }
DI int crow(int reg, int h) { return (reg & 3) + 8 * (reg >> 2) + 4 * h; }
DI f32x16 mfma32(bf16x8 a, bf16x8 b, f32x16 c) { return __builtin_amdgcn_mfma_f32_32x32x16_bf16(a, b, c, 0, 0, 0); }
DI float fexp2(float x) { return __builtin_amdgcn_exp2f(x); }
DI f32x16 zero16() { f32x16 z;
#pragma unroll
  for (int i = 0; i < 16; ++i) z[i] = 0.f; return z; }
DI int seq_of_token(int tok, int& base, int& S) { if (tok < MP) { int s = tok >> 13; base = s << 13; S = 8192; return s; } int j = (tok - MP) >> 12; base = MP + (j << 12); S = 4096; return 8 + j; }
DI void seq_info(int seq, int& base, int& S) { if (seq < 8) { base = seq << 13; S = 8192; } else { base = MP + ((seq - 8) << 12); S = 4096; } }

DI void sincos_d(double a, float& s, float& c) {
  const double TWO_PI = 6.283185307179586476925286766559;
  a -= TWO_PI * __builtin_rint(a / TWO_PI);
  const double x2 = a * a;
  double ts = 1.0, tc = 1.0, ss = 1.0, cc = 1.0;
#pragma unroll
  for (int n = 1; n <= 13; ++n) { tc *= -x2 / (double)((2 * n - 1) * (2 * n)); ts *= -x2 / (double)((2 * n) * (2 * n + 1)); cc += tc; ss += ts; }
  s = (float)(a * ss); c = (float)cc;
}

DI bf16x8 tr_frag(const char* tile, int rs, int rowA, int rowB, int n0, int lane) {
#if USE_TR
  const int i16 = lane & 15, q4 = i16 >> 2, p4 = i16 & 3, nh = (lane >> 4) & 1;
  const char* a1 = tile + (rowA + q4) * rs + (n0 + 16 * nh + 4 * p4) * 2;
  const char* a2 = tile + (rowB + q4) * rs + (n0 + 16 * nh + 4 * p4) * 2;
  v4i16_t lo = __builtin_amdgcn_ds_read_tr16_b64_v4i16((__attribute__((address_space(3))) v4i16_t*)a1);
  v4i16_t hi = __builtin_amdgcn_ds_read_tr16_b64_v4i16((__attribute__((address_space(3))) v4i16_t*)a2);
  return (bf16x8){lo[0], lo[1], lo[2], lo[3], hi[0], hi[1], hi[2], hi[3]};
#else
  const int c = n0 + (lane & 31);
  bf16x8 f;
#pragma unroll
  for (int j = 0; j < 4; ++j) { f[j] = *(const short*)(tile + (rowA + j) * rs + c * 2); f[4 + j] = *(const short*)(tile + (rowB + j) * rs + c * 2); }
  return f;
#endif
}

DI float wave_sum(float v) {
#pragma unroll
  for (int o = 32; o >= 1; o >>= 1) v += __shfl_xor(v, o);
  return v;
}

DI void rowpass(int lane, const bf16_t* xn_in_row, float s_in, const float* xin_row, const bf16_t* add_row, const float* gpost, float* xout_row, bf16_t* xn_row, float* s_out) {
  float x[16];
  if (xin_row) {
#pragma unroll
    for (int i = 0; i < 4; ++i) { const f32x4 v = *(const f32x4*)(xin_row + i * 256 + lane * 4); x[4 * i] = v[0]; x[4 * i + 1] = v[1]; x[4 * i + 2] = v[2]; x[4 * i + 3] = v[3]; }
  } else {
#pragma unroll
    for (int i = 0; i < 4; ++i) { const u32x2 v = *(const u32x2*)(xn_in_row + i * 256 + lane * 4); x[4 * i] = bflo(v[0]) * s_in; x[4 * i + 1] = bfhi(v[0]) * s_in; x[4 * i + 2] = bflo(v[1]) * s_in; x[4 * i + 3] = bfhi(v[1]) * s_in; }
  }
  if (add_row) {
    float a[16]; float ss = 0.f;
#pragma unroll
    for (int i = 0; i < 4; ++i) { const u32x2 v = *(const u32x2*)(add_row + i * 256 + lane * 4); a[4 * i] = bflo(v[0]); a[4 * i + 1] = bfhi(v[0]); a[4 * i + 2] = bflo(v[1]); a[4 * i + 3] = bfhi(v[1]); }
#pragma unroll
    for (int i = 0; i < 16; ++i) ss += a[i] * a[i];
    ss = wave_sum(ss);
    const float ra = rsqrtf(ss * (1.0f / 1024.0f) + EPS);
#pragma unroll
    for (int i = 0; i < 4; ++i) { const f32x4 g = *(const f32x4*)(gpost + i * 256 + lane * 4);
#pragma unroll
      for (int e = 0; e < 4; ++e) x[4 * i + e] += a[4 * i + e] * ra * g[e]; }
  }
  if (xout_row) {
#pragma unroll
    for (int i = 0; i < 4; ++i) *(f32x4*)(xout_row + i * 256 + lane * 4) = (f32x4){x[4 * i], x[4 * i + 1], x[4 * i + 2], x[4 * i + 3]};
  }
  if (xn_row) {
    float ss = 0.f;
#pragma unroll
    for (int i = 0; i < 16; ++i) ss += x[i] * x[i];
    ss = wave_sum(ss);
    const float ms = ss * (1.0f / 1024.0f) + EPS;
    const float rx = rsqrtf(ms);
#pragma unroll
    for (int i = 0; i < 4; ++i) { u32x2 w; w[0] = cvtpk(x[4 * i] * rx, x[4 * i + 1] * rx); w[1] = cvtpk(x[4 * i + 2] * rx, x[4 * i + 3] * rx); *(u32x2*)(xn_row + i * 256 + lane * 4) = w; }
    if (lane == 0) *s_out = __builtin_sqrtf(ms);
  }
}

namespace pg8 {
#define PG8_LAS __attribute__((address_space(3)))
typedef unsigned short bf16_t;
typedef short bf16x8 __attribute__((ext_vector_type(8)));
typedef float f32x4 __attribute__((ext_vector_type(4)));
typedef unsigned u32x4 __attribute__((ext_vector_type(4)));
constexpr int BM = 256, BK = 64, HALF = 128, HTB = HALF * BK * 2  , STAGE_BYTES = 8 * HTB, NXCD = 8, WGM = 8;

__host__ __device__ __forceinline__ int lds_byte(int r, int c) { const int st = (r >> 4) * 2 + (c >> 5), rr = r & 15, cc = c & 31, ob = rr * 64 + cc * 2; return st * 1024 + (ob ^ (((ob >> 9) & 1) << 5)); }
__host__ __device__ __forceinline__ void stage_rc(int b, int& R, int& C) { const int st = b / 1024, sb = b % 1024, swz = sb ^ (((sb >> 9) & 1) << 5); R = (st >> 1) * 16 + swz / 64; C = (st & 1) * 32 + (swz % 64) / 2; }
__host__ __device__ __forceinline__ int perm32(int rho) { const int n = rho >> 4, i = rho & 15; return 8 * (i >> 2) + 4 * n + (i & 3); }

struct Unit { int pm, pn; long arow; };
struct Gemm { const bf16_t* A; const bf16_t* Bt; int M, N, K; };
template <class Epi, class Sched, bool ALIGN_EPI = false, bool SP2 = false>
__device__ __forceinline__ void gemm_phase(PG8_LAS unsigned char* lds, const Gemm g, const Sched& S, const Epi& E) {
    int tid_ = threadIdx.x; asm volatile("" : "+v"(tid_));
    const int tid = tid_, wid = __builtin_amdgcn_readfirstlane(tid >> 6), lane = tid & 63, wr = wid >> 2, wc = wid & 3, fr = lane & 15, fq = lane >> 4;
    const int K = g.K, nt = K / BK;
    unsigned voffA[2], voffB[2];
#pragma unroll
    for (int i = 0; i < 2; ++i) { int R, C; stage_rc(tid * 16 + i * 8192, R, C); const int Rb = Epi::PERM ? ((R & ~31) + perm32(R & 31)) : R;
        voffA[i] = (unsigned)(R * K + C) * 2u; voffB[i] = (unsigned)(Rb * K + C) * 2u; }
    const size_t kstep = (size_t)(BK * 2);
    const size_t hstep = (size_t)HALF * K * 2;
    const size_t tstep = 2 * hstep;
    const unsigned ldsw = (unsigned)wid * 1024u;
    const int aoff = lds_byte(wr * 64 + fr, fq * 8), boff = lds_byte(wc * 32 + fr, fq * 8);
#define PG8_SA(b, h) (((b) * 2 + (h)) * HTB)
#define PG8_SB(b, h) ((4 + (b) * 2 + (h)) * HTB)
#define PG8_STAGE(bufoff, gbase, voff) do { _Pragma("unroll") for (int _i = 0; _i < 2; ++_i) \
        __builtin_amdgcn_global_load_lds((const unsigned*)((const char*)(gbase) + (voff)[_i]), (PG8_LAS unsigned*)(lds + (bufoff) + ldsw + _i * 8192), 16, 0, 0); } while (0)
#define PG8_LDA(dst, b, h) do { _Pragma("unroll") for (int m = 0; m < 4; ++m) _Pragma("unroll") for (int k = 0; k < 2; ++k) dst[m][k] = *(const PG8_LAS bf16x8*)(lds + PG8_SA(b, h) + aoff + m * 2048 + k * 1024); } while (0)
#define PG8_LDB(dst, b, h) do { _Pragma("unroll") for (int n = 0; n < 2; ++n) _Pragma("unroll") for (int k = 0; k < 2; ++k) dst[n][k] = *(const PG8_LAS bf16x8*)(lds + PG8_SB(b, h) + boff + n * 2048 + k * 1024); } while (0)
#define PG8_MMA(ai, bj, At, Bt) do { __builtin_amdgcn_s_setprio(1); _Pragma("unroll") for (int m = 0; m < 4; ++m) _Pragma("unroll") for (int n = 0; n < 2; ++n) _Pragma("unroll") for (int k = 0; k < 2; ++k) \
        acc[ai][bj][m][n] = __builtin_amdgcn_mfma_f32_16x16x32_bf16(Bt[n][k], At[m][k], acc[ai][bj][m][n], 0, 0, 0); __builtin_amdgcn_s_setprio(0); } while (0)
#define PG8_WAIT_V(n) asm volatile("s_waitcnt vmcnt(" #n ")" ::: "memory")
#define PG8_WAIT_L(n) asm volatile("s_waitcnt lgkmcnt(" #n ")" ::: "memory")
#define PG8_BAR __builtin_amdgcn_s_barrier()
#define PG8_SCHED __builtin_amdgcn_sched_barrier(0)
    Unit cur, nxt; int ui = 0;
    if (!S.next(0, cur)) return;
    f32x4 acc[2][2][4][2];
#pragma unroll
    for (int a = 0; a < 2; ++a)
#pragma unroll
        for (int b = 0; b < 2; ++b)
#pragma unroll
            for (int m = 0; m < 4; ++m)
#pragma unroll
                for (int n = 0; n < 2; ++n) acc[a][b][m][n] = (f32x4){0.f, 0.f, 0.f, 0.f};
    bf16x8 At[4][2], B0[2][2], B1[2][2];
    const char* cA = (const char*)g.A + cur.arow * (long)(K * 2); const char* cB = (const char*)g.Bt + (size_t)cur.pn * tstep;
    S.a_ready(cur);
    if constexpr (SP2) {
        PG8_STAGE(PG8_SB(0, 0), cB, voffB); PG8_STAGE(PG8_SB(0, 1), cB + hstep, voffB); PG8_STAGE(PG8_SA(0, 0), cA, voffA); PG8_STAGE(PG8_SA(0, 1), cA + hstep, voffA);
        if (wr == 1) PG8_BAR;
        PG8_WAIT_V(2); PG8_BAR;
        PG8_STAGE(PG8_SB(1, 0), cB + kstep, voffB); PG8_STAGE(PG8_SA(1, 0), cA + kstep, voffA); PG8_STAGE(PG8_SB(1, 1), cB + hstep + kstep, voffB);
        PG8_WAIT_V(6); PG8_BAR;
    } else {
        PG8_STAGE(PG8_SB(0, 0), cB, voffB); PG8_STAGE(PG8_SA(0, 0), cA, voffA); PG8_STAGE(PG8_SB(0, 1), cB + hstep, voffB); PG8_STAGE(PG8_SA(0, 1), cA + hstep, voffA);
        if (wr == 1) PG8_BAR;
        PG8_WAIT_V(4); PG8_BAR;
        PG8_STAGE(PG8_SB(1, 0), cB + kstep, voffB); PG8_STAGE(PG8_SA(1, 0), cA + kstep, voffA); PG8_STAGE(PG8_SB(1, 1), cB + hstep + kstep, voffB);
        PG8_WAIT_V(6); PG8_BAR;
    }
    for (;;) {
        const bool has_next = S.next(ui + 1, nxt);
        const char* nA = has_next ? (const char*)g.A + nxt.arow * (long)(K * 2) : cA; const char* nB = has_next ? (const char*)g.Bt + (size_t)nxt.pn * tstep : cB;
        for (int t = 0; t < nt; t += 2) {
            const bool last = (t == nt - 2);
            const char* a1 = cA + (size_t)(t + 1) * kstep;
            const char* a2 = last ? nA : cA + (size_t)(t + 2) * kstep; const char* b2 = last ? nB : cB + (size_t)(t + 2) * kstep;
            const char* a3 = a2 + kstep; const char* b3 = b2 + kstep;
            if (last && has_next) S.a_ready(nxt);
            if constexpr (SP2) {
            PG8_LDB(B0, 0, 0); PG8_LDB(B1, 0, 1); PG8_SCHED; PG8_LDA(At, 0, 0); PG8_STAGE(PG8_SA(1, 1), a1 + hstep, voffA);
            PG8_WAIT_V(8); PG8_WAIT_L(0); PG8_BAR; PG8_MMA(0, 0, At, B0); PG8_MMA(0, 1, At, B1); PG8_BAR; PG8_SCHED;
            PG8_LDA(At, 0, 1); PG8_STAGE(PG8_SB(0, 0), b2, voffB); PG8_STAGE(PG8_SB(0, 1), b2 + hstep, voffB); PG8_STAGE(PG8_SA(0, 0), a2, voffA);
            PG8_WAIT_V(8); PG8_WAIT_L(0); PG8_BAR; PG8_MMA(1, 0, At, B0); PG8_MMA(1, 1, At, B1); PG8_BAR; PG8_SCHED;
            PG8_LDB(B0, 1, 0); PG8_LDB(B1, 1, 1); PG8_SCHED; PG8_LDA(At, 1, 0); PG8_STAGE(PG8_SA(0, 1), a2 + hstep, voffA);
            PG8_WAIT_V(8); PG8_WAIT_L(0); PG8_BAR; PG8_MMA(0, 0, At, B0); PG8_MMA(0, 1, At, B1); PG8_BAR; PG8_SCHED;
            PG8_LDA(At, 1, 1); PG8_STAGE(PG8_SB(1, 0), b3, voffB); PG8_STAGE(PG8_SB(1, 1), b3 + hstep, voffB); PG8_STAGE(PG8_SA(1, 0), a3, voffA);
            PG8_WAIT_V(8); PG8_WAIT_L(0); PG8_BAR; PG8_MMA(1, 0, At, B0); PG8_MMA(1, 1, At, B1); PG8_BAR; PG8_SCHED;
            } else {
            PG8_LDB(B0, 0, 0); PG8_SCHED; PG8_LDA(At, 0, 0); PG8_STAGE(PG8_SA(1, 1), a1 + hstep, voffA);
            PG8_WAIT_L(8); PG8_BAR; PG8_WAIT_L(0); PG8_MMA(0, 0, At, B0); PG8_BAR; PG8_SCHED;
            PG8_LDB(B1, 0, 1); PG8_STAGE(PG8_SB(0, 0), b2, voffB);
            PG8_BAR; PG8_WAIT_L(0); PG8_MMA(0, 1, At, B1); PG8_BAR;
            PG8_LDA(At, 0, 1); PG8_STAGE(PG8_SA(0, 0), a2, voffA);
            PG8_BAR; PG8_WAIT_L(0); PG8_MMA(1, 0, At, B0); PG8_BAR; PG8_SCHED;
            PG8_STAGE(PG8_SB(0, 1), b2 + hstep, voffB);
            PG8_WAIT_V(6); PG8_BAR; PG8_MMA(1, 1, At, B1); PG8_BAR;
            PG8_LDB(B0, 1, 0); PG8_SCHED; PG8_LDA(At, 1, 0); PG8_STAGE(PG8_SA(0, 1), a2 + hstep, voffA);
            PG8_WAIT_L(8); PG8_BAR; PG8_WAIT_L(0); PG8_MMA(0, 0, At, B0); PG8_BAR; PG8_SCHED;
            PG8_LDB(B1, 1, 1); PG8_STAGE(PG8_SB(1, 0), b3, voffB);
            PG8_BAR; PG8_WAIT_L(0); PG8_MMA(0, 1, At, B1); PG8_BAR;
            PG8_LDA(At, 1, 1); PG8_STAGE(PG8_SA(1, 0), a3, voffA);
            PG8_BAR; PG8_WAIT_L(0); PG8_MMA(1, 0, At, B0); PG8_BAR; PG8_SCHED;
            PG8_STAGE(PG8_SB(1, 1), b3 + hstep, voffB);
            PG8_WAIT_V(6); PG8_BAR; PG8_MMA(1, 1, At, B1); PG8_BAR;
            }
        }
        if constexpr (ALIGN_EPI) { if (wr == 0) PG8_BAR; }
        if constexpr (!Epi::AFTER_DRAIN) { E(acc, cur, wr, wc, fr, fq); S.done(cur); }
        if (!has_next) break;
#pragma unroll
        for (int a = 0; a < 2; ++a)
#pragma unroll
            for (int b = 0; b < 2; ++b)
#pragma unroll
                for (int m = 0; m < 4; ++m)
#pragma unroll
                    for (int n = 0; n < 2; ++n) acc[a][b][m][n] = (f32x4){0.f, 0.f, 0.f, 0.f};
        cur = nxt; cA = nA; cB = nB; ++ui;
        if constexpr (ALIGN_EPI) { if (wr == 1) PG8_BAR; }
    }
    PG8_WAIT_V(0);
    if constexpr (!ALIGN_EPI) { if (wr == 0) PG8_BAR; }
    PG8_BAR;
    if constexpr (Epi::AFTER_DRAIN) { E.fused(acc, cur, wr, wc, fr, fq, lds, wid, lane); S.done(cur); }
#undef PG8_SA
#undef PG8_SB
#undef PG8_STAGE
#undef PG8_LDA
#undef PG8_LDB
#undef PG8_MMA
#undef PG8_WAIT_V
#undef PG8_WAIT_L
#undef PG8_BAR
#undef PG8_SCHED
}
}

DI int swz(int row, int ch) { return row * 128 + ((ch ^ ((row >> 1) & 7)) << 4); }
template <int AI> DI void stage_t(char* lds, const pg8::f32x4 (&acc)[2][2][4][2], int wr, int wc, int fr, int fq, int shift) {
  float* sC = (float*)lds;
#pragma unroll
  for (int bj = 0; bj < 2; ++bj)
#pragma unroll
    for (int m = 0; m < 4; ++m)
#pragma unroll
      for (int n = 0; n < 2; ++n) *(pg8::f32x4*)(sC + (64 * wr + 16 * m + fr + shift) * CST + 128 * bj + 32 * wc + 16 * n + 4 * fq) = acc[AI][bj][m][n];
}
DI void ld8(const float* p, float (&v)[8]) { const f32x4 a = *(const f32x4*)p, b = *(const f32x4*)(p + 4); v[0] = a[0]; v[1] = a[1]; v[2] = a[2]; v[3] = a[3]; v[4] = b[0]; v[5] = b[1]; v[6] = b[2]; v[7] = b[3]; }
DI u32x4 pack8(const float (&v)[8]) { u32x4 w; w[0] = cvtpk(v[0], v[1]); w[1] = cvtpk(v[2], v[3]); w[2] = cvtpk(v[4], v[5]); w[3] = cvtpk(v[6], v[7]); return w; }

enum { EPI_PLAIN = 0, EPI_ROPEA = 1, EPI_NRB = 2 };
DI void ld4(const float* p, float (&v)[4]) { const f32x4 a = *(const f32x4*)p; v[0] = a[0]; v[1] = a[1]; v[2] = a[2]; v[3] = a[3]; }
DI void epi_rows(char* lds, int tid, int kind, int tok0, int sc0, bf16_t* dst, int pitch, int col0, float scale, const float* gain, const char* tab) {
  const float* sC = (const float*)lds + sc0;
  const int lane = tid & 63, w = tid >> 6, j = lane & 31, jj = j & 15;
#pragma unroll 2
  for (int pass = 0; pass < 8; ++pass) {
    const int row = pass * 16 + w * 2 + (lane >> 5);
    const int tok = tok0 + row;
    float v[4]; ld4(sC + row * CST + 4 * j, v);
    if (kind == EPI_ROPEA) {
      if (jj < 4) {
        const int pos = (tok < MP) ? (tok & 8191) : (tok & 4095);
        float o[4]; ld4(sC + row * CST + 4 * (j ^ 2), o);
        float cs[4], sn[4]; ld4((const float*)(tab + T_ROPET_C) + pos * 8 + 4 * (jj & 1), cs); ld4((const float*)(tab + T_ROPET_S) + pos * 8 + 4 * (jj & 1), sn);
#pragma unroll
        for (int e = 0; e < 4; ++e) v[e] = (jj < 2) ? (v[e] * cs[e] - o[e] * sn[e]) : (v[e] * cs[e] + o[e] * sn[e]);
      }
    } else if (kind == EPI_NRB) {
      float ss = v[0] * v[0] + v[1] * v[1] + v[2] * v[2] + v[3] * v[3];
      ss += __shfl_xor(ss, 1); ss += __shfl_xor(ss, 2); ss += __shfl_xor(ss, 4); ss += __shfl_xor(ss, 8);
      const float rr = rsqrtf(ss * (1.0f / 64.0f) + EPS);
      float o[4]; ld4(sC + row * CST + 4 * (j ^ 4), o);
      float go[4], gp[4]; ld4(gain + 4 * jj, go); ld4(gain + 4 * (jj ^ 4), gp);
      const int pos = (tok < MP) ? (tok & 8191) : (tok & 4095);
      const float* tc = (jj < 8) ? ((const float*)(tab + T_ROPER_C) + (pos >> 6) * 16) : ((const float*)(tab + T_ROPEC_C) + (pos & 63) * 16);
      const float* ts = (jj < 8) ? ((const float*)(tab + T_ROPER_S) + (pos >> 6) * 16) : ((const float*)(tab + T_ROPEC_S) + (pos & 63) * 16);
      float cs[4], sn[4]; ld4(tc + 4 * (jj & 3), cs); ld4(ts + 4 * (jj & 3), sn);
#pragma unroll
      for (int e = 0; e < 4; ++e) { const float yo = v[e] * rr * go[e], yp = o[e] * rr * gp[e]; v[e] = ((jj & 4) == 0) ? (yo * cs[e] - yp * sn[e]) : (yo * cs[e] + yp * sn[e]); }
    }
    u32x2 wv; wv[0] = cvtpk(v[0] * scale, v[1] * scale); wv[1] = cvtpk(v[2] * scale, v[3] * scale);
    *(u32x2*)(dst + (size_t)tok * pitch + col0 + 4 * j) = wv;
  }
}

DI float gelu_tanh(float x) { const float u = x * x; const float t = x * (-2.302208198f + -0.1029432397f * u); return x * __builtin_amdgcn_rcpf(1.0f + fexp2(t)); }

constexpr float ATT_THR = 6.0f;
template <bool MASKED>
DI void flash_core(char* lds, int tid, const bf16_t* Qp, int qpitch, const bf16_t* Kp, int kpitch, const bf16_t* Vp, int vpitch,
                   int base, int dil, int L, int iq0, int kt0, int ntiles, f32x16 (&O)[2], float& m_run, float& l_run) {
  const int lane = tid & 63, w = tid >> 6, r32 = lane & 31, h = lane >> 5;
  const int iq = iq0 + 32 * w + r32;
  bf16x8 qf[4];
  { const bf16_t* qrow = Qp + (size_t)(base + dil * iq) * qpitch;
#pragma unroll
    for (int ks = 0; ks < 4; ++ks) qf[ks] = *(const bf16x8*)(qrow + 16 * ks + 8 * h); }
  const int lrow = tid >> 3, lch = tid & 7;
  const int kso = swz(lrow, lch), vso = 8192 + (lch >> 2) * 4096 + lrow * 64 + (lch & 3) * 16;
  u32x4 kreg, vreg;
#define FA_GLOAD(t) do { int ik = kt0 + 64 * (t) + lrow; ik = ik < 0 ? 0 : (ik > L - 1 ? L - 1 : ik); const size_t tok = (size_t)(base + dil * ik); \
    kreg = *(const u32x4*)(Kp + tok * kpitch + lch * 8); vreg = *(const u32x4*)(Vp + tok * vpitch + lch * 8); } while (0)
#define FA_LSTORE(b) do { *(u32x4*)(lds + (b) * 16384 + kso) = kreg; *(u32x4*)(lds + (b) * 16384 + vso) = vreg; } while (0)
  FA_GLOAD(0); FA_LSTORE(0); __syncthreads();
  O[0] = zero16(); O[1] = zero16(); m_run = 0.f; l_run = 0.f;
  f32x16 negm = zero16();
  const int iqw = iq0 + 32 * w;
  for (int t = 0; t < ntiles; ++t) {
    const bool more = (t + 1 < ntiles);
    if (more) FA_GLOAD(t + 1);
    const char* kb = lds + (t & 1) * 16384; const char* vb = kb + 8192;
    bool need = true;
    if (MASKED) { const int k_lo = kt0 + 64 * t; need = (k_lo + 63 >= iqw - 64) && (k_lo <= iqw + 31 + 64); }
    if (need) {
      f32x16 S0 = negm, S1 = negm;
#pragma unroll
      for (int ks = 0; ks < 4; ++ks) {
        const bf16x8 k0 = *(const bf16x8*)(kb + swz(r32, 2 * ks + h));
        const bf16x8 k1 = *(const bf16x8*)(kb + swz(32 + r32, 2 * ks + h));
        S0 = mfma32(k0, qf[ks], S0); S1 = mfma32(k1, qf[ks], S1);
      }
      if (MASKED) {
#pragma unroll
        for (int r = 0; r < 16; ++r) { const int ik0 = kt0 + 64 * t + crow(r, h), ik1 = ik0 + 32; const int d0 = ik0 - iq, d1 = ik1 - iq;
          const bool v0 = (ik0 >= 0) && (ik0 < L) && (d0 <= 64) && (d0 >= -64); const bool v1 = (ik1 >= 0) && (ik1 < L) && (d1 <= 64) && (d1 >= -64);
          S0[r] = v0 ? S0[r] : -1e30f; S1[r] = v1 ? S1[r] : -1e30f; }
      }
      float mx = __builtin_fmaxf(__builtin_fmaxf(S0[0], S0[1]), S1[0]);
      mx = __builtin_fmaxf(__builtin_fmaxf(mx, S1[1]), S0[2]);
#pragma unroll
      for (int r = 2; r < 16; r += 2) { mx = __builtin_fmaxf(__builtin_fmaxf(mx, S1[r]), S1[r + 1]); if (r + 2 < 16) mx = __builtin_fmaxf(__builtin_fmaxf(mx, S0[r + 1]), S0[r + 2]); else mx = __builtin_fmaxf(mx, S0[r + 1]); }
      mx = __builtin_fmaxf(mx, __shfl_xor(mx, 32));
      if (__builtin_amdgcn_ballot_w64(mx > ATT_THR) != 0ull) {
        const float dl = __builtin_fmaxf(mx, 0.f); m_run += dl; const float alpha = fexp2(-dl); l_run *= alpha;
#pragma unroll
        for (int r = 0; r < 16; ++r) { O[0][r] *= alpha; O[1][r] *= alpha; S0[r] -= dl; S1[r] -= dl; negm[r] = -m_run; }
      }
      float ps0 = 0.f, ps1 = 0.f;
#pragma unroll
      for (int r = 0; r < 16; ++r) { S0[r] = fexp2(S0[r]); S1[r] = fexp2(S1[r]); ps0 += S0[r]; ps1 += S1[r]; }
      l_run += ps0 + ps1;
#pragma unroll
      for (int s = 0; s < 4; ++s) {
        const int kvb = s >> 1, sp = s & 1;
        u32x4 pw;
        if (kvb == 0) { pw[0] = cvtpk(S0[8 * sp], S0[8 * sp + 1]); pw[1] = cvtpk(S0[8 * sp + 2], S0[8 * sp + 3]); pw[2] = cvtpk(S0[8 * sp + 4], S0[8 * sp + 5]); pw[3] = cvtpk(S0[8 * sp + 6], S0[8 * sp + 7]); }
        else          { pw[0] = cvtpk(S1[8 * sp], S1[8 * sp + 1]); pw[1] = cvtpk(S1[8 * sp + 2], S1[8 * sp + 3]); pw[2] = cvtpk(S1[8 * sp + 4], S1[8 * sp + 5]); pw[3] = cvtpk(S1[8 * sp + 6], S1[8 * sp + 7]); }
        const bf16x8 xs = __builtin_bit_cast(bf16x8, pw);
        const int rowA = 32 * kvb + 16 * sp + 4 * h;
#pragma unroll
        for (int db = 0; db < 2; ++db) { const bf16x8 vf = tr_frag(vb + db * 4096, 64, rowA, rowA + 8, 0, lane); O[db] = mfma32(vf, xs, O[db]); }
      }
    }
    if (more) FA_LSTORE((t + 1) & 1);
    __syncthreads();
  }
#undef FA_GLOAD
#undef FA_LSTORE
}

DI void flash_grid(char* lds, int tid, const bf16_t* Qp, const bf16_t* Kp, const bf16_t* Vp, int base, int iq0, int ntiles, float kbound, f32x16 (&O)[2], float& l_out) {
  const int lane = tid & 63, w = tid >> 6, r32 = lane & 31, h = lane >> 5;
  bf16x8 qf[4];
  { const bf16_t* qrow = Qp + (size_t)(base + iq0 + 32 * w + r32) * 512;
#pragma unroll
    for (int ks = 0; ks < 4; ++ks) qf[ks] = *(const bf16x8*)(qrow + 16 * ks + 8 * h); }
  float qn2 = 0.f;
#pragma unroll
  for (int ks = 0; ks < 4; ++ks)
#pragma unroll
    for (int e = 0; e < 8; ++e) { const float qv = __uint_as_float(((unsigned)(unsigned short)qf[ks][e]) << 16); qn2 += qv * qv; }
  qn2 += __shfl_xor(qn2, 32);
  const float m_row = __builtin_sqrtf(qn2) * kbound;
  const int lrow = tid >> 3, lch = tid & 7;
  const int kso = swz(lrow, lch), vso = 16384 + (lch >> 2) * 4096 + lrow * 64 + (lch & 3) * 16;
  const unsigned goff = (unsigned)(((base + lrow) * 128 + lch * 8) * 2);
#define KG(t) ((const char*)Kp + (size_t)(goff + (unsigned)(t) * (64u * 128u * 2u)))
#define VG(t) ((const char*)Vp + (size_t)(goff + (unsigned)(t) * (64u * 128u * 2u)))
  u32x4 kreg, vreg;
  int kfo[4];
#pragma unroll
  for (int ks = 0; ks < 4; ++ks) kfo[ks] = r32 * 128 + (((2 * ks + h) ^ ((r32 >> 1) & 7)) << 4);
  float l_run = 0.f;
  f32x16 negm;
#pragma unroll
  for (int r = 0; r < 16; ++r) negm[r] = -m_row;
  O[0] = zero16(); O[1] = zero16();
#define SB() __builtin_amdgcn_sched_barrier(0)
#define FG_QK(SN0, SN1, kb) do { bf16x8 kf[8]; \
    _Pragma("unroll") for (int ks = 0; ks < 4; ++ks) { kf[2 * ks] = *(const bf16x8*)((kb) + kfo[ks]); kf[2 * ks + 1] = *(const bf16x8*)((kb) + 4096 + kfo[ks]); } \
    SN0 = mfma32(kf[0], qf[0], negm); SN1 = mfma32(kf[1], qf[0], negm); \
    _Pragma("unroll") for (int ks = 1; ks < 4; ++ks) { SN0 = mfma32(kf[2 * ks], qf[ks], SN0); SN1 = mfma32(kf[2 * ks + 1], qf[ks], SN1); } } while (0)
  kreg = *(const u32x4*)KG(0); vreg = *(const u32x4*)VG(0);
  *(u32x4*)(lds + kso) = kreg; *(u32x4*)(lds + vso) = vreg;
  kreg = *(const u32x4*)KG(1);
  __syncthreads();
  f32x16 SA0, SA1, SB0, SB1;
  FG_QK(SA0, SA1, lds);
#pragma unroll
  for (int r = 0; r < 16; ++r) { SA0[r] = fexp2(SA0[r]); SA1[r] = fexp2(SA1[r]); }
  *(u32x4*)(lds + 8192 + kso) = kreg;
  __syncthreads();
#define FG_STEP(SC0, SC1, SN0, SN1, t, HASN, HASK) do { \
    const int cur_ = (t) & 1; \
    if (HASK) kreg = *(const u32x4*)KG((t) + 2); \
    if (HASN) vreg = *(const u32x4*)VG((t) + 1); \
    const char* kb_ = lds + (cur_ ^ 1) * 8192; const char* vb_ = lds + 16384 + cur_ * 8192; \
    bf16x8 kf_[8]; \
    if (HASN) { _Pragma("unroll") for (int ks = 0; ks < 2; ++ks) { kf_[2 * ks] = *(const bf16x8*)(kb_ + kfo[ks]); kf_[2 * ks + 1] = *(const bf16x8*)(kb_ + 4096 + kfo[ks]); } } \
    SB(); \
      \
    float ps_ = 0.f; u32x4 pw_[4]; \
    _Pragma("unroll") for (int g = 0; g < 8; ++g) { \
      if (HASN && g == 2) { _Pragma("unroll") for (int ks = 2; ks < 4; ++ks) { kf_[2 * ks] = *(const bf16x8*)(kb_ + kfo[ks]); kf_[2 * ks + 1] = *(const bf16x8*)(kb_ + 4096 + kfo[ks]); } } \
      if (HASN) { __builtin_amdgcn_s_setprio(1); if (g == 0) SN0 = mfma32(kf_[0], qf[0], negm); else if (g == 1) SN1 = mfma32(kf_[1], qf[0], negm); \
                  else if ((g & 1) == 0) SN0 = mfma32(kf_[g], qf[g >> 1], SN0); else SN1 = mfma32(kf_[g], qf[g >> 1], SN1); __builtin_amdgcn_s_setprio(0); } \
      if (g < 4) { ps_ += (SC0[4 * g] + SC0[4 * g + 1]) + (SC0[4 * g + 2] + SC0[4 * g + 3]); pw_[g >> 1][2 * (g & 1)] = cvtpk(SC0[4 * g], SC0[4 * g + 1]); pw_[g >> 1][2 * (g & 1) + 1] = cvtpk(SC0[4 * g + 2], SC0[4 * g + 3]); } \
      else { const int g2 = g - 4; ps_ += (SC1[4 * g2] + SC1[4 * g2 + 1]) + (SC1[4 * g2 + 2] + SC1[4 * g2 + 3]); pw_[2 + (g2 >> 1)][2 * (g2 & 1)] = cvtpk(SC1[4 * g2], SC1[4 * g2 + 1]); pw_[2 + (g2 >> 1)][2 * (g2 & 1) + 1] = cvtpk(SC1[4 * g2 + 2], SC1[4 * g2 + 3]); } \
      asm volatile("" : "+v"(ps_)); asm volatile("" : "+v"(pw_[g >> 1])); \
      SB(); } \
    l_run += ps_; \
      \
    bf16x8 vf_[8]; \
    _Pragma("unroll") for (int s = 0; s < 2; ++s) { const int rowA = 16 * s + 4 * h; \
      vf_[2 * s] = tr_frag(vb_, 64, rowA, rowA + 8, 0, lane); vf_[2 * s + 1] = tr_frag(vb_ + 4096, 64, rowA, rowA + 8, 0, lane); } \
    SB(); \
      \
    _Pragma("unroll") for (int g = 0; g < 8; ++g) { \
      if (g == 2) { _Pragma("unroll") for (int s = 2; s < 4; ++s) { const int rowA = 16 * s + 4 * h; \
        vf_[2 * s] = tr_frag(vb_, 64, rowA, rowA + 8, 0, lane); vf_[2 * s + 1] = tr_frag(vb_ + 4096, 64, rowA, rowA + 8, 0, lane); } } \
      __builtin_amdgcn_s_setprio(1); O[g & 1] = mfma32(vf_[g], __builtin_bit_cast(bf16x8, pw_[g >> 1]), O[g & 1]); __builtin_amdgcn_s_setprio(0); \
      if (HASN) { if (g < 4) { SN0[4 * g] = fexp2(SN0[4 * g]); SN0[4 * g + 1] = fexp2(SN0[4 * g + 1]); SN0[4 * g + 2] = fexp2(SN0[4 * g + 2]); SN0[4 * g + 3] = fexp2(SN0[4 * g + 3]); } \
                  else { const int g2 = g - 4; SN1[4 * g2] = fexp2(SN1[4 * g2]); SN1[4 * g2 + 1] = fexp2(SN1[4 * g2 + 1]); SN1[4 * g2 + 2] = fexp2(SN1[4 * g2 + 2]); SN1[4 * g2 + 3] = fexp2(SN1[4 * g2 + 3]); } \
                  if (g < 4) asm volatile("" : "+v"(SN0)); else asm volatile("" : "+v"(SN1)); } \
      SB(); } \
    if (HASK) *(u32x4*)(lds + cur_ * 8192 + kso) = kreg; \
    if (HASN) *(u32x4*)(lds + (cur_ ^ 1) * 8192 + vso) = vreg; \
    __syncthreads(); } while (0)
  int t = 0;
  for (; t + 3 < ntiles; t += 2) { FG_STEP(SA0, SA1, SB0, SB1, t, true, true); FG_STEP(SB0, SB1, SA0, SA1, t + 1, true, true); }
  FG_STEP(SA0, SA1, SB0, SB1, t, true, false);
  FG_STEP(SB0, SB1, SA0, SA1, t + 1, false, false);
#undef KG
#undef VG
#undef FG_STEP
#undef FG_QK
#undef SB
  l_out = l_run;
}

DI void flash_dil(char* lds, int tid, const bf16_t* Qp, const bf16_t* Kp, const bf16_t* Vp, int base, int dil, int L, int i0, f32x16 (&O)[2], float& m_out, float& l_out) {
  const int lane = tid & 63, w = tid >> 6, r32 = lane & 31, h = lane >> 5;
  const int kt0 = i0 - 64;
#pragma unroll
  for (int i = 0; i < 6; ++i) { const int c = tid + 512 * i, row = c >> 3, ch = c & 7; int ik = kt0 + row; ik = ik < 0 ? 0 : (ik > L - 1 ? L - 1 : ik);
    const size_t tok = (size_t)(base + dil * ik);
    const u32x4 kreg = *(const u32x4*)(Kp + tok * 256 + ch * 8), vreg = *(const u32x4*)(Vp + tok * 256 + ch * 8);
    *(u32x4*)(lds + swz(row, ch)) = kreg;
    *(u32x4*)(lds + 49152 + (ch >> 2) * 24576 + row * 64 + (ch & 3) * 16) = vreg; }
  const int iq = i0 + 32 * w + r32;
  bf16x8 qf[4];
  { const bf16_t* qrow = Qp + (size_t)(base + dil * iq) * 256;
#pragma unroll
    for (int ks = 0; ks < 4; ++ks) qf[ks] = *(const bf16x8*)(qrow + 16 * ks + 8 * h); }
  __syncthreads();
  O[0] = zero16(); O[1] = zero16();
  float m_run = -1e30f, l_run = 0.f;
#pragma unroll 1
  for (int b = 0; b < 5; ++b) {
    const int rb = 32 * w + 32 * b;
    f32x16 S = zero16();
#pragma unroll
    for (int ks = 0; ks < 4; ++ks) { const bf16x8 kf = *(const bf16x8*)(lds + swz(rb + r32, 2 * ks + h)); S = mfma32(kf, qf[ks], S); }
#pragma unroll
    for (int r = 0; r < 16; ++r) { const int ik = kt0 + rb + crow(r, h); const int d = ik - iq; const bool v = (ik >= 0) && (ik < L) && (d <= 64) && (d >= -64); S[r] = v ? S[r] : -1e30f; }
    float mx = S[0];
#pragma unroll
    for (int r = 1; r < 16; ++r) mx = __builtin_fmaxf(mx, S[r]);
    mx = __builtin_fmaxf(mx, __shfl_xor(mx, 32));
    const float m_new = __builtin_fmaxf(m_run, mx); const float alpha = fexp2(m_run - m_new); m_run = m_new;
    float ps = 0.f;
#pragma unroll
    for (int r = 0; r < 16; ++r) { S[r] = fexp2(S[r] - m_new); ps += S[r]; }
    l_run = l_run * alpha + ps;
#pragma unroll
    for (int r = 0; r < 16; ++r) { O[0][r] *= alpha; O[1][r] *= alpha; }
#pragma unroll
    for (int sp = 0; sp < 2; ++sp) {
      u32x4 pw; pw[0] = cvtpk(S[8 * sp], S[8 * sp + 1]); pw[1] = cvtpk(S[8 * sp + 2], S[8 * sp + 3]); pw[2] = cvtpk(S[8 * sp + 4], S[8 * sp + 5]); pw[3] = cvtpk(S[8 * sp + 6], S[8 * sp + 7]);
      const bf16x8 xs = __builtin_bit_cast(bf16x8, pw);
      const int rowA = rb + 16 * sp + 4 * h;
#pragma unroll
      for (int db = 0; db < 2; ++db) { const bf16x8 vf = tr_frag(lds + 49152 + db * 24576, 64, rowA, rowA + 8, 0, lane); O[db] = mfma32(vf, xs, O[db]); }
    }
  }
  m_out = m_run; l_out = l_run;
  __syncthreads();
}

struct OneUnit { long arow; int pn;
  DI bool next(int i, pg8::Unit& u) const { if (i != 0) return false; u.pm = 0; u.pn = pn; u.arow = arow; return true; }
  DI void a_ready(const pg8::Unit&) const {}
  DI void done(const pg8::Unit&) const {} };
struct EpiP1 { static constexpr bool PERM = false, AFTER_DRAIN = true;
  int tid, tok_tile0, nt; char* ws; const float* gq; const float* gk;
  template <int AI> DI void pass(char* lds, const pg8::f32x4 (&acc)[2][2][4][2], int wr, int wc, int fr, int fq) const {
    stage_t<AI>(lds, acc, wr, wc, fr, fq, 0); __syncthreads();
    int tid = this->tid; asm volatile("" : "+v"(tid));
    const int tok0 = tok_tile0 + AI * 128;
    const char* tab = ws + WS_TAB;
    bf16_t* QA = (bf16_t*)(ws + WS_QA); bf16_t* KA = (bf16_t*)(ws + WS_KA); bf16_t* VA = (bf16_t*)(ws + WS_VA);
    bf16_t* QB = (bf16_t*)(ws + WS_QB); bf16_t* KB = (bf16_t*)(ws + WS_KB); bf16_t* VB = (bf16_t*)(ws + WS_VB); bf16_t* ZC = (bf16_t*)(ws + WS_ZC);
    for (int hf = 0; hf < 2; ++hf) { const int c128 = nt * 2 + hf;
      int kind = EPI_PLAIN; bf16_t* dst = ZC; int pitch = 512, col0 = (c128 - 12) * 128; float scale = 1.0f; const float* gain = nullptr;
      if (c128 < 2) { kind = EPI_ROPEA; dst = QA; pitch = 256; col0 = c128 * 128; scale = QSCALE; }
      else if (c128 < 4) { kind = EPI_ROPEA; dst = KA; pitch = 256; col0 = (c128 - 2) * 128; }
      else if (c128 < 6) { dst = VA; pitch = 256; col0 = (c128 - 4) * 128; }
      else if (c128 < 10) { kind = EPI_NRB; dst = QB; pitch = 512; col0 = (c128 - 6) * 128; scale = QSCALE; gain = gq; }
      else if (c128 == 10) { kind = EPI_NRB; dst = KB; pitch = 128; col0 = 0; gain = gk; }
      else if (c128 == 11) { dst = VB; pitch = 128; col0 = 0; }
      epi_rows(lds, tid, kind, tok0, hf * 128, dst, pitch, col0, scale, gain, tab); }
    __syncthreads();
  }
  DI void fused(pg8::f32x4 (&acc)[2][2][4][2], const pg8::Unit&, int wr, int wc, int fr, int fq, PG8_LAS unsigned char* lds3, int, int) const {
    char* lds = (char*)lds3; pass<0>(lds, acc, wr, wc, fr, fq); pass<1>(lds, acc, wr, wc, fr, fq); }
};
struct EpiPlain { static constexpr bool PERM = false, AFTER_DRAIN = true;
  int tid, tok_tile0, col_tile0; bf16_t* dst; const char* tab;
  template <int AI> DI void pass(char* lds, const pg8::f32x4 (&acc)[2][2][4][2], int wr, int wc, int fr, int fq) const {
    stage_t<AI>(lds, acc, wr, wc, fr, fq, 0); __syncthreads();
    int tid = this->tid; asm volatile("" : "+v"(tid));
    for (int hf = 0; hf < 2; ++hf) epi_rows(lds, tid, EPI_PLAIN, tok_tile0 + AI * 128, hf * 128, dst, DM, col_tile0 + hf * 128, 1.0f, nullptr, tab);
    __syncthreads();
  }
  DI void fused(pg8::f32x4 (&acc)[2][2][4][2], const pg8::Unit&, int wr, int wc, int fr, int fq, PG8_LAS unsigned char* lds3, int, int) const {
    char* lds = (char*)lds3; pass<0>(lds, acc, wr, wc, fr, fq); pass<1>(lds, acc, wr, wc, fr, fq); }
};
struct EpiP4 { static constexpr bool PERM = false, AFTER_DRAIN = true;
  int tid, p0, nt; const float* cw; const float* cb; bf16_t* ACT;
  template <int PS> DI void pass(char* lds, const pg8::f32x4 (&acc)[2][2][4][2], int wr, int wc, int fr, int fq) const {
    float* sCw = (float*)lds;
    stage_t<PS>(lds, acc, wr, wc, fr, fq, PS);
    if (PS == 0) { if (wr == 0 && fr == 0) {
#pragma unroll
        for (int bj = 0; bj < 2; ++bj)
#pragma unroll
          for (int n = 0; n < 2; ++n) *(pg8::f32x4*)(sCw + 128 * CST + 128 * bj + 32 * wc + 16 * n + 4 * fq) = acc[1][bj][0][n]; } }
    else { if (wr == 1 && fr == 15) {
#pragma unroll
        for (int bj = 0; bj < 2; ++bj)
#pragma unroll
          for (int n = 0; n < 2; ++n) *(pg8::f32x4*)(sCw + 128 * bj + 32 * wc + 16 * n + 4 * fq) = acc[0][bj][3][n]; } }
    __syncthreads();
    const float* sC = (const float*)lds;
    int tid = this->tid; asm volatile("" : "+v"(tid));
    const int lane = tid & 63, w = tid >> 6, jj = lane & 15; const int f0 = nt * 128 + 8 * jj;
    float c0[8], c1[8], c2[8], bb[8]; ld8(cw + f0, c0); ld8(cw + DFF + f0, c1); ld8(cw + 2 * DFF + f0, c2); ld8(cb + f0, bb);
#pragma unroll 2
    for (int ps = 0; ps < 4; ++ps) {
      const int q = ps * 32 + w * 4 + (lane >> 4);
      const int i = 1 + q;
      const int tok = p0 + 127 * PS + i;
      if (q < 127 && tok < MT) {
        const int pos = (tok < MP) ? (tok & 8191) : (tok & 4095); const int S = (tok < MP) ? 8192 : 4096;
        float gm[8], gc[8], gp[8], up[8];
        ld8(sC + (i - 1) * CST + 8 * jj, gm); ld8(sC + i * CST + 8 * jj, gc); ld8(sC + (i + 1) * CST + 8 * jj, gp); ld8(sC + i * CST + 128 + 8 * jj, up);
        if (pos - 1 < 0) {
#pragma unroll
          for (int e = 0; e < 8; ++e) gm[e] = 0.f; }
        if (pos + 1 >= S) {
#pragma unroll
          for (int e = 0; e < 8; ++e) gp[e] = 0.f; }
        float o[8];
#pragma unroll
        for (int e = 0; e < 8; e += 2) {
          const f32x2 a = {gm[e], gm[e + 1]}, b = {gc[e], gc[e + 1]}, c = {gp[e], gp[e + 1]};
          const f32x2 k0 = {c0[e], c0[e + 1]}, k1 = {c1[e], c1[e + 1]}, k2 = {c2[e], c2[e + 1]}, kb = {bb[e], bb[e + 1]}, uu = {up[e], up[e + 1]};
          const f32x2 x = k0 * a + (k1 * b + (k2 * c + kb));
          const f32x2 u = x * x;
          const f32x2 t = x * (u * -0.1029432397f + -2.302208198f);
          f32x2 d; d.x = fexp2(t.x); d.y = fexp2(t.y); d = d + 1.0f;
          f32x2 r; r.x = __builtin_amdgcn_rcpf(d.x); r.y = __builtin_amdgcn_rcpf(d.y);
          const f32x2 y = (x * r) * uu;
          o[e] = y.x; o[e + 1] = y.y; }
        *(u32x4*)(ACT + (size_t)tok * DFF + f0) = pack8(o);
      }
    }
    __syncthreads();
  }
  DI void fused(pg8::f32x4 (&acc)[2][2][4][2], const pg8::Unit&, int wr, int wc, int fr, int fq, PG8_LAS unsigned char* lds3, int, int) const {
    char* lds = (char*)lds3; pass<0>(lds, acc, wr, wc, fr, fq); pass<1>(lds, acc, wr, wc, fr, fq); }
};

#define XB_TMO      128
#define XB_XCNT(j)  (256  + 64 * (j))
#define XB_XSUB(j)  (1280 + 64 * (j))
#define XB_XGEN(j)  (2304 + 64 * (j))
#define XB_TOP      3328
#define XB_TOPGEN   3392
#define XCD_BAR_WORDS 3456
#define XB_SPIN_CAP (1u << 22)

__device__ __forceinline__ unsigned xb_ld(unsigned* p)              { return __hip_atomic_load(p, __ATOMIC_RELAXED, __HIP_MEMORY_SCOPE_AGENT); }
__device__ __forceinline__ unsigned xb_add(unsigned* p, unsigned v) { return __hip_atomic_fetch_add(p, v, __ATOMIC_RELAXED, __HIP_MEMORY_SCOPE_AGENT); }
__device__ __forceinline__ unsigned xb_xcc_id() { return (unsigned)__builtin_amdgcn_s_getreg((3 << 11) | 20) & 0xFu; }
#define XB_SPIN(cond, bar) do { unsigned _sp = 0; while (cond) { __builtin_amdgcn_s_sleep(1); \
    if ((++_sp & 255u) == 0u) { if (xb_ld(&(bar)[XB_TMO])) break; if (_sp > XB_SPIN_CAP) { atomicAdd(&(bar)[XB_TMO], 1u); break; } } } } while (0)

struct XcdBarrier {
    unsigned* bar; unsigned x;
    volatile __attribute__((address_space(3))) unsigned* st;
};

__device__ __forceinline__ XcdBarrier xcd_barrier_post(unsigned* bar, volatile __attribute__((address_space(3))) unsigned* st) {
    XcdBarrier b; b.bar = bar; b.x = xb_xcc_id(); b.st = st;
    if (threadIdx.x == 0) (void)xb_add(&bar[XB_XCNT(b.x)], 1u);
    return b;
}
__device__ __forceinline__ void xcd_barrier_complete(unsigned* bar, unsigned x, unsigned& nloc, unsigned& nx) {
    const unsigned G = gridDim.x * gridDim.y * gridDim.z;
    unsigned sum, cnt, mine, sp = 0u;
    for (;;) {
        sum = 0u; cnt = 0u; mine = 0u;
#pragma unroll
        for (unsigned j = 0; j < 16; ++j) { const unsigned c = xb_ld(&bar[XB_XCNT(j)]); sum += c; cnt += (c > 0u) ? 1u : 0u; mine = (j == x) ? c : mine; }
        if (sum == G) break;
        __builtin_amdgcn_s_sleep(1);
        if ((++sp & 255u) == 0u) { if (xb_ld(&bar[XB_TMO])) break; if (sp > XB_SPIN_CAP) { atomicAdd(&bar[XB_TMO], 1u); break; } }
    }
    nloc = mine > 0u ? mine : 1u; nx = cnt > 0u ? cnt : 1u;
}

__device__ __forceinline__ void xcd_barrier(const XcdBarrier& b) {
    asm volatile("s_waitcnt vmcnt(0)" ::: "memory");
    __syncthreads();
    if (threadIdx.x == 0) {
        unsigned* bar = b.bar;
        __builtin_amdgcn_s_waitcnt(0);
        unsigned nloc = b.st[0], nx = b.st[1];
        if (nloc == 0u) { xcd_barrier_complete(bar, b.x, nloc, nx); b.st[0] = nloc; b.st[1] = nx; }
        const unsigned old = xb_add(&bar[XB_XSUB(b.x)], 1u);
        const unsigned gen = old / nloc;
        if (old + 1u == (gen + 1u) * nloc) {
            __builtin_amdgcn_fence(__ATOMIC_RELEASE, "agent");
            asm volatile("s_waitcnt vmcnt(0)" ::: "memory");
            const unsigned og = xb_add(&bar[XB_TOP], 1u);
            const unsigned tg = og / nx;
            if (og + 1u == (tg + 1u) * nx) xb_add(&bar[XB_TOPGEN], 1u);
            else XB_SPIN(xb_ld(&bar[XB_TOPGEN]) == tg, bar);
            __builtin_amdgcn_fence(__ATOMIC_ACQUIRE, "agent");
            xb_add(&bar[XB_XGEN(b.x)], 1u);
            asm volatile("s_waitcnt vmcnt(0)" ::: "memory");
        } else {
            XB_SPIN(xb_ld(&bar[XB_XGEN(b.x)]) == gen, bar);
            __builtin_amdgcn_fence(__ATOMIC_ACQUIRE, "agent");
            asm volatile("s_waitcnt vmcnt(0)" ::: "memory");
        }
    }
    __syncthreads();
}

DI bool tile_map(int round, int blk, int MTn, int NTn, int gm, int gn, int& mt, int& nt) {
  const int xcd = blk & 7, slot = blk >> 3, ngn = NTn / gn;
  const int gidx = round * 8 + xcd, mg = gidx / ngn, ng = gidx % ngn;
  mt = mg * gm + slot / gn; nt = ng * gn + slot % gn;
  return mt < MTn;
}
__global__ void __launch_bounds__(NTHREADS, 2) mega(Params p) {
  __shared__ __attribute__((aligned(16))) char lds[LDS_BYTES];
  __shared__ int s_item;
  __shared__ unsigned s_xb[2];
  const int nblk = gridDim.x, blk = blockIdx.x;
  if (threadIdx.x < 2) s_xb[threadIdx.x] = 0u;
  __syncthreads();
  const XcdBarrier xbar = xcd_barrier_post((unsigned*)(p.ws + WS_CTL) + 4096, (volatile __attribute__((address_space(3))) unsigned*)s_xb);
  for (int step = p.plo; step <= p.phi; ++step) {
  const int ph = p.seq[step];
  int tid = threadIdx.x; asm volatile("" : "+v"(tid));
  const int lane = tid & 63, w = tid >> 6, r32 = lane & 31, h = lane >> 5;
  size_t zoff = 0; asm volatile("" : "+s"(zoff));
  char* ws = p.ws + zoff;
  const char* tab = ws + WS_TAB;
  bf16_t* XN = (bf16_t*)(ws + WS_XN); bf16_t* OB = (bf16_t*)(ws + WS_O);
  bf16_t* QA = (bf16_t*)(ws + WS_QA); bf16_t* KA = (bf16_t*)(ws + WS_KA); bf16_t* VA = (bf16_t*)(ws + WS_VA);
  bf16_t* QB = (bf16_t*)(ws + WS_QB); bf16_t* KB = (bf16_t*)(ws + WS_KB); bf16_t* VB = (bf16_t*)(ws + WS_VB);
  bf16_t* ZC = (bf16_t*)(ws + WS_ZC); bf16_t* BF = (bf16_t*)(ws + WS_BF); bf16_t* PART = (bf16_t*)(ws + WS_PART); float* LSE = (float*)(ws + WS_LSE);
  bf16_t* MIX = (bf16_t*)(ws + WS_MIX); bf16_t* ACT = (bf16_t*)(ws + WS_ACT); bf16_t* FF = (bf16_t*)(ws + WS_FF); float* RS = (float*)(ws + WS_RS);
  unsigned* ctl = (unsigned*)(ws + WS_CTL);
  {
    if (ph == 0) { if (PHEN(0)) {
      const int gt = blk * NTHREADS + tid, gn = nblk * NTHREADS;
      for (int i = gt; i < 8192 * 8; i += gn) { const int pos = i >> 3, f = i & 7;
        const float inv[8] = {1.0f, 0.1939227432012558f, 0.03760603070259094f, 0.007292664609849453f, 0.0014142135623842478f, 0.00027424818836152554f, 5.3182957344688475e-05f, 1.0313385246263351e-05f};
        float iv = inv[0];
#pragma unroll
        for (int q = 1; q < 8; ++q) iv = (f == q) ? inv[q] : iv;
        const float ang = (float)pos * iv; float s, c; sincos_d((double)ang, s, c);
        ((float*)(tab + T_ROPET_C))[i] = c; ((float*)(tab + T_ROPET_S))[i] = s; }
      for (int i = gt; i < 192 * 16; i += gn) { const int pr = i >> 4, f = i & 15;
        const float inv[16] = {1.0f, 0.5623413324356079f, 0.3162277638912201f, 0.17782793939113617f, 0.10000000149011612f, 0.05623413249850273f, 0.03162277489900589f, 0.017782794311642647f,
                               0.009999999776482582f, 0.005623413249850273f, 0.003162277629598975f, 0.0017782794311642647f, 0.0010000000474974513f, 0.000562341301701963f, 0.0003162277571391314f, 0.00017782794020604342f};
        float iv = inv[0];
#pragma unroll
        for (int q = 1; q < 16; ++q) iv = (f == q) ? inv[q] : iv;
        const int pos = pr < 128 ? pr : pr - 128; const float ang = (float)pos * iv; float s, c; sincos_d((double)ang, s, c);
        if (pr < 128) { ((float*)(tab + T_ROPER_C))[pos * 16 + f] = c; ((float*)(tab + T_ROPER_S))[pos * 16 + f] = s; }
        else { ((float*)(tab + T_ROPEC_C))[pos * 16 + f] = c; ((float*)(tab + T_ROPEC_S))[pos * 16 + f] = s; } }
      for (int i = gt; i < 8192; i += gn) { float s, c; sincos_d(6.283185307179586476925286766559 * (double)i / 8192.0, s, c); ((float*)(tab + T_TW_C))[i] = c; ((float*)(tab + T_TW_S))[i] = s; }
      for (int i = gt; i < 128 * 128; i += gn) { const int a = i >> 7, b = i & 127; float s, c; sincos_d(6.283185307179586476925286766559 * (double)((a * b) & 127) / 128.0, s, c);
        ((bf16_t*)(tab + T_C128))[i] = (bf16_t)cvtpk(c, 0.f); ((bf16_t*)(tab + T_S128))[i] = (bf16_t)cvtpk(s, 0.f); }
      for (int i = gt; i < 64 * 64; i += gn) { const int a = i >> 6, b = i & 63; float s, c; sincos_d(6.283185307179586476925286766559 * (double)((a * b) & 63) / 64.0, s, c);
        ((bf16_t*)(tab + T_C64))[i] = (bf16_t)cvtpk(c, 0.f); ((bf16_t*)(tab + T_S64))[i] = (bf16_t)cvtpk(s, 0.f); }
      for (int i = gt; i < 32 * 32; i += gn) { const int a = i >> 5, b = i & 31; float s, c; sincos_d(6.283185307179586476925286766559 * (double)((a * b) & 31) / 32.0, s, c);
        ((bf16_t*)(tab + T_C32))[i] = (bf16_t)cvtpk(c, 0.f); ((bf16_t*)(tab + T_S32))[i] = (bf16_t)cvtpk(s, 0.f); }
      float* tl = (float*)lds;
      float* ctab = tl + 64 * 65;
      for (int it = blk; it < 2 * 3776; it += nblk) {
        const int l = it / 3776; int r = it % 3776;
        int mat, kt_, nt_;
        if (r < 384) { mat = 0; kt_ = r / 24; nt_ = r % 24; }
        else if (r < 640) { r -= 384; mat = 1; kt_ = r / 16; nt_ = r % 16; }
        else if (r < 1664) { r -= 640; mat = 2; kt_ = r / 64; nt_ = r % 64; }
        else if (r < 2688) { r -= 1664; mat = 3; kt_ = r / 64; nt_ = r % 64; }
        else if (r < 3712) { r -= 2688; mat = 4; kt_ = r / 16; nt_ = r % 16; }
        else { r -= 3712; mat = 5; kt_ = r / 4; nt_ = r % 4; }
        const float* src; int ld; const float* gain; bf16_t* dst; int dld;
        char* wl = ws + WS_W + (size_t)l * W_LAYER;
        int scol0 = nt_ * 64;
        if (mat == 0) { src = p.w_in + (size_t)l * DM * 1792; ld = 1792; gain = p.g_mix_pre + l * DM; dst = (bf16_t*)(wl + W_IN); dld = DM; }
        else if (mat == 1) { src = p.w_out + (size_t)l * DM * DM; ld = DM; gain = p.g_heads + l * DM; dst = (bf16_t*)(wl + W_OUT); dld = DM; }
        else if (mat == 2) { src = p.w_gate + (size_t)l * DM * DFF; ld = DFF; gain = p.g_ffn_pre + l * DM; dst = (bf16_t*)(wl + W_GU); dld = DM; }
        else if (mat == 3) { src = p.w_up + (size_t)l * DM * DFF; ld = DFF; gain = p.g_ffn_pre + l * DM; dst = (bf16_t*)(wl + W_GU); dld = DM; }
        else if (mat == 4) { src = p.w_down + (size_t)l * DFF * DM; ld = DM; gain = nullptr; dst = (bf16_t*)(wl + W_DOWN); dld = DFF; }
        else { src = p.w_in + (size_t)l * DM * 1792; ld = 1792; gain = p.g_mix_pre + l * DM; dst = (bf16_t*)(wl + W_IN); dld = DM; scol0 = 1536 + nt_ * 64; }
        const int k0 = kt_ * 64;
#pragma unroll
        for (int i = 0; i < 2; ++i) { const int kk = (tid >> 4) + 32 * i, n4 = (tid & 15) * 4; const f32x4 v = *(const f32x4*)(src + (size_t)(k0 + kk) * ld + scol0 + n4);
          tl[kk * 65 + n4] = v[0]; tl[kk * 65 + n4 + 1] = v[1]; tl[kk * 65 + n4 + 2] = v[2]; tl[kk * 65 + n4 + 3] = v[3]; }
        if (mat == 5 && tid < 64) { float s, c; sincos_d(6.283185307179586476925286766559 * (double)tid / 64.0, s, c); ctab[tid] = c; ctab[64 + tid] = s; }
        __syncthreads();
        if (mat != 5) {
          { const int nn = tid >> 3, k8 = (tid & 7) * 8;
            float v[8];
#pragma unroll
            for (int e = 0; e < 8; ++e) v[e] = tl[(k8 + e) * 65 + nn] * (gain ? gain[k0 + k8 + e] : 1.0f);
            int drow = nt_ * 64 + nn;
            if (mat == 2) drow = (nt_ >> 1) * 256 + (nt_ & 1) * 64 + nn; else if (mat == 3) drow = (nt_ >> 1) * 256 + 128 + (nt_ & 1) * 64 + nn;
            *(u32x4*)(dst + (size_t)drow * dld + k0 + k8) = pack8(v); }
        } else {
          for (int i = 0; i < 16; ++i) { const int idx = tid + 512 * i, np = idx >> 6, kk = idx & 63;
            const int ri = np >> 6, cp = np & 63; float a = 0.f;
            for (int c = 0; c < 64; ++c) { const int m = (c * cp) & 63; const float t = ri ? -ctab[64 + m] : ctab[m]; a += tl[kk * 65 + c] * t; }
            dst[(size_t)(1536 + nt_ * 128 + np) * dld + k0 + kk] = (bf16_t)cvtpk(a * gain[k0 + kk], 0.f); }
        }
        __syncthreads();
      }
#pragma unroll 2
      for (int row = blk * 8 + w; row < MT; row += nblk * 8) {
        const float* xr = row < MP ? p.x_prompt + (size_t)row * DM : p.x_sample + (size_t)(row - MP) * DM;
        rowpass(lane, nullptr, 0.f, xr, nullptr, nullptr, nullptr, XN + (size_t)row * DM, RS + row);
      }
    } } else {
      const int l = (ph - 1) >> 3, sub = (ph - 1) & 7;
      char* wl = ws + WS_W + (size_t)l * W_LAYER;
      if (sub == 0 && PHEN(1)) {
        const bf16_t* Bt = (const bf16_t*)(wl + W_IN);
        for (int vr = blk; vr < 256 * 10; vr += nblk) { const int rnd = vr >> 8, vb = vr & 255;
          int mt, nt; if (!tile_map(rnd, vb, 320, 8, 4, 8, mt, nt)) continue;
          const pg8::Gemm g{XN, Bt, MT, NIN, DM};
          const OneUnit S1{(long)mt * 256, nt};
          const EpiP1 E{tid, mt * 256, nt, ws, p.g_q + l * 64, p.g_k + l * 64};
          pg8::gemm_phase<EpiP1, OneUnit, false, true>((PG8_LAS unsigned char*)lds, g, S1, E);
        }
      } else if (sub == 1 && PHEN(2)) {
        unsigned* ctr = ctl + 64 * (1 + step);
        for (;;) {
          if (tid == 0) s_item = (int)atomicAdd(ctr, 1u);
          __syncthreads();
          const int it = s_item;
          __syncthreads();
          if (it >= 8960) break;
          int tid_item = tid; asm volatile("" : "+v"(tid_item));
          { const int tid = tid_item, lane = tid & 63, w = tid >> 6, r32 = lane & 31, h = lane >> 5;
          if (it < 2560) {
            int seq, kvh, qblk, rh;
            if (it < 2048) { const int combo = it >> 7, wi = it & 127; seq = combo >> 1; kvh = combo & 1; qblk = wi >> 2; rh = wi & 3; }
            else { const int i2 = it - 2048; const int combo = i2 >> 6, wi = i2 & 63; seq = 8 + (combo >> 1); kvh = combo & 1; qblk = wi >> 2; rh = wi & 3; }
            int base, S; seq_info(seq, base, S);
            const int hq = kvh * 4 + rh;
            f32x16 O[2]; float m_run, l_run;
            float gk = __builtin_fabsf(p.g_k[l * 64 + lane]);
#pragma unroll
            for (int o = 32; o >= 1; o >>= 1) gk = __builtin_fmaxf(gk, __shfl_xor(gk, o));
            flash_grid(lds, tid, QB + hq * 64, KB + kvh * 64, VB + kvh * 64, base, qblk * 256, S >> 6, gk * 8.0f * 1.01f, O, l_run); m_run = 0.f;
            const float lt = l_run + __shfl_xor(l_run, 32); const float inv = 1.0f / lt;
            float ss = 0.f;
#pragma unroll
            for (int r = 0; r < 16; ++r) { O[0][r] *= inv; O[1][r] *= inv; ss += O[0][r] * O[0][r] + O[1][r] * O[1][r]; }
            ss += __shfl_xor(ss, 32);
            const float rr = rsqrtf(ss * (1.0f / 64.0f) + EPS);
            const int tok = base + qblk * 256 + 32 * w + r32;
            bf16_t* orow = OB + (size_t)tok * DM + 256 + hq * 64;
#pragma unroll
            for (int db = 0; db < 2; ++db)
#pragma unroll
              for (int g4 = 0; g4 < 4; ++g4) { u32x2 wv; wv[0] = cvtpk(O[db][4 * g4] * rr, O[db][4 * g4 + 1] * rr); wv[1] = cvtpk(O[db][4 * g4 + 2] * rr, O[db][4 * g4 + 3] * rr);
                *(u32x2*)(orow + 32 * db + 8 * g4 + 4 * h) = wv; }
          } else if (it < 6400) {
            const int i2 = it - 2560; const int pat = i2 / 1280; const int rem = i2 % 1280; const int head = rem & 3; const int tb = rem >> 2;
            int seq, ub; if (tb < 256) { seq = tb >> 5; ub = tb & 31; } else { seq = 8 + ((tb - 256) >> 4); ub = (tb - 256) & 15; }
            int base, S; seq_info(seq, base, S);
            const int dil = pat == 0 ? 1 : (pat == 1 ? 4 : 16); const int L = S / dil;
            const int u0 = ub * 256; const int res = u0 / L; const int i0 = u0 % L;
            f32x16 O[2]; float m_run, l_run;
            flash_dil(lds, tid, QA + head * 64, KA + head * 64, VA + head * 64, base + res, dil, L, i0, O, m_run, l_run);
            const float lt = l_run + __shfl_xor(l_run, 32); const float inv = 1.0f / lt;
            const int tok = base + res + dil * (i0 + 32 * w + r32);
            bf16_t* orow = PART + ((size_t)pat * MT + tok) * 256 + head * 64;
#pragma unroll
            for (int db = 0; db < 2; ++db)
#pragma unroll
              for (int g4 = 0; g4 < 4; ++g4) { u32x2 wv; wv[0] = cvtpk(O[db][4 * g4] * inv, O[db][4 * g4 + 1] * inv); wv[1] = cvtpk(O[db][4 * g4 + 2] * inv, O[db][4 * g4 + 3] * inv);
                *(u32x2*)(orow + 32 * db + 8 * g4 + 4 * h) = wv; }
            if (h == 0) LSE[((size_t)pat * MT + tok) * 4 + head] = m_run + __log2f(lt);
          } else {
            const int i2 = it - 6400; const int g = i2 & 3; const int mt = i2 >> 2;
            int seq, s2, S2; if (mt < 512) { seq = mt >> 6; s2 = mt & 63; S2 = 64; } else { seq = 8 + ((mt - 512) >> 5); s2 = (mt - 512) & 31; S2 = 32; }
            int base, S; seq_info(seq, base, S);
#pragma unroll
            for (int i = 0; i < 4; ++i) { const int c = tid + 512 * i, row = c >> 4, ch = c & 15;
              *(u32x4*)(lds + row * 320 + ch * 16) = *(const u32x4*)(ZC + (size_t)(base + S2 * row + s2) * 512 + g * 128 + ch * 8); }
            __syncthreads();
            const int kb1 = w & 3, nb = w >> 2;
            f32x16 Ar = zero16(), Ai = zero16();
            const bf16_t* C1 = (const bf16_t*)(tab + T_C128) + (32 * kb1 + r32) * 128 + 8 * h; const bf16_t* S1t = (const bf16_t*)(tab + T_S128) + (32 * kb1 + r32) * 128 + 8 * h;
#pragma unroll
            for (int ks = 0; ks < 8; ++ks) {
              const bf16x8 aC = *(const bf16x8*)(C1 + 16 * ks), aS = *(const bf16x8*)(S1t + 16 * ks);
              const int rowA = 16 * ks + 8 * h;
              const bf16x8 zr = tr_frag(lds, 320, rowA, rowA + 4, nb * 32, lane), zi = tr_frag(lds, 320, rowA, rowA + 4, 64 + nb * 32, lane);
              const bf16x8 zrn = zr ^ (short)0x8000;
              Ar = mfma32(aC, zr, Ar); Ar = mfma32(aS, zi, Ar);
              Ai = mfma32(aC, zi, Ai); Ai = mfma32(aS, zrn, Ai);
            }
            const int twm = 8192 / S;
#pragma unroll
            for (int r = 0; r < 16; ++r) { const int k1 = 32 * kb1 + crow(r, h); const int ai = ((k1 * s2) & (S - 1)) * twm;
              const float cs = ((const float*)(tab + T_TW_C))[ai], sn = ((const float*)(tab + T_TW_S))[ai];
              bf16_t* orow = BF + (size_t)(base + k1 * S2 + s2) * 512 + g * 128;
              const float br = Ar[r] * cs + Ai[r] * sn, bi = Ai[r] * cs - Ar[r] * sn;
              orow[nb * 32 + r32] = (bf16_t)cvtpk(br, 0.f); orow[64 + nb * 32 + r32] = (bf16_t)cvtpk(bi, 0.f); }
            __syncthreads();
          }
          }
        }
      } else if (sub == 2 && PHEN(3)) {
        for (int it = blk; it < 1536 + 1280; it += nblk) {
          if (it < 1536) {
            int seq, kq, g, S2;
            if (it < 1024) { seq = it >> 7; kq = (it >> 2) & 31; g = it & 3; S2 = 64; } else { const int i2 = it - 1024; seq = 8 + (i2 >> 7); kq = (i2 >> 2) & 31; g = i2 & 3; S2 = 32; }
            int base, S; seq_info(seq, base, S);
            const int nch = 4 * S2 * 16;
            for (int c = tid; c < nch; c += 512) { const int sb = c / (S2 * 16), rc = c % (S2 * 16), row = rc >> 4, ch = rc & 15;
              *(u32x4*)(lds + sb * 20480 + row * 320 + ch * 16) = *(const u32x4*)(BF + (size_t)(base + (4 * kq + sb) * S2 + row) * 512 + g * 128 + ch * 8); }
            __syncthreads();
            const bool act = (S2 == 64) || (w < 4);
            if (act) {
              const int sb = (S2 == 64) ? (w >> 1) : w, mb = (S2 == 64) ? (w & 1) : 0;
              const char* tile = lds + sb * 20480;
              const bf16_t* Ct = (const bf16_t*)(tab + (S2 == 64 ? T_C64 : T_C32)) + (32 * mb + r32) * S2 + 8 * h;
              const bf16_t* St = (const bf16_t*)(tab + (S2 == 64 ? T_S64 : T_S32)) + (32 * mb + r32) * S2 + 8 * h;
              f32x16 Y[2]; Y[0] = zero16(); Y[1] = zero16();
              const int nks = S2 >> 4;
              for (int ks = 0; ks < nks; ++ks) {
                const bf16x8 aC = *(const bf16x8*)(Ct + 16 * ks), aS = *(const bf16x8*)(St + 16 * ks);
                const int rowA = 16 * ks + 8 * h;
#pragma unroll
                for (int nb = 0; nb < 2; ++nb) { const bf16x8 br = tr_frag(tile, 320, rowA, rowA + 4, nb * 32, lane), bi = tr_frag(tile, 320, rowA, rowA + 4, 64 + nb * 32, lane);
                  Y[nb] = mfma32(aC, br, Y[nb]); Y[nb] = mfma32(aS, bi, Y[nb]); }
              }
              const int k1 = 4 * kq + sb;
#pragma unroll
              for (int r = 0; r < 16; ++r) { float ss = Y[0][r] * Y[0][r] + Y[1][r] * Y[1][r];
                ss += __shfl_xor(ss, 1); ss += __shfl_xor(ss, 2); ss += __shfl_xor(ss, 4); ss += __shfl_xor(ss, 8); ss += __shfl_xor(ss, 16);
                const float rr = rsqrtf(ss * (1.0f / 64.0f) + EPS);
                const int tok = base + k1 + 128 * (32 * mb + crow(r, h));
                bf16_t* orow = OB + (size_t)tok * DM + 768 + g * 64;
                orow[r32] = (bf16_t)cvtpk(Y[0][r] * rr, 0.f); orow[32 + r32] = (bf16_t)cvtpk(Y[1][r] * rr, 0.f); }
            }
            __syncthreads();
          } else {
            const int t0 = (it - 1536) * 64;
            for (int pp = 0; pp < 4; ++pp) { const int idx = pp * 512 + tid; const int tok = t0 + (idx >> 5), head = (idx >> 3) & 3, dch = idx & 7;
              float ls[3]; u32x4 pv[3];
#pragma unroll
              for (int q = 0; q < 3; ++q) { ls[q] = LSE[((size_t)q * MT + tok) * 4 + head]; pv[q] = *(const u32x4*)(PART + ((size_t)q * MT + tok) * 256 + head * 64 + dch * 8); }
              const float mx = fmaxf(ls[0], fmaxf(ls[1], ls[2]));
              float wq[3]; float wsum = 0.f;
#pragma unroll
              for (int q = 0; q < 3; ++q) { wq[q] = fexp2(ls[q] - mx); wsum += wq[q]; }
              const float iw = 1.0f / wsum;
              float o[8];
#pragma unroll
              for (int e = 0; e < 8; ++e) o[e] = 0.f;
#pragma unroll
              for (int q = 0; q < 3; ++q) { const float ww = wq[q] * iw;
#pragma unroll
                for (int e2 = 0; e2 < 4; ++e2) { o[2 * e2] += ww * bflo(pv[q][e2]); o[2 * e2 + 1] += ww * bfhi(pv[q][e2]); } }
              float ss = 0.f;
#pragma unroll
              for (int e = 0; e < 8; ++e) ss += o[e] * o[e];
              ss += __shfl_xor(ss, 1); ss += __shfl_xor(ss, 2); ss += __shfl_xor(ss, 4);
              const float rr = rsqrtf(ss * (1.0f / 64.0f) + EPS);
#pragma unroll
              for (int e = 0; e < 8; ++e) o[e] *= rr;
              *(u32x4*)(OB + (size_t)tok * DM + head * 64 + dch * 8) = pack8(o); }
          }
        }
      } else if ((sub == 3 || sub == 6) && PHEN(4)) {
        const bf16_t* A = (sub == 3) ? OB : ACT; const int K = (sub == 3) ? DM : DFF;
        const bf16_t* Bt = (const bf16_t*)(wl + (sub == 3 ? W_OUT : W_DOWN));
        bf16_t* dst = (sub == 3) ? MIX : FF;
        for (int vr = blk; vr < 256 * 5; vr += nblk) { const int rnd = vr >> 8, vb = vr & 255;
          int mt, nt; if (!tile_map(rnd, vb, 320, 4, 8, 4, mt, nt)) continue;
          const pg8::Gemm g{A, Bt, MT, DM, K};
          const OneUnit S1{(long)mt * 256, nt};
          const EpiPlain E{tid, mt * 256, nt * 256, dst, tab};
          pg8::gemm_phase<EpiPlain, OneUnit, false, true>((PG8_LAS unsigned char*)lds, g, S1, E);
        }
      } else if ((sub == 4 || sub == 7) && PHEN(5)) {
        const bool first = (sub == 4);
        const float* gpost = (first ? p.g_mix_post : p.g_ffn_post) + l * DM;
        const bf16_t* add = first ? MIX : FF;
        const bool need_xn = !(l == 1 && sub == 7);
#pragma unroll 4
      for (int row = blk * 8 + w; row < MT; row += nblk * 8) {
          const bool last = (l == 1 && sub == 7);
          rowpass(lane, XN + (size_t)row * DM, RS[row], nullptr, add + (size_t)row * DM, gpost, last ? p.out + (size_t)row * DM : nullptr, last ? nullptr : XN + (size_t)row * DM, RS + row);
        }
      } else if (sub == 5 && PHEN(6)) {
        const bf16_t* Bt = (const bf16_t*)(wl + W_GU);
        const float* cw = p.conv_w + (size_t)l * 3 * DFF; const float* cb = p.conv_b + (size_t)l * DFF;
        for (int vr = blk; vr < 256 * 41; vr += nblk) { const int rnd = vr >> 8, vb = vr & 255;
          int mt, nt; if (!tile_map(rnd, vb, 323, 32, 4, 8, mt, nt)) continue;
          const int p0 = 254 * mt - 1;
          const pg8::Gemm g{XN, Bt, MT, 2 * DFF, DM};
          const OneUnit S1{(long)p0, nt};
          const EpiP4 E{tid, p0, nt, cw, cb, ACT};
          pg8::gemm_phase<EpiP4, OneUnit, false, true>((PG8_LAS unsigned char*)lds, g, S1, E);
        }
      }
    }
  }
    if (step < p.phi) { if (step == p.plo) cg::this_grid().sync(); else xcd_barrier(xbar); }
  }
}

extern "C" void kernel_launch(void* const* d_in, const int* in_sizes, int n_in, void* d_out, int out_size, void* d_ws, size_t ws_size, hipStream_t stream) {
  (void)in_sizes; (void)n_in; (void)out_size; (void)ws_size;
  static int grid_blocks = 0;
  if (!grid_blocks) {
    int dev = 0, cus = 0, per_cu = 0;
    hipGetDevice(&dev);
    hipDeviceGetAttribute(&cus, hipDeviceAttributeMultiprocessorCount, dev);
    hipOccupancyMaxActiveBlocksPerMultiprocessor(&per_cu, mega, NTHREADS, 0);
    if (per_cu > 1) per_cu = 1;
    if (per_cu < 1) per_cu = 1;
    grid_blocks = cus * per_cu; if (grid_blocks > 256) grid_blocks = 256;
  }
  Params p{};
  p.x_prompt = (const float*)d_in[0]; p.x_sample = (const float*)d_in[1];
  p.g_mix_pre = (const float*)d_in[2]; p.g_mix_post = (const float*)d_in[3]; p.w_in = (const float*)d_in[4]; p.g_q = (const float*)d_in[5]; p.g_k = (const float*)d_in[6];
  p.g_heads = (const float*)d_in[7]; p.w_out = (const float*)d_in[8]; p.g_ffn_pre = (const float*)d_in[9]; p.g_ffn_post = (const float*)d_in[10];
  p.w_gate = (const float*)d_in[11]; p.w_up = (const float*)d_in[12]; p.conv_w = (const float*)d_in[13]; p.conv_b = (const float*)d_in[14]; p.w_down = (const float*)d_in[15];
  p.out = (float*)d_out; p.ws = (char*)d_ws;
  hipMemsetAsync(d_ws, 0, 65536, stream);
#if MULTI_LAUNCH
  for (int ph = 0; ph <= 16; ++ph) p.seq[ph] = ph;
  for (int ph = 0; ph <= 16; ++ph) { p.plo = ph; p.phi = ph; hipLaunchKernelGGL(mega, dim3(grid_blocks), dim3(NTHREADS), 0, stream, p); }
#else
  int ns = 0;
  for (int ph = 0; ph <= 16; ++ph) { p.seq[ns++] = ph; if (ph >= 1 && ((ph - 1) & 7) == DUPSUB) p.seq[ns++] = ph; if (ph == DUPPH) p.seq[ns++] = ph; }
  p.plo = 0; p.phi = ns - 1;
  void* args[] = {&p};
  hipError_t e = hipLaunchCooperativeKernel((void*)mega, dim3(grid_blocks), dim3(NTHREADS), args, 0, stream);
  if (e != hipSuccess) fprintf(stderr, "cooperative launch failed: %s (grid %d)\n", hipGetErrorString(e), grid_blocks);
#endif
}
```

```cpp
#include <hip/hip_runtime.h>
#include <hip/hip_cooperative_groups.h>
#include <cstdio>
#include <cstdint>
namespace cg = cooperative_groups;

#define DI __device__ __forceinline__
typedef unsigned short bf16_t;
typedef short bf16x8 __attribute__((ext_vector_type(8)));
typedef short s16x4 __attribute__((ext_vector_type(4)));
typedef float f32x16 __attribute__((ext_vector_type(16)));
typedef float f32x4 __attribute__((ext_vector_type(4)));
typedef float f32x2 __attribute__((ext_vector_type(2)));
typedef unsigned u32x4 __attribute__((ext_vector_type(4)));
typedef unsigned u32x2 __attribute__((ext_vector_type(2)));
typedef __bf16 bf16x2_t __attribute__((ext_vector_type(2)));
typedef short v4i16_t __attribute__((ext_vector_type(4)));

#ifndef USE_TR
#define USE_TR 1
#endif
#ifndef PHMASK
#define PHMASK 0x1ff
#endif
#define PHEN(b) ((PHMASK>>(b))&1)
#ifndef DUPSUB
#define DUPSUB -1
#endif
#ifndef DUPPH
#define DUPPH -1
#endif
#ifndef MULTI_LAUNCH
#define MULTI_LAUNCH 0
#endif

constexpr int DM = 1024, DFF = 4096;
constexpr int MP = 65536, MS = 16384, MT = MP + MS;
constexpr int NIN = 1792;
constexpr float EPS = 1e-6f;
constexpr float QSCALE = 0.125f * 1.4426950408889634f;
constexpr int NTHREADS = 512;
constexpr int CST = 260;
constexpr int LDS_BYTES = 129 * CST * 4;

constexpr size_t MiB = 1ull << 20;
constexpr size_t WS_CTL = 0;
constexpr size_t WS_TAB = 1 * MiB;
constexpr size_t WS_W = 4 * MiB;
constexpr size_t W_LAYER = 30 * MiB, W_IN = 0, W_OUT = 4 * MiB, W_GU = 6 * MiB, W_DOWN = 22 * MiB;
constexpr size_t WS_XN = 64 * MiB;
constexpr size_t WS_O = 224 * MiB;
constexpr size_t WS_QA = 384 * MiB, WS_KA = 424 * MiB, WS_VA = 464 * MiB, WS_QB = 504 * MiB, WS_KB = 584 * MiB, WS_VB = 604 * MiB;
constexpr size_t WS_ZC = 624 * MiB, WS_BF = 704 * MiB, WS_PART = 784 * MiB, WS_LSE = 904 * MiB;
constexpr size_t WS_MIX = 384 * MiB;
constexpr size_t WS_ACT = 224 * MiB;
constexpr size_t WS_FF = 864 * MiB;
constexpr size_t WS_RS = 3 * MiB;
constexpr size_t WS_END = 1024 * MiB;
constexpr size_t T_ROPET_C = 0, T_ROPET_S = 256 * 1024;
constexpr size_t T_ROPER_C = 512 * 1024, T_ROPER_S = T_ROPER_C + 8192;
constexpr size_t T_ROPEC_C = T_ROPER_S + 8192, T_ROPEC_S = T_ROPEC_C + 4096;
constexpr size_t T_TW_C = 640 * 1024, T_TW_S = T_TW_C + 32768;
constexpr size_t T_C128 = 768 * 1024, T_S128 = T_C128 + 32768;
constexpr size_t T_C64 = T_S128 + 32768, T_S64 = T_C64 + 8192;
constexpr size_t T_C32 = T_S64 + 8192, T_S32 = T_C32 + 2048;

struct Params {
  const float* x_prompt; const float* x_sample;
  const float* g_mix_pre; const float* g_mix_post; const float* w_in; const float* g_q; const float* g_k; const float* g_heads; const float* w_out;
  const float* g_ffn_pre; const float* g_ffn_post; const float* w_gate; const float* w_up; const float* conv_w; const float* conv_b; const float* w_down;
  float* out; char* ws;
  int plo, phi;
  int seq[30];
};

DI unsigned cvtpk(float lo, float hi) { f32x2 v = {lo, hi}; bf16x2_t b = __builtin_convertvector(v, bf16x2_t); return __builtin_bit_cast(unsigned, b); }
DI float bflo(unsigned u) { return __uint_as_float(u << 16); }
DI float bfhi(unsigned u) { return __uint_as_float(u & 0xffff0000u); }
DI int crow(int reg, int h) { return (reg & 3) + 8 * (reg >> 2) + 4 * h; }
DI f32x16 mfma32(bf16x8 a, bf16x8 b, f32x16 c) { return __builtin_amdgcn_mfma_f32_32x32x16_bf16(a, b, c, 0, 0, 0); }
DI float fexp2(float x) { return __builtin_amdgcn_exp2f(x); }
DI f32x16 zero16() { f32x16 z;
#pragma unroll
  for (int i = 0; i < 16; ++i) z[i] = 0.f; return z; }
DI int seq_of_token(int tok, int& base, int& S) { if (tok < MP) { int s = tok >> 13; base = s << 13; S = 8192; return s; } int j = (tok - MP) >> 12; base = MP + (j << 12); S = 4096; return 8 + j; }
DI void seq_info(int seq, int& base, int& S) { if (seq < 8) { base = seq << 13; S = 8192; } else { base = MP + ((seq - 8) << 12); S = 4096; } }

DI void sincos_d(double a, float& s, float& c) {
  const double TWO_PI = 6.283185307179586476925286766559;
  a -= TWO_PI * __builtin_rint(a / TWO_PI);
  const double x2 = a * a;
  double ts = 1.0, tc = 1.0, ss = 1.0, cc = 1.0;
#pragma unroll
  for (int n = 1; n <= 13; ++n) { tc *= -x2 / (double)((2 * n - 1) * (2 * n)); ts *= -x2 / (double)((2 * n) * (2 * n + 1)); cc += tc; ss += ts; }
  s = (float)(a * ss); c = (float)cc;
}

DI bf16x8 tr_frag(const char* tile, int rs, int rowA, int rowB, int n0, int lane) {
#if USE_TR
  const int i16 = lane & 15, q4 = i16 >> 2, p4 = i16 & 3, nh = (lane >> 4) & 1;
  const char* a1 = tile + (rowA + q4) * rs + (n0 + 16 * nh + 4 * p4) * 2;
  const char* a2 = tile + (rowB + q4) * rs + (n0 + 16 * nh + 4 * p4) * 2;
  v4i16_t lo = __builtin_amdgcn_ds_read_tr16_b64_v4i16((__attribute__((address_space(3))) v4i16_t*)a1);
  v4i16_t hi = __builtin_amdgcn_ds_read_tr16_b64_v4i16((__attribute__((address_space(3))) v4i16_t*)a2);
  return (bf16x8){lo[0], lo[1], lo[2], lo[3], hi[0], hi[1], hi[2], hi[3]};
#else
  const int c = n0 + (lane & 31);
  bf16x8 f;
#pragma unroll
  for (int j = 0; j < 4; ++j) { f[j] = *(const short*)(tile + (rowA + j) * rs + c * 2); f[4 + j] = *(const short*)(tile + (rowB + j) * rs + c * 2); }
  return f;
#endif
}

DI float wave_sum(float v) {
#pragma unroll
  for (int o = 32; o >= 1; o >>= 1) v += __shfl_xor(v, o);
  return v;
}

DI void rowpass(int lane, const bf16_t* xn_in_row, float s_in, const float* xin_row, const bf16_t* add_row, const float* gpost, float* xout_row, bf16_t* xn_row, float* s_out) {
  float x[16];
  if (xin_row) {
#pragma unroll
    for (int i = 0; i < 4; ++i) { const f32x4 v = *(const f32x4*)(xin_row + i * 256 + lane * 4); x[4 * i] = v[0]; x[4 * i + 1] = v[1]; x[4 * i + 2] = v[2]; x[4 * i + 3] = v[3]; }
  } else {
#pragma unroll
    for (int i = 0; i < 4; ++i) { const u32x2 v = *(const u32x2*)(xn_in_row + i * 256 + lane * 4); x[4 * i] = bflo(v[0]) * s_in; x[4 * i + 1] = bfhi(v[0]) * s_in; x[4 * i + 2] = bflo(v[1]) * s_in; x[4 * i + 3] = bfhi(v[1]) * s_in; }
  }
  if (add_row) {
    float a[16]; float ss = 0.f;
#pragma unroll
    for (int i = 0; i < 4; ++i) { const u32x2 v = *(const u32x2*)(add_row + i * 256 + lane * 4); a[4 * i] = bflo(v[0]); a[4 * i + 1] = bfhi(v[0]); a[4 * i + 2] = bflo(v[1]); a[4 * i + 3] = bfhi(v[1]); }
#pragma unroll
    for (int i = 0; i < 16; ++i) ss += a[i] * a[i];
    ss = wave_sum(ss);
    const float ra = rsqrtf(ss * (1.0f / 1024.0f) + EPS);
#pragma unroll
    for (int i = 0; i < 4; ++i) { const f32x4 g = *(const f32x4*)(gpost + i * 256 + lane * 4);
#pragma unroll
      for (int e = 0; e < 4; ++e) x[4 * i + e] += a[4 * i + e] * ra * g[e]; }
  }
  if (xout_row) {
#pragma unroll
    for (int i = 0; i < 4; ++i) *(f32x4*)(xout_row + i * 256 + lane * 4) = (f32x4){x[4 * i], x[4 * i + 1], x[4 * i + 2], x[4 * i + 3]};
  }
  if (xn_row) {
    float ss = 0.f;
#pragma unroll
    for (int i = 0; i < 16; ++i) ss += x[i] * x[i];
    ss = wave_sum(ss);
    const float ms = ss * (1.0f / 1024.0f) + EPS;
    const float rx = rsqrtf(ms);
#pragma unroll
    for (int i = 0; i < 4; ++i) { u32x2 w; w[0] = cvtpk(x[4 * i] * rx, x[4 * i + 1] * rx); w[1] = cvtpk(x[4 * i + 2] * rx, x[4 * i + 3] * rx); *(u32x2*)(xn_row + i * 256 + lane * 4) = w; }
    if (lane == 0) *s_out = __builtin_sqrtf(ms);
  }
}

namespace pg8 {
#define PG8_LAS __attribute__((address_space(3)))
typedef unsigned short bf16_t;
typedef short bf16x8 __attribute__((ext_vector_type(8)));
typedef float f32x4 __attribute__((ext_vector_type(4)));
typedef unsigned u32x4 __attribute__((ext_vector_type(4)));
constexpr int BM = 256, BK = 64, HALF = 128, HTB = HALF * BK * 2  , STAGE_BYTES = 8 * HTB, NXCD = 8, WGM = 8;

__host__ __device__ __forceinline__ int lds_byte(int r, int c) { const int st = (r >> 4) * 2 + (c >> 5), rr = r & 15, cc = c & 31, ob = rr * 64 + cc * 2; return st * 1024 + (ob ^ (((ob >> 9) & 1) << 5)); }
__host__ __device__ __forceinline__ void stage_rc(int b, int& R, int& C) { const int st = b / 1024, sb = b % 1024, swz = sb ^ (((sb >> 9) & 1) << 5); R = (st >> 1) * 16 + swz / 64; C = (st & 1) * 32 + (swz % 64) / 2; }
__host__ __device__ __forceinline__ int perm32(int rho) { const int n = rho >> 4, i = rho & 15; return 8 * (i >> 2) + 4 * n + (i & 3); }

struct Unit { int pm, pn; long arow; };
struct Gemm { const bf16_t* A; const bf16_t* Bt; int M, N, K; };
template <class Epi, class Sched, bool ALIGN_EPI = false, bool SP2 = false>
__device__ __forceinline__ void gemm_phase(PG8_LAS unsigned char* lds, const Gemm g, const Sched& S, const Epi& E) {
    int tid_ = threadIdx.x; asm volatile("" : "+v"(tid_));
    const int tid = tid_, wid = __builtin_amdgcn_readfirstlane(tid >> 6), lane = tid & 63, wr = wid >> 2, wc = wid & 3, fr = lane & 15, fq = lane >> 4;
    const int K = g.K, nt = K / BK;
    unsigned voffA[2], voffB[2];
#pragma unroll
    for (int i = 0; i < 2; ++i) { int R, C; stage_rc(tid * 16 + i * 8192, R, C); const int Rb = Epi::PERM ? ((R & ~31) + perm32(R & 31)) : R;
        voffA[i] = (unsigned)(R * K + C) * 2u; voffB[i] = (unsigned)(Rb * K + C) * 2u; }
    const size_t kstep = (size_t)(BK * 2);
    const size_t hstep = (size_t)HALF * K * 2;
    const size_t tstep = 2 * hstep;
    const unsigned ldsw = (unsigned)wid * 1024u;
    const int aoff = lds_byte(wr * 64 + fr, fq * 8), boff = lds_byte(wc * 32 + fr, fq * 8);
#define PG8_SA(b, h) (((b) * 2 + (h)) * HTB)
#define PG8_SB(b, h) ((4 + (b) * 2 + (h)) * HTB)
#define PG8_STAGE(bufoff, gbase, voff) do { _Pragma("unroll") for (int _i = 0; _i < 2; ++_i) \
        __builtin_amdgcn_global_load_lds((const unsigned*)((const char*)(gbase) + (voff)[_i]), (PG8_LAS unsigned*)(lds + (bufoff) + ldsw + _i * 8192), 16, 0, 0); } while (0)
#define PG8_LDA(dst, b, h) do { _Pragma("unroll") for (int m = 0; m < 4; ++m) _Pragma("unroll") for (int k = 0; k < 2; ++k) dst[m][k] = *(const PG8_LAS bf16x8*)(lds + PG8_SA(b, h) + aoff + m * 2048 + k * 1024); } while (0)
#define PG8_LDB(dst, b, h) do { _Pragma("unroll") for (int n = 0; n < 2; ++n) _Pragma("unroll") for (int k = 0; k < 2; ++k) dst[n][k] = *(const PG8_LAS bf16x8*)(lds + PG8_SB(b, h) + boff + n * 2048 + k * 1024); } while (0)
#define PG8_MMA(ai, bj, At, Bt) do { __builtin_amdgcn_s_setprio(1); _Pragma("unroll") for (int m = 0; m < 4; ++m) _Pragma("unroll") for (int n = 0; n < 2; ++n) _Pragma("unroll") for (int k = 0; k < 2; ++k) \
        acc[ai][bj][m][n] = __builtin_amdgcn_mfma_f32_16x16x32_bf16(Bt[n][k], At[m][k], acc[ai][bj][m][n], 0, 0, 0); __builtin_amdgcn_s_setprio(0); } while (0)
#define PG8_WAIT_V(n) asm volatile("s_waitcnt vmcnt(" #n ")" ::: "memory")
#define PG8_WAIT_L(n) asm volatile("s_waitcnt lgkmcnt(" #n ")" ::: "memory")
#define PG8_BAR __builtin_amdgcn_s_barrier()
#define PG8_SCHED __builtin_amdgcn_sched_barrier(0)
    Unit cur, nxt; int ui = 0;
    if (!S.next(0, cur)) return;
    f32x4 acc[2][2][4][2];
#pragma unroll
    for (int a = 0; a < 2; ++a)
#pragma unroll
        for (int b = 0; b < 2; ++b)
#pragma unroll
            for (int m = 0; m < 4; ++m)
#pragma unroll
                for (int n = 0; n < 2; ++n) acc[a][b][m][n] = (f32x4){0.f, 0.f, 0.f, 0.f};
    bf16x8 At[4][2], B0[2][2], B1[2][2];
    const char* cA = (const char*)g.A + cur.arow * (long)(K * 2); const char* cB = (const char*)g.Bt + (size_t)cur.pn * tstep;
    S.a_ready(cur);
    if constexpr (SP2) {
        PG8_STAGE(PG8_SB(0, 0), cB, voffB); PG8_STAGE(PG8_SB(0, 1), cB + hstep, voffB); PG8_STAGE(PG8_SA(0, 0), cA, voffA); PG8_STAGE(PG8_SA(0, 1), cA + hstep, voffA);
        if (wr == 1) PG8_BAR;
        PG8_WAIT_V(2); PG8_BAR;
        PG8_STAGE(PG8_SB(1, 0), cB + kstep, voffB); PG8_STAGE(PG8_SA(1, 0), cA + kstep, voffA); PG8_STAGE(PG8_SB(1, 1), cB + hstep + kstep, voffB);
        PG8_WAIT_V(6); PG8_BAR;
    } else {
        PG8_STAGE(PG8_SB(0, 0), cB, voffB); PG8_STAGE(PG8_SA(0, 0), cA, voffA); PG8_STAGE(PG8_SB(0, 1), cB + hstep, voffB); PG8_STAGE(PG8_SA(0, 1), cA + hstep, voffA);
        if (wr == 1) PG8_BAR;
        PG8_WAIT_V(4); PG8_BAR;
        PG8_STAGE(PG8_SB(1, 0), cB + kstep, voffB); PG8_STAGE(PG8_SA(1, 0), cA + kstep, voffA); PG8_STAGE(PG8_SB(1, 1), cB + hstep + kstep, voffB);
        PG8_WAIT_V(6); PG8_BAR;
    }
    for (;;) {
        const bool has_next = S.next(ui + 1, nxt);
        const char* nA = has_next ? (const char*)g.A + nxt.arow * (long)(K * 2) : cA; const char* nB = has_next ? (const char*)g.Bt + (size_t)nxt.pn * tstep : cB;
        for (int t = 0; t < nt; t += 2) {
            const bool last = (t == nt - 2);
            const char* a1 = cA + (size_t)(t + 1) * kstep;
            const char* a2 = last ? nA : cA + (size_t)(t + 2) * kstep; const char* b2 = last ? nB : cB + (size_t)(t + 2) * kstep;
            const char* a3 = a2 + kstep; const char* b3 = b2 + kstep;
            if (last && has_next) S.a_ready(nxt);
            if constexpr (SP2) {
            PG8_LDB(B0, 0, 0); PG8_LDB(B1, 0, 1); PG8_SCHED; PG8_LDA(At, 0, 0); PG8_STAGE(PG8_SA(1, 1), a1 + hstep, voffA);
            PG8_WAIT_V(8); PG8_WAIT_L(0); PG8_BAR; PG8_MMA(0, 0, At, B0); PG8_MMA(0, 1, At, B1); PG8_BAR; PG8_SCHED;
            PG8_LDA(At, 0, 1); PG8_STAGE(PG8_SB(0, 0), b2, voffB); PG8_STAGE(PG8_SB(0, 1), b2 + hstep, voffB); PG8_STAGE(PG8_SA(0, 0), a2, voffA);
            PG8_WAIT_V(8); PG8_WAIT_L(0); PG8_BAR; PG8_MMA(1, 0, At, B0); PG8_MMA(1, 1, At, B1); PG8_BAR; PG8_SCHED;
            PG8_LDB(B0, 1, 0); PG8_LDB(B1, 1, 1); PG8_SCHED; PG8_LDA(At, 1, 0); PG8_STAGE(PG8_SA(0, 1), a2 + hstep, voffA);
            PG8_WAIT_V(8); PG8_WAIT_L(0); PG8_BAR; PG8_MMA(0, 0, At, B0); PG8_MMA(0, 1, At, B1); PG8_BAR; PG8_SCHED;
            PG8_LDA(At, 1, 1); PG8_STAGE(PG8_SB(1, 0), b3, voffB); PG8_STAGE(PG8_SB(1, 1), b3 + hstep, voffB); PG8_STAGE(PG8_SA(1, 0), a3, voffA);
            PG8_WAIT_V(8); PG8_WAIT_L(0); PG8_BAR; PG8_MMA(1, 0, At, B0); PG8_MMA(1, 1, At, B1); PG8_BAR; PG8_SCHED;
            } else {
            PG8_LDB(B0, 0, 0); PG8_SCHED; PG8_LDA(At, 0, 0); PG8_STAGE(PG8_SA(1, 1), a1 + hstep, voffA);
            PG8_WAIT_L(8); PG8_BAR; PG8_WAIT_L(0); PG8_MMA(0, 0, At, B0); PG8_BAR; PG8_SCHED;
            PG8_LDB(B1, 0, 1); PG8_STAGE(PG8_SB(0, 0), b2, voffB);
            PG8_BAR; PG8_WAIT_L(0); PG8_MMA(0, 1, At, B1); PG8_BAR;
            PG8_LDA(At, 0, 1); PG8_STAGE(PG8_SA(0, 0), a2, voffA);
            PG8_BAR; PG8_WAIT_L(0); PG8_MMA(1, 0, At, B0); PG8_BAR; PG8_SCHED;
            PG8_STAGE(PG8_SB(0, 1), b2 + hstep, voffB);
            PG8_WAIT_V(6); PG8_BAR; PG8_MMA(1, 1, At, B1); PG8_BAR;
            PG8_LDB(B0, 1, 0); PG8_SCHED; PG8_LDA(At, 1, 0); PG8_STAGE(PG8_SA(0, 1), a2 + hstep, voffA);
            PG8_WAIT_L(8); PG8_BAR; PG8_WAIT_L(0); PG8_MMA(0, 0, At, B0); PG8_BAR; PG8_SCHED;
            PG8_LDB(B1, 1, 1); PG8_STAGE(PG8_SB(1, 0), b3, voffB);
            PG8_BAR; PG8_WAIT_L(0); PG8_MMA(0, 1, At, B1); PG8_BAR;
            PG8_LDA(At, 1, 1); PG8_STAGE(PG8_SA(1, 0), a3, voffA);
            PG8_BAR; PG8_WAIT_L(0); PG8_MMA(1, 0, At, B0); PG8_BAR; PG8_SCHED;
            PG8_STAGE(PG8_SB(1, 1), b3 + hstep, voffB);
            PG8_WAIT_V(6); PG8_BAR; PG8_MMA(1, 1, At, B1); PG8_BAR;
            }
        }
        if constexpr (ALIGN_EPI) { if (wr == 0) PG8_BAR; }
        if constexpr (!Epi::AFTER_DRAIN) { E(acc, cur, wr, wc, fr, fq); S.done(cur); }
        if (!has_next) break;
#pragma unroll
        for (int a = 0; a < 2; ++a)
#pragma unroll
            for (int b = 0; b < 2; ++b)
#pragma unroll
                for (int m = 0; m < 4; ++m)
#pragma unroll
                    for (int n = 0; n < 2; ++n) acc[a][b][m][n] = (f32x4){0.f, 0.f, 0.f, 0.f};
        cur = nxt; cA = nA; cB = nB; ++ui;
        if constexpr (ALIGN_EPI) { if (wr == 1) PG8_BAR; }
    }
    PG8_WAIT_V(0);
    if constexpr (!ALIGN_EPI) { if (wr == 0) PG8_BAR; }
    PG8_BAR;
    if constexpr (Epi::AFTER_DRAIN) { E.fused(acc, cur, wr, wc, fr, fq, lds, wid, lane); S.done(cur); }
#undef PG8_SA
#undef PG8_SB
#undef PG8_STAGE
#undef PG8_LDA
#undef PG8_LDB
#undef PG8_MMA
#undef PG8_WAIT_V
#undef PG8_WAIT_L
#undef PG8_BAR
#undef PG8_SCHED
}
}

DI int swz(int row, int ch) { return row * 128 + ((ch ^ ((row >> 1) & 7)) << 4); }
template <int AI> DI void stage_t(char* lds, const pg8::f32x4 (&acc)[2][2][4][2], int wr, int wc, int fr, int fq, int shift) {
  float* sC = (float*)lds;
#pragma unroll
  for (int bj = 0; bj < 2; ++bj)
#pragma unroll
    for (int m = 0; m < 4; ++m)
#pragma unroll
      for (int n = 0; n < 2; ++n) *(pg8::f32x4*)(sC + (64 * wr + 16 * m + fr + shift) * CST + 128 * bj + 32 * wc + 16 * n + 4 * fq) = acc[AI][bj][m][n];
}
DI void ld8(const float* p, float (&v)[8]) { const f32x4 a = *(const f32x4*)p, b = *(const f32x4*)(p + 4); v[0] = a[0]; v[1] = a[1]; v[2] = a[2]; v[3] = a[3]; v[4] = b[0]; v[5] = b[1]; v[6] = b[2]; v[7] = b[3]; }
DI u32x4 pack8(const float (&v)[8]) { u32x4 w; w[0] = cvtpk(v[0], v[1]); w[1] = cvtpk(v[2], v[3]); w[2] = cvtpk(v[4], v[5]); w[3] = cvtpk(v[6], v[7]); return w; }

enum { EPI_PLAIN = 0, EPI_ROPEA = 1, EPI_NRB = 2 };
DI void ld4(const float* p, float (&v)[4]) { const f32x4 a = *(const f32x4*)p; v[0] = a[0]; v[1] = a[1]; v[2] = a[2]; v[3] = a[3]; }
DI void epi_rows(char* lds, int tid, int kind, int tok0, int sc0, bf16_t* dst, int pitch, int col0, float scale, const float* gain, const char* tab) {
  const float* sC = (const float*)lds + sc0;
  const int lane = tid & 63, w = tid >> 6, j = lane & 31, jj = j & 15;
#pragma unroll 2
  for (int pass = 0; pass < 8; ++pass) {
    const int row = pass * 16 + w * 2 + (lane >> 5);
    const int tok = tok0 + row;
    float v[4]; ld4(sC + row * CST + 4 * j, v);
    if (kind == EPI_ROPEA) {
      if (jj < 4) {
        const int pos = (tok < MP) ? (tok & 8191) : (tok & 4095);
        float o[4]; ld4(sC + row * CST + 4 * (j ^ 2), o);
        float cs[4], sn[4]; ld4((const float*)(tab + T_ROPET_C) + pos * 8 + 4 * (jj & 1), cs); ld4((const float*)(tab + T_ROPET_S) + pos * 8 + 4 * (jj & 1), sn);
#pragma unroll
        for (int e = 0; e < 4; ++e) v[e] = (jj < 2) ? (v[e] * cs[e] - o[e] * sn[e]) : (v[e] * cs[e] + o[e] * sn[e]);
      }
    } else if (kind == EPI_NRB) {
      float ss = v[0] * v[0] + v[1] * v[1] + v[2] * v[2] + v[3] * v[3];
      ss += __shfl_xor(ss, 1); ss += __shfl_xor(ss, 2); ss += __shfl_xor(ss, 4); ss += __shfl_xor(ss, 8);
      const float rr = rsqrtf(ss * (1.0f / 64.0f) + EPS);
      float o[4]; ld4(sC + row * CST + 4 * (j ^ 4), o);
      float go[4], gp[4]; ld4(gain + 4 * jj, go); ld4(gain + 4 * (jj ^ 4), gp);
      const int pos = (tok < MP) ? (tok & 8191) : (tok & 4095);
      const float* tc = (jj < 8) ? ((const float*)(tab + T_ROPER_C) + (pos >> 6) * 16) : ((const float*)(tab + T_ROPEC_C) + (pos & 63) * 16);
      const float* ts = (jj < 8) ? ((const float*)(tab + T_ROPER_S) + (pos >> 6) * 16) : ((const float*)(tab + T_ROPEC_S) + (pos & 63) * 16);
      float cs[4], sn[4]; ld4(tc + 4 * (jj & 3), cs); ld4(ts + 4 * (jj & 3), sn);
#pragma unroll
      for (int e = 0; e < 4; ++e) { const float yo = v[e] * rr * go[e], yp = o[e] * rr * gp[e]; v[e] = ((jj & 4) == 0) ? (yo * cs[e] - yp * sn[e]) : (yo * cs[e] + yp * sn[e]); }
    }
    u32x2 wv; wv[0] = cvtpk(v[0] * scale, v[1] * scale); wv[1] = cvtpk(v[2] * scale, v[3] * scale);
    *(u32x2*)(dst + (size_t)tok * pitch + col0 + 4 * j) = wv;
  }
}

DI float gelu_tanh(float x) { const float u = x * x; const float t = x * (-2.302208198f + -0.1029432397f * u); return x * __builtin_amdgcn_rcpf(1.0f + fexp2(t)); }

constexpr float ATT_THR = 6.0f;
template <bool MASKED>
DI void flash_core(char* lds, int tid, const bf16_t* Qp, int qpitch, const bf16_t* Kp, int kpitch, const bf16_t* Vp, int vpitch,
                   int base, int dil, int L, int iq0, int kt0, int ntiles, f32x16 (&O)[2], float& m_run, float& l_run) {
  const int lane = tid & 63, w = tid >> 6, r32 = lane & 31, h = lane >> 5;
  const int iq = iq0 + 32 * w + r32;
  bf16x8 qf[4];
  { const bf16_t* qrow = Qp + (size_t)(base + dil * iq) * qpitch;
#pragma unroll
    for (int ks = 0; ks < 4; ++ks) qf[ks] = *(const bf16x8*)(qrow + 16 * ks + 8 * h); }
  const int lrow = tid >> 3, lch = tid & 7;
  const int kso = swz(lrow, lch), vso = 8192 + (lch >> 2) * 4096 + lrow * 64 + (lch & 3) * 16;
  u32x4 kreg, vreg;
#define FA_GLOAD(t) do { int ik = kt0 + 64 * (t) + lrow; ik = ik < 0 ? 0 : (ik > L - 1 ? L - 1 : ik); const size_t tok = (size_t)(base + dil * ik); \
    kreg = *(const u32x4*)(Kp + tok * kpitch + lch * 8); vreg = *(const u32x4*)(Vp + tok * vpitch + lch * 8); } while (0)
#define FA_LSTORE(b) do { *(u32x4*)(lds + (b) * 16384 + kso) = kreg; *(u32x4*)(lds + (b) * 16384 + vso) = vreg; } while (0)
  FA_GLOAD(0); FA_LSTORE(0); __syncthreads();
  O[0] = zero16(); O[1] = zero16(); m_run = 0.f; l_run = 0.f;
  f32x16 negm = zero16();
  const int iqw = iq0 + 32 * w;
  for (int t = 0; t < ntiles; ++t) {
    const bool more = (t + 1 < ntiles);
    if (more) FA_GLOAD(t + 1);
    const char* kb = lds + (t & 1) * 16384; const char* vb = kb + 8192;
    bool need = true;
    if (MASKED) { const int k_lo = kt0 + 64 * t; need = (k_lo + 63 >= iqw - 64) && (k_lo <= iqw + 31 + 64); }
    if (need) {
      f32x16 S0 = negm, S1 = negm;
#pragma unroll
      for (int ks = 0; ks < 4; ++ks) {
        const bf16x8 k0 = *(const bf16x8*)(kb + swz(r32, 2 * ks + h));
        const bf16x8 k1 = *(const bf16x8*)(kb + swz(32 + r32, 2 * ks + h));
        S0 = mfma32(k0, qf[ks], S0); S1 = mfma32(k1, qf[ks], S1);
      }
      if (MASKED) {
#pragma unroll
        for (int r = 0; r < 16; ++r) { const int ik0 = kt0 + 64 * t + crow(r, h), ik1 = ik0 + 32; const int d0 = ik0 - iq, d1 = ik1 - iq;
          const bool v0 = (ik0 >= 0) && (ik0 < L) && (d0 <= 64) && (d0 >= -64); const bool v1 = (ik1 >= 0) && (ik1 < L) && (d1 <= 64) && (d1 >= -64);
          S0[r] = v0 ? S0[r] : -1e30f; S1[r] = v1 ? S1[r] : -1e30f; }
      }
      float mx = __builtin_fmaxf(__builtin_fmaxf(S0[0], S0[1]), S1[0]);
      mx = __builtin_fmaxf(__builtin_fmaxf(mx, S1[1]), S0[2]);
#pragma unroll
      for (int r = 2; r < 16; r += 2) { mx = __builtin_fmaxf(__builtin_fmaxf(mx, S1[r]), S1[r + 1]); if (r + 2 < 16) mx = __builtin_fmaxf(__builtin_fmaxf(mx, S0[r + 1]), S0[r + 2]); else mx = __builtin_fmaxf(mx, S0[r + 1]); }
      mx = __builtin_fmaxf(mx, __shfl_xor(mx, 32));
      if (__builtin_amdgcn_ballot_w64(mx > ATT_THR) != 0ull) {
        const float dl = __builtin_fmaxf(mx, 0.f); m_run += dl; const float alpha = fexp2(-dl); l_run *= alpha;
#pragma unroll
        for (int r = 0; r < 16; ++r) { O[0][r] *= alpha; O[1][r] *= alpha; S0[r] -= dl; S1[r] -= dl; negm[r] = -m_run; }
      }
      float ps0 = 0.f, ps1 = 0.f;
#pragma unroll
      for (int r = 0; r < 16; ++r) { S0[r] = fexp2(S0[r]); S1[r] = fexp2(S1[r]); ps0 += S0[r]; ps1 += S1[r]; }
      l_run += ps0 + ps1;
#pragma unroll
      for (int s = 0; s < 4; ++s) {
        const int kvb = s >> 1, sp = s & 1;
        u32x4 pw;
        if (kvb == 0) { pw[0] = cvtpk(S0[8 * sp], S0[8 * sp + 1]); pw[1] = cvtpk(S0[8 * sp + 2], S0[8 * sp + 3]); pw[2] = cvtpk(S0[8 * sp + 4], S0[8 * sp + 5]); pw[3] = cvtpk(S0[8 * sp + 6], S0[8 * sp + 7]); }
        else          { pw[0] = cvtpk(S1[8 * sp], S1[8 * sp + 1]); pw[1] = cvtpk(S1[8 * sp + 2], S1[8 * sp + 3]); pw[2] = cvtpk(S1[8 * sp + 4], S1[8 * sp + 5]); pw[3] = cvtpk(S1[8 * sp + 6], S1[8 * sp + 7]); }
        const bf16x8 xs = __builtin_bit_cast(bf16x8, pw);
        const int rowA = 32 * kvb + 16 * sp + 4 * h;
#pragma unroll
        for (int db = 0; db < 2; ++db) { const bf16x8 vf = tr_frag(vb + db * 4096, 64, rowA, rowA + 8, 0, lane); O[db] = mfma32(vf, xs, O[db]); }
      }
    }
    if (more) FA_LSTORE((t + 1) & 1);
    __syncthreads();
  }
#undef FA_GLOAD
#undef FA_LSTORE
}

DI void flash_grid(char* lds, int tid, const bf16_t* Qp, const bf16_t* Kp, const bf16_t* Vp, int base, int iq0, int ntiles, float kbound, f32x16 (&O)[2], float& l_out) {
  const int lane = tid & 63, w = tid >> 6, r32 = lane & 31, h = lane >> 5;
  bf16x8 qf[4];
  { const bf16_t* qrow = Qp + (size_t)(base + iq0 + 32 * w + r32) * 512;
#pragma unroll
    for (int ks = 0; ks < 4; ++ks) qf[ks] = *(const bf16x8*)(qrow + 16 * ks + 8 * h); }
  float qn2 = 0.f;
#pragma unroll
  for (int ks = 0; ks < 4; ++ks)
#pragma unroll
    for (int e = 0; e < 8; ++e) { const float qv = __uint_as_float(((unsigned)(unsigned short)qf[ks][e]) << 16); qn2 += qv * qv; }
  qn2 += __shfl_xor(qn2, 32);
  const float m_row = __builtin_sqrtf(qn2) * kbound;
  const int lrow = tid >> 3, lch = tid & 7;
  const int kso = swz(lrow, lch), vso = 16384 + (lch >> 2) * 4096 + lrow * 64 + (lch & 3) * 16;
  const unsigned goff = (unsigned)(((base + lrow) * 128 + lch * 8) * 2);
#define KG(t) ((const char*)Kp + (size_t)(goff + (unsigned)(t) * (64u * 128u * 2u)))
#define VG(t) ((const char*)Vp + (size_t)(goff + (unsigned)(t) * (64u * 128u * 2u)))
  u32x4 kreg, vreg;
  int kfo[4];
#pragma unroll
  for (int ks = 0; ks < 4; ++ks) kfo[ks] = r32 * 128 + (((2 * ks + h) ^ ((r32 >> 1) & 7)) << 4);
  float l_run = 0.f;
  f32x16 negm;
#pragma unroll
  for (int r = 0; r < 16; ++r) negm[r] = -m_row;
  O[0] = zero16(); O[1] = zero16();
#define SB() __builtin_amdgcn_sched_barrier(0)
#define FG_QK(SN0, SN1, kb) do { bf16x8 kf[8]; \
    _Pragma("unroll") for (int ks = 0; ks < 4; ++ks) { kf[2 * ks] = *(const bf16x8*)((kb) + kfo[ks]); kf[2 * ks + 1] = *(const bf16x8*)((kb) + 4096 + kfo[ks]); } \
    SN0 = mfma32(kf[0], qf[0], negm); SN1 = mfma32(kf[1], qf[0], negm); \
    _Pragma("unroll") for (int ks = 1; ks < 4; ++ks) { SN0 = mfma32(kf[2 * ks], qf[ks], SN0); SN1 = mfma32(kf[2 * ks + 1], qf[ks], SN1); } } while (0)
  kreg = *(const u32x4*)KG(0); vreg = *(const u32x4*)VG(0);
  *(u32x4*)(lds + kso) = kreg; *(u32x4*)(lds + vso) = vreg;
  kreg = *(const u32x4*)KG(1);
  __syncthreads();
  f32x16 SA0, SA1, SB0, SB1;
  FG_QK(SA0, SA1, lds);
#pragma unroll
  for (int r = 0; r < 16; ++r) { SA0[r] = fexp2(SA0[r]); SA1[r] = fexp2(SA1[r]); }
  *(u32x4*)(lds + 8192 + kso) = kreg;
  __syncthreads();
#define FG_STEP(SC0, SC1, SN0, SN1, t, HASN, HASK) do { \
    const int cur_ = (t) & 1; \
    if (HASK) kreg = *(const u32x4*)KG((t) + 2); \
    if (HASN) vreg = *(const u32x4*)VG((t) + 1); \
    const char* kb_ = lds + (cur_ ^ 1) * 8192; const char* vb_ = lds + 16384 + cur_ * 8192; \
    bf16x8 kf_[8]; \
    if (HASN) { _Pragma("unroll") for (int ks = 0; ks < 2; ++ks) { kf_[2 * ks] = *(const bf16x8*)(kb_ + kfo[ks]); kf_[2 * ks + 1] = *(const bf16x8*)(kb_ + 4096 + kfo[ks]); } } \
    SB(); \
      \
    float ps_ = 0.f; u32x4 pw_[4]; \
    _Pragma("unroll") for (int g = 0; g < 8; ++g) { \
      if (HASN && g == 2) { _Pragma("unroll") for (int ks = 2; ks < 4; ++ks) { kf_[2 * ks] = *(const bf16x8*)(kb_ + kfo[ks]); kf_[2 * ks + 1] = *(const bf16x8*)(kb_ + 4096 + kfo[ks]); } } \
      if (HASN) { __builtin_amdgcn_s_setprio(1); if (g == 0) SN0 = mfma32(kf_[0], qf[0], negm); else if (g == 1) SN1 = mfma32(kf_[1], qf[0], negm); \
                  else if ((g & 1) == 0) SN0 = mfma32(kf_[g], qf[g >> 1], SN0); else SN1 = mfma32(kf_[g], qf[g >> 1], SN1); __builtin_amdgcn_s_setprio(0); } \
      if (g < 4) { ps_ += (SC0[4 * g] + SC0[4 * g + 1]) + (SC0[4 * g + 2] + SC0[4 * g + 3]); pw_[g >> 1][2 * (g & 1)] = cvtpk(SC0[4 * g], SC0[4 * g + 1]); pw_[g >> 1][2 * (g & 1) + 1] = cvtpk(SC0[4 * g + 2], SC0[4 * g + 3]); } \
      else { const int g2 = g - 4; ps_ += (SC1[4 * g2] + SC1[4 * g2 + 1]) + (SC1[4 * g2 + 2] + SC1[4 * g2 + 3]); pw_[2 + (g2 >> 1)][2 * (g2 & 1)] = cvtpk(SC1[4 * g2], SC1[4 * g2 + 1]); pw_[2 + (g2 >> 1)][2 * (g2 & 1) + 1] = cvtpk(SC1[4 * g2 + 2], SC1[4 * g2 + 3]); } \
      asm volatile("" : "+v"(ps_)); asm volatile("" : "+v"(pw_[g >> 1])); \
      SB(); } \
    l_run += ps_; \
      \
    bf16x8 vf_[8]; \
    _Pragma("unroll") for (int s = 0; s < 2; ++s) { const int rowA = 16 * s + 4 * h; \
      vf_[2 * s] = tr_frag(vb_, 64, rowA, rowA + 8, 0, lane); vf_[2 * s + 1] = tr_frag(vb_ + 4096, 64, rowA, rowA + 8, 0, lane); } \
    SB(); \
      \
    _Pragma("unroll") for (int g = 0; g < 8; ++g) { \
      if (g == 2) { _Pragma("unroll") for (int s = 2; s < 4; ++s) { const int rowA = 16 * s + 4 * h; \
        vf_[2 * s] = tr_frag(vb_, 64, rowA, rowA + 8, 0, lane); vf_[2 * s + 1] = tr_frag(vb_ + 4096, 64, rowA, rowA + 8, 0, lane); } } \
      __builtin_amdgcn_s_setprio(1); O[g & 1] = mfma32(vf_[g], __builtin_bit_cast(bf16x8, pw_[g >> 1]), O[g & 1]); __builtin_amdgcn_s_setprio(0); \
      if (HASN) { if (g < 4) { SN0[4 * g] = fexp2(SN0[4 * g]); SN0[4 * g + 1] = fexp2(SN0[4 * g + 1]); SN0[4 * g + 2] = fexp2(SN0[4 * g + 2]); SN0[4 * g + 3] = fexp2(SN0[4 * g + 3]); } \
                  else { const int g2 = g - 4; SN1[4 * g2] = fexp2(SN1[4 * g2]); SN1[4 * g2 + 1] = fexp2(SN1[4 * g2 + 1]); SN1[4 * g2 + 2] = fexp2(SN1[4 * g2 + 2]); SN1[4 * g2 + 3] = fexp2(SN1[4 * g2 + 3]); } \
                  if (g < 4) asm volatile("" : "+v"(SN0)); else asm volatile("" : "+v"(SN1)); } \
      SB(); } \
    if (HASK) *(u32x4*)(lds + cur_ * 8192 + kso) = kreg; \
    if (HASN) *(u32x4*)(lds + (cur_ ^ 1) * 8192 + vso) = vreg; \
    __syncthreads(); } while (0)
  int t = 0;
  for (; t + 3 < ntiles; t += 2) { FG_STEP(SA0, SA1, SB0, SB1, t, true, true); FG_STEP(SB0, SB1, SA0, SA1, t + 1, true, true); }
  FG_STEP(SA0, SA1, SB0, SB1, t, true, false);
  FG_STEP(SB0, SB1, SA0, SA1, t + 1, false, false);
#undef KG
#undef VG
#undef FG_STEP
#undef FG_QK
#undef SB
  l_out = l_run;
}

DI void flash_dil(char* lds, int tid, const bf16_t* Qp, const bf16_t* Kp, const bf16_t* Vp, int base, int dil, int L, int i0, f32x16 (&O)[2], float& m_out, float& l_out) {
  const int lane = tid & 63, w = tid >> 6, r32 = lane & 31, h = lane >> 5;
  const int kt0 = i0 - 64;
#pragma unroll
  for (int i = 0; i < 6; ++i) { const int c = tid + 512 * i, row = c >> 3, ch = c & 7; int ik = kt0 + row; ik = ik < 0 ? 0 : (ik > L - 1 ? L - 1 : ik);
    const size_t tok = (size_t)(base + dil * ik);
    const u32x4 kreg = *(const u32x4*)(Kp + tok * 256 + ch * 8), vreg = *(const u32x4*)(Vp + tok * 256 + ch * 8);
    *(u32x4*)(lds + swz(row, ch)) = kreg;
    *(u32x4*)(lds + 49152 + (ch >> 2) * 24576 + row * 64 + (ch & 3) * 16) = vreg; }
  const int iq = i0 + 32 * w + r32;
  bf16x8 qf[4];
  { const bf16_t* qrow = Qp + (size_t)(base + dil * iq) * 256;
#pragma unroll
    for (int ks = 0; ks < 4; ++ks) qf[ks] = *(const bf16x8*)(qrow + 16 * ks + 8 * h); }
  __syncthreads();
  O[0] = zero16(); O[1] = zero16();
  float m_run = -1e30f, l_run = 0.f;
#pragma unroll 1
  for (int b = 0; b < 5; ++b) {
    const int rb = 32 * w + 32 * b;
    f32x16 S = zero16();
#pragma unroll
    for (int ks = 0; ks < 4; ++ks) { const bf16x8 kf = *(const bf16x8*)(lds + swz(rb + r32, 2 * ks + h)); S = mfma32(kf, qf[ks], S); }
#pragma unroll
    for (int r = 0; r < 16; ++r) { const int ik = kt0 + rb + crow(r, h); const int d = ik - iq; const bool v = (ik >= 0) && (ik < L) && (d <= 64) && (d >= -64); S[r] = v ? S[r] : -1e30f; }
    float mx = S[0];
#pragma unroll
    for (int r = 1; r < 16; ++r) mx = __builtin_fmaxf(mx, S[r]);
    mx = __builtin_fmaxf(mx, __shfl_xor(mx, 32));
    const float m_new = __builtin_fmaxf(m_run, mx); const float alpha = fexp2(m_run - m_new); m_run = m_new;
    float ps = 0.f;
#pragma unroll
    for (int r = 0; r < 16; ++r) { S[r] = fexp2(S[r] - m_new); ps += S[r]; }
    l_run = l_run * alpha + ps;
#pragma unroll
    for (int r = 0; r < 16; ++r) { O[0][r] *= alpha; O[1][r] *= alpha; }
#pragma unroll
    for (int sp = 0; sp < 2; ++sp) {
      u32x4 pw; pw[0] = cvtpk(S[8 * sp], S[8 * sp + 1]); pw[1] = cvtpk(S[8 * sp + 2], S[8 * sp + 3]); pw[2] = cvtpk(S[8 * sp + 4], S[8 * sp + 5]); pw[3] = cvtpk(S[8 * sp + 6], S[8 * sp + 7]);
      const bf16x8 xs = __builtin_bit_cast(bf16x8, pw);
      const int rowA = rb + 16 * sp + 4 * h;
#pragma unroll
      for (int db = 0; db < 2; ++db) { const bf16x8 vf = tr_frag(lds + 49152 + db * 24576, 64, rowA, rowA + 8, 0, lane); O[db] = mfma32(vf, xs, O[db]); }
    }
  }
  m_out = m_run; l_out = l_run;
  __syncthreads();
}

struct OneUnit { long arow; int pn;
  DI bool next(int i, pg8::Unit& u) const { if (i != 0) return false; u.pm = 0; u.pn = pn; u.arow = arow; return true; }
  DI void a_ready(const pg8::Unit&) const {}
  DI void done(const pg8::Unit&) const {} };
struct EpiP1 { static constexpr bool PERM = false, AFTER_DRAIN = true;
  int tid, tok_tile0, nt; char* ws; const float* gq; const float* gk;
  template <int AI> DI void pass(char* lds, const pg8::f32x4 (&acc)[2][2][4][2], int wr, int wc, int fr, int fq) const {
    stage_t<AI>(lds, acc, wr, wc, fr, fq, 0); __syncthreads();
    int tid = this->tid; asm volatile("" : "+v"(tid));
    const int tok0 = tok_tile0 + AI * 128;
    const char* tab = ws + WS_TAB;
    bf16_t* QA = (bf16_t*)(ws + WS_QA); bf16_t* KA = (bf16_t*)(ws + WS_KA); bf16_t* VA = (bf16_t*)(ws + WS_VA);
    bf16_t* QB = (bf16_t*)(ws + WS_QB); bf16_t* KB = (bf16_t*)(ws + WS_KB); bf16_t* VB = (bf16_t*)(ws + WS_VB); bf16_t* ZC = (bf16_t*)(ws + WS_ZC);
    for (int hf = 0; hf < 2; ++hf) { const int c128 = nt * 2 + hf;
      int kind = EPI_PLAIN; bf16_t* dst = ZC; int pitch = 256, col0 = (c128 - 12) * 128; float scale = 1.0f; const float* gain = nullptr;
      if (c128 < 2) { kind = EPI_ROPEA; dst = QA; pitch = 256; col0 = c128 * 128; scale = QSCALE; }
      else if (c128 < 4) { kind = EPI_ROPEA; dst = KA; pitch = 256; col0 = (c128 - 2) * 128; }
      else if (c128 < 6) { dst = VA; pitch = 256; col0 = (c128 - 4) * 128; }
      else if (c128 < 10) { kind = EPI_NRB; dst = QB; pitch = 512; col0 = (c128 - 6) * 128; scale = QSCALE; gain = gq; }
      else if (c128 == 10) { kind = EPI_NRB; dst = KB; pitch = 128; col0 = 0; gain = gk; }
      else if (c128 == 11) { dst = VB; pitch = 128; col0 = 0; }
      epi_rows(lds, tid, kind, tok0, hf * 128, dst, pitch, col0, scale, gain, tab); }
    __syncthreads();
  }
  DI void fused(pg8::f32x4 (&acc)[2][2][4][2], const pg8::Unit&, int wr, int wc, int fr, int fq, PG8_LAS unsigned char* lds3, int, int) const {
    char* lds = (char*)lds3; pass<0>(lds, acc, wr, wc, fr, fq); pass<1>(lds, acc, wr, wc, fr, fq); }
};
struct EpiPlain { static constexpr bool PERM = false, AFTER_DRAIN = true;
  int tid, tok_tile0, col_tile0; bf16_t* dst; const char* tab;
  template <int AI> DI void pass(char* lds, const pg8::f32x4 (&acc)[2][2][4][2], int wr, int wc, int fr, int fq) const {
    stage_t<AI>(lds, acc, wr, wc, fr, fq, 0); __syncthreads();
    int tid = this->tid; asm volatile("" : "+v"(tid));
    for (int hf = 0; hf < 2; ++hf) epi_rows(lds, tid, EPI_PLAIN, tok_tile0 + AI * 128, hf * 128, dst, DM, col_tile0 + hf * 128, 1.0f, nullptr, tab);
    __syncthreads();
  }
  DI void fused(pg8::f32x4 (&acc)[2][2][4][2], const pg8::Unit&, int wr, int wc, int fr, int fq, PG8_LAS unsigned char* lds3, int, int) const {
    char* lds = (char*)lds3; pass<0>(lds, acc, wr, wc, fr, fq); pass<1>(lds, acc, wr, wc, fr, fq); }
};
struct EpiP4 { static constexpr bool PERM = false, AFTER_DRAIN = true;
  int tid, p0, nt; const float* cw; const float* cb; bf16_t* ACT;
  template <int PS> DI void pass(char* lds, const pg8::f32x4 (&acc)[2][2][4][2], int wr, int wc, int fr, int fq) const {
    float* sCw = (float*)lds;
    stage_t<PS>(lds, acc, wr, wc, fr, fq, PS);
    if (PS == 0) { if (wr == 0 && fr == 0) {
#pragma unroll
        for (int bj = 0; bj < 2; ++bj)
#pragma unroll
          for (int n = 0; n < 2; ++n) *(pg8::f32x4*)(sCw + 128 * CST + 128 * bj + 32 * wc + 16 * n + 4 * fq) = acc[1][bj][0][n]; } }
    else { if (wr == 1 && fr == 15) {
#pragma unroll
        for (int bj = 0; bj < 2; ++bj)
#pragma unroll
          for (int n = 0; n < 2; ++n) *(pg8::f32x4*)(sCw + 128 * bj + 32 * wc + 16 * n + 4 * fq) = acc[0][bj][3][n]; } }
    __syncthreads();
    const float* sC = (const float*)lds;
    int tid = this->tid; asm volatile("" : "+v"(tid));
    const int lane = tid & 63, w = tid >> 6, jj = lane & 15; const int f0 = nt * 128 + 8 * jj;
    float c0[8], c1[8], c2[8], bb[8]; ld8(cw + f0, c0); ld8(cw + DFF + f0, c1); ld8(cw + 2 * DFF + f0, c2); ld8(cb + f0, bb);
#pragma unroll 2
    for (int ps = 0; ps < 4; ++ps) {
      const int q = ps * 32 + w * 4 + (lane >> 4);
      const int i = 1 + q;
      const int tok = p0 + 127 * PS + i;
      if (q < 127 && tok < MT) {
        const int pos = (tok < MP) ? (tok & 8191) : (tok & 4095); const int S = (tok < MP) ? 8192 : 4096;
        float gm[8], gc[8], gp[8], up[8];
        ld8(sC + (i - 1) * CST + 8 * jj, gm); ld8(sC + i * CST + 8 * jj, gc); ld8(sC + (i + 1) * CST + 8 * jj, gp); ld8(sC + i * CST + 128 + 8 * jj, up);
        if (pos - 1 < 0) {
#pragma unroll
          for (int e = 0; e < 8; ++e) gm[e] = 0.f; }
        if (pos + 1 >= S) {
#pragma unroll
          for (int e = 0; e < 8; ++e) gp[e] = 0.f; }
        float o[8];
#pragma unroll
        for (int e = 0; e < 8; e += 2) {
          const f32x2 a = {gm[e], gm[e + 1]}, b = {gc[e], gc[e + 1]}, c = {gp[e], gp[e + 1]};
          const f32x2 k0 = {c0[e], c0[e + 1]}, k1 = {c1[e], c1[e + 1]}, k2 = {c2[e], c2[e + 1]}, kb = {bb[e], bb[e + 1]}, uu = {up[e], up[e + 1]};
          const f32x2 x = k0 * a + (k1 * b + (k2 * c + kb));
          const f32x2 u = x * x;
          const f32x2 t = x * (u * -0.1029432397f + -2.302208198f);
          f32x2 d; d.x = fexp2(t.x); d.y = fexp2(t.y); d = d + 1.0f;
          f32x2 r; r.x = __builtin_amdgcn_rcpf(d.x); r.y = __builtin_amdgcn_rcpf(d.y);
          const f32x2 y = (x * r) * uu;
          o[e] = y.x; o[e + 1] = y.y; }
        *(u32x4*)(ACT + (size_t)tok * DFF + f0) = pack8(o);
      }
    }
    __syncthreads();
  }
  DI void fused(pg8::f32x4 (&acc)[2][2][4][2], const pg8::Unit&, int wr, int wc, int fr, int fq, PG8_LAS unsigned char* lds3, int, int) const {
    char* lds = (char*)lds3; pass<0>(lds, acc, wr, wc, fr, fq); pass<1>(lds, acc, wr, wc, fr, fq); }
};

#define XB_TMO      128
#define XB_XCNT(j)  (256  + 64 * (j))
#define XB_XSUB(j)  (1280 + 64 * (j))
#define XB_XGEN(j)  (2304 + 64 * (j))
#define XB_TOP      3328
#define XB_TOPGEN   3392
#define XCD_BAR_WORDS 3456
#define XB_SPIN_CAP (1u << 22)

__device__ __forceinline__ unsigned xb_ld(unsigned* p)              { return __hip_atomic_load(p, __ATOMIC_RELAXED, __HIP_MEMORY_SCOPE_AGENT); }
__device__ __forceinline__ unsigned xb_add(unsigned* p, unsigned v) { return __hip_atomic_fetch_add(p, v, __ATOMIC_RELAXED, __HIP_MEMORY_SCOPE_AGENT); }
__device__ __forceinline__ unsigned xb_xcc_id() { return (unsigned)__builtin_amdgcn_s_getreg((3 << 11) | 20) & 0xFu; }
#define XB_SPIN(cond, bar) do { unsigned _sp = 0; while (cond) { __builtin_amdgcn_s_sleep(1); \
    if ((++_sp & 255u) == 0u) { if (xb_ld(&(bar)[XB_TMO])) break; if (_sp > XB_SPIN_CAP) { atomicAdd(&(bar)[XB_TMO], 1u); break; } } } } while (0)

struct XcdBarrier {
    unsigned* bar; unsigned x;
    volatile __attribute__((address_space(3))) unsigned* st;
};

__device__ __forceinline__ XcdBarrier xcd_barrier_post(unsigned* bar, volatile __attribute__((address_space(3))) unsigned* st) {
    XcdBarrier b; b.bar = bar; b.x = xb_xcc_id(); b.st = st;
    if (threadIdx.x == 0) (void)xb_add(&bar[XB_XCNT(b.x)], 1u);
    return b;
}
__device__ __forceinline__ void xcd_barrier_complete(unsigned* bar, unsigned x, unsigned& nloc, unsigned& nx) {
    const unsigned G = gridDim.x * gridDim.y * gridDim.z;
    unsigned sum, cnt, mine, sp = 0u;
    for (;;) {
        sum = 0u; cnt = 0u; mine = 0u;
#pragma unroll
        for (unsigned j = 0; j < 16; ++j) { const unsigned c = xb_ld(&bar[XB_XCNT(j)]); sum += c; cnt += (c > 0u) ? 1u : 0u; mine = (j == x) ? c : mine; }
        if (sum == G) break;
        __builtin_amdgcn_s_sleep(1);
        if ((++sp & 255u) == 0u) { if (xb_ld(&bar[XB_TMO])) break; if (sp > XB_SPIN_CAP) { atomicAdd(&bar[XB_TMO], 1u); break; } }
    }
    nloc = mine > 0u ? mine : 1u; nx = cnt > 0u ? cnt : 1u;
}

__device__ __forceinline__ void xcd_barrier(const XcdBarrier& b) {
    asm volatile("s_waitcnt vmcnt(0)" ::: "memory");
    __syncthreads();
    if (threadIdx.x == 0) {
        unsigned* bar = b.bar;
        __builtin_amdgcn_s_waitcnt(0);
        unsigned nloc = b.st[0], nx = b.st[1];
        if (nloc == 0u) { xcd_barrier_complete(bar, b.x, nloc, nx); b.st[0] = nloc; b.st[1] = nx; }
        const unsigned old = xb_add(&bar[XB_XSUB(b.x)], 1u);
        const unsigned gen = old / nloc;
        if (old + 1u == (gen + 1u) * nloc) {
            __builtin_amdgcn_fence(__ATOMIC_RELEASE, "agent");
            asm volatile("s_waitcnt vmcnt(0)" ::: "memory");
            const unsigned og = xb_add(&bar[XB_TOP], 1u);
            const unsigned tg = og / nx;
            if (og + 1u == (tg + 1u) * nx) xb_add(&bar[XB_TOPGEN], 1u);
            else XB_SPIN(xb_ld(&bar[XB_TOPGEN]) == tg, bar);
            __builtin_amdgcn_fence(__ATOMIC_ACQUIRE, "agent");
            xb_add(&bar[XB_XGEN(b.x)], 1u);
            asm volatile("s_waitcnt vmcnt(0)" ::: "memory");
        } else {
            XB_SPIN(xb_ld(&bar[XB_XGEN(b.x)]) == gen, bar);
            __builtin_amdgcn_fence(__ATOMIC_ACQUIRE, "agent");
            asm volatile("s_waitcnt vmcnt(0)" ::: "memory");
        }
    }
    __syncthreads();
}

DI bool tile_map(int round, int blk, int MTn, int NTn, int gm, int gn, int& mt, int& nt) {
  const int xcd = blk & 7, slot = blk >> 3, ngn = NTn / gn;
  const int gidx = round * 8 + xcd, mg = gidx / ngn, ng = gidx % ngn;
  mt = mg * gm + slot / gn; nt = ng * gn + slot % gn;
  return mt < MTn;
}
__global__ void __launch_bounds__(NTHREADS, 2) mega(Params p) {
  __shared__ __attribute__((aligned(16))) char lds[LDS_BYTES];
  __shared__ int s_item;
  __shared__ unsigned s_xb[2];
  const int nblk = gridDim.x, blk = blockIdx.x;
  if (threadIdx.x < 2) s_xb[threadIdx.x] = 0u;
  __syncthreads();
  const XcdBarrier xbar = xcd_barrier_post((unsigned*)(p.ws + WS_CTL) + 4096, (volatile __attribute__((address_space(3))) unsigned*)s_xb);
  for (int step = p.plo; step <= p.phi; ++step) {
  const int ph = p.seq[step];
  int tid = threadIdx.x; asm volatile("" : "+v"(tid));
  const int lane = tid & 63, w = tid >> 6, r32 = lane & 31, h = lane >> 5;
  size_t zoff = 0; asm volatile("" : "+s"(zoff));
  char* ws = p.ws + zoff;
  const char* tab = ws + WS_TAB;
  bf16_t* XN = (bf16_t*)(ws + WS_XN); bf16_t* OB = (bf16_t*)(ws + WS_O);
  bf16_t* QA = (bf16_t*)(ws + WS_QA); bf16_t* KA = (bf16_t*)(ws + WS_KA); bf16_t* VA = (bf16_t*)(ws + WS_VA);
  bf16_t* QB = (bf16_t*)(ws + WS_QB); bf16_t* KB = (bf16_t*)(ws + WS_KB); bf16_t* VB = (bf16_t*)(ws + WS_VB);
  bf16_t* ZC = (bf16_t*)(ws + WS_ZC); bf16_t* BF = (bf16_t*)(ws + WS_BF); bf16_t* PART = (bf16_t*)(ws + WS_PART); float* LSE = (float*)(ws + WS_LSE);
  bf16_t* MIX = (bf16_t*)(ws + WS_MIX); bf16_t* ACT = (bf16_t*)(ws + WS_ACT); bf16_t* FF = (bf16_t*)(ws + WS_FF); float* RS = (float*)(ws + WS_RS);
  unsigned* ctl = (unsigned*)(ws + WS_CTL);
  {
    if (ph == 0) { if (PHEN(0)) {
      const int gt = blk * NTHREADS + tid, gn = nblk * NTHREADS;
      for (int i = gt; i < 8192 * 8; i += gn) { const int pos = i >> 3, f = i & 7;
        const float inv[8] = {1.0f, 0.1939227432012558f, 0.03760603070259094f, 0.007292664609849453f, 0.0014142135623842478f, 0.00027424818836152554f, 5.3182957344688475e-05f, 1.0313385246263351e-05f};
        float iv = inv[0];
#pragma unroll
        for (int q = 1; q < 8; ++q) iv = (f == q) ? inv[q] : iv;
        const float ang = (float)pos * iv; float s, c; sincos_d((double)ang, s, c);
        ((float*)(tab + T_ROPET_C))[i] = c; ((float*)(tab + T_ROPET_S))[i] = s; }
      for (int i = gt; i < 192 * 16; i += gn) { const int pr = i >> 4, f = i & 15;
        const float inv[16] = {1.0f, 0.5623413324356079f, 0.3162277638912201f, 0.17782793939113617f, 0.10000000149011612f, 0.05623413249850273f, 0.03162277489900589f, 0.017782794311642647f,
                               0.009999999776482582f, 0.005623413249850273f, 0.003162277629598975f, 0.0017782794311642647f, 0.0010000000474974513f, 0.000562341301701963f, 0.0003162277571391314f, 0.00017782794020604342f};
        float iv = inv[0];
#pragma unroll
        for (int q = 1; q < 16; ++q) iv = (f == q) ? inv[q] : iv;
        const int pos = pr < 128 ? pr : pr - 128; const float ang = (float)pos * iv; float s, c; sincos_d((double)ang, s, c);
        if (pr < 128) { ((float*)(tab + T_ROPER_C))[pos * 16 + f] = c; ((float*)(tab + T_ROPER_S))[pos * 16 + f] = s; }
        else { ((float*)(tab + T_ROPEC_C))[pos * 16 + f] = c; ((float*)(tab + T_ROPEC_S))[pos * 16 + f] = s; } }
      for (int i = gt; i < 8192; i += gn) { float s, c; sincos_d(6.283185307179586476925286766559 * (double)i / 8192.0, s, c); ((float*)(tab + T_TW_C))[i] = c; ((float*)(tab + T_TW_S))[i] = s; }
      for (int i = gt; i < 128 * 128; i += gn) { const int a = i >> 7, b = i & 127; float s, c; sincos_d(6.283185307179586476925286766559 * (double)((a * b) & 127) / 128.0, s, c);
        ((bf16_t*)(tab + T_C128))[i] = (bf16_t)cvtpk(c, 0.f); ((bf16_t*)(tab + T_S128))[i] = (bf16_t)cvtpk(s, 0.f); }
      for (int i = gt; i < 64 * 64; i += gn) { const int a = i >> 6, b = i & 63; float s, c; sincos_d(6.283185307179586476925286766559 * (double)((a * b) & 63) / 64.0, s, c);
        ((bf16_t*)(tab + T_C64))[i] = (bf16_t)cvtpk(c, 0.f); ((bf16_t*)(tab + T_S64))[i] = (bf16_t)cvtpk(s, 0.f); }
      for (int i = gt; i < 32 * 32; i += gn) { const int a = i >> 5, b = i & 31; float s, c; sincos_d(6.283185307179586476925286766559 * (double)((a * b) & 31) / 32.0, s, c);
        ((bf16_t*)(tab + T_C32))[i] = (bf16_t)cvtpk(c, 0.f); ((bf16_t*)(tab + T_S32))[i] = (bf16_t)cvtpk(s, 0.f); }
      float* tl = (float*)lds;
      float* ctab = tl + 64 * 65;
      for (int it = blk; it < 2 * 3776; it += nblk) {
        const int l = it / 3776; int r = it % 3776;
        int mat, kt_, nt_;
        if (r < 384) { mat = 0; kt_ = r / 24; nt_ = r % 24; }
        else if (r < 640) { r -= 384; mat = 1; kt_ = r / 16; nt_ = r % 16; }
        else if (r < 1664) { r -= 640; mat = 2; kt_ = r / 64; nt_ = r % 64; }
        else if (r < 2688) { r -= 1664; mat = 3; kt_ = r / 64; nt_ = r % 64; }
        else if (r < 3712) { r -= 2688; mat = 4; kt_ = r / 16; nt_ = r % 16; }
        else { r -= 3712; mat = 5; kt_ = r / 4; nt_ = r % 4; }
        const float* src; int ld; const float* gain; bf16_t* dst; int dld;
        char* wl = ws + WS_W + (size_t)l * W_LAYER;
        int scol0 = nt_ * 64;
        if (mat == 0) { src = p.w_in + (size_t)l * DM * 1792; ld = 1792; gain = p.g_mix_pre + l * DM; dst = (bf16_t*)(wl + W_IN); dld = DM; }
        else if (mat == 1) { src = p.w_out + (size_t)l * DM * DM; ld = DM; gain = p.g_heads + l * DM; dst = (bf16_t*)(wl + W_OUT); dld = DM; }
        else if (mat == 2) { src = p.w_gate + (size_t)l * DM * DFF; ld = DFF; gain = p.g_ffn_pre + l * DM; dst = (bf16_t*)(wl + W_GU); dld = DM; }
        else if (mat == 3) { src = p.w_up + (size_t)l * DM * DFF; ld = DFF; gain = p.g_ffn_pre + l * DM; dst = (bf16_t*)(wl + W_GU); dld = DM; }
        else if (mat == 4) { src = p.w_down + (size_t)l * DFF * DM; ld = DM; gain = nullptr; dst = (bf16_t*)(wl + W_DOWN); dld = DFF; }
        else { src = p.w_in + (size_t)l * DM * 1792; ld = 1792; gain = p.g_mix_pre + l * DM; dst = (bf16_t*)(wl + W_IN); dld = DM; scol0 = 1536 + nt_ * 64; }
        const int k0 = kt_ * 64;
#pragma unroll
        for (int i = 0; i < 2; ++i) { const int kk = (tid >> 4) + 32 * i, n4 = (tid & 15) * 4; const f32x4 v = *(const f32x4*)(src + (size_t)(k0 + kk) * ld + scol0 + n4);
          tl[kk * 65 + n4] = v[0]; tl[kk * 65 + n4 + 1] = v[1]; tl[kk * 65 + n4 + 2] = v[2]; tl[kk * 65 + n4 + 3] = v[3]; }
        if (mat == 5 && tid < 64) { float s, c; sincos_d(6.283185307179586476925286766559 * (double)tid / 64.0, s, c); ctab[tid] = c; ctab[64 + tid] = s; }
        __syncthreads();
        if (mat != 5) {
          { const int nn = tid >> 3, k8 = (tid & 7) * 8;
            float v[8];
#pragma unroll
            for (int e = 0; e < 8; ++e) v[e] = tl[(k8 + e) * 65 + nn] * (gain ? gain[k0 + k8 + e] : 1.0f);
            int drow = nt_ * 64 + nn;
            if (mat == 2) drow = (nt_ >> 1) * 256 + (nt_ & 1) * 64 + nn; else if (mat == 3) drow = (nt_ >> 1) * 256 + 128 + (nt_ & 1) * 64 + nn;
            *(u32x4*)(dst + (size_t)drow * dld + k0 + k8) = pack8(v); }
        } else {
          for (int i = 0; i < 8; ++i) { const int idx = tid + 512 * i, np = idx >> 6, kk = idx & 63;
            const int ri = np > 32, cp = ri ? np - 32 : np; float a = 0.f;
            for (int c = 0; c < 64; ++c) { const int m = (c * cp) & 63; const float t = ri ? -ctab[64 + m] : ctab[m]; a += tl[kk * 65 + c] * t; }
            dst[(size_t)(1536 + nt_ * 64 + np) * dld + k0 + kk] = (bf16_t)cvtpk(a * gain[k0 + kk], 0.f); }
        }
        __syncthreads();
      }
#pragma unroll 2
      for (int row = blk * 8 + w; row < MT; row += nblk * 8) {
        const float* xr = row < MP ? p.x_prompt + (size_t)row * DM : p.x_sample + (size_t)(row - MP) * DM;
        rowpass(lane, nullptr, 0.f, xr, nullptr, nullptr, nullptr, XN + (size_t)row * DM, RS + row);
      }
    } } else {
      const int l = (ph - 1) >> 3, sub = (ph - 1) & 7;
      char* wl = ws + WS_W + (size_t)l * W_LAYER;
      if (sub == 0 && PHEN(1)) {
        const bf16_t* Bt = (const bf16_t*)(wl + W_IN);
        for (int vr = blk; vr < 256 * 9; vr += nblk) { const int rnd = vr >> 8, vb = vr & 255;
          int mt, nt; if (!tile_map(rnd, vb, 320, 7, 32, 1, mt, nt)) continue;
          const pg8::Gemm g{XN, Bt, MT, NIN, DM};
          const OneUnit S1{(long)mt * 256, nt};
          const EpiP1 E{tid, mt * 256, nt, ws, p.g_q + l * 64, p.g_k + l * 64};
          pg8::gemm_phase<EpiP1, OneUnit, false, true>((PG8_LAS unsigned char*)lds, g, S1, E);
        }
      } else if (sub == 1 && PHEN(2)) {
        unsigned* ctr = ctl + 64 * (1 + step);
        for (;;) {
          if (tid == 0) s_item = (int)atomicAdd(ctr, 1u);
          __syncthreads();
          const int it = s_item;
          __syncthreads();
          if (it >= 8960) break;
          int tid_item = tid; asm volatile("" : "+v"(tid_item));
          { const int tid = tid_item, lane = tid & 63, w = tid >> 6, r32 = lane & 31, h = lane >> 5;
          if (it < 2560) {
            int seq, kvh, qblk, rh;
            if (it < 2048) { const int combo = it >> 7, wi = it & 127; seq = combo >> 1; kvh = combo & 1; qblk = wi >> 2; rh = wi & 3; }
            else { const int i2 = it - 2048; const int combo = i2 >> 6, wi = i2 & 63; seq = 8 + (combo >> 1); kvh = combo & 1; qblk = wi >> 2; rh = wi & 3; }
            int base, S; seq_info(seq, base, S);
            const int hq = kvh * 4 + rh;
            f32x16 O[2]; float m_run, l_run;
            float gk = __builtin_fabsf(p.g_k[l * 64 + lane]);
#pragma unroll
            for (int o = 32; o >= 1; o >>= 1) gk = __builtin_fmaxf(gk, __shfl_xor(gk, o));
            flash_grid(lds, tid, QB + hq * 64, KB + kvh * 64, VB + kvh * 64, base, qblk * 256, S >> 6, gk * 8.0f * 1.01f, O, l_run); m_run = 0.f;
            const float lt = l_run + __shfl_xor(l_run, 32); const float inv = 1.0f / lt;
            float ss = 0.f;
#pragma unroll
            for (int r = 0; r < 16; ++r) { O[0][r] *= inv; O[1][r] *= inv; ss += O[0][r] * O[0][r] + O[1][r] * O[1][r]; }
            ss += __shfl_xor(ss, 32);
            const float rr = rsqrtf(ss * (1.0f / 64.0f) + EPS);
            const int tok = base + qblk * 256 + 32 * w + r32;
            bf16_t* orow = OB + (size_t)tok * DM + 256 + hq * 64;
#pragma unroll
            for (int db = 0; db < 2; ++db)
#pragma unroll
              for (int g4 = 0; g4 < 4; ++g4) { u32x2 wv; wv[0] = cvtpk(O[db][4 * g4] * rr, O[db][4 * g4 + 1] * rr); wv[1] = cvtpk(O[db][4 * g4 + 2] * rr, O[db][4 * g4 + 3] * rr);
                *(u32x2*)(orow + 32 * db + 8 * g4 + 4 * h) = wv; }
          } else if (it < 6400) {
            const int i2 = it - 2560; const int pat = i2 / 1280; const int rem = i2 % 1280; const int head = rem & 3; const int tb = rem >> 2;
            int seq, ub; if (tb < 256) { seq = tb >> 5; ub = tb & 31; } else { seq = 8 + ((tb - 256) >> 4); ub = (tb - 256) & 15; }
            int base, S; seq_info(seq, base, S);
            const int dil = pat == 0 ? 1 : (pat == 1 ? 4 : 16); const int L = S / dil;
            const int u0 = ub * 256; const int res = u0 / L; const int i0 = u0 % L;
            f32x16 O[2]; float m_run, l_run;
            flash_dil(lds, tid, QA + head * 64, KA + head * 64, VA + head * 64, base + res, dil, L, i0, O, m_run, l_run);
            const float lt = l_run + __shfl_xor(l_run, 32); const float inv = 1.0f / lt;
            const int tok = base + res + dil * (i0 + 32 * w + r32);
            bf16_t* orow = PART + ((size_t)pat * MT + tok) * 256 + head * 64;
#pragma unroll
            for (int db = 0; db < 2; ++db)
#pragma unroll
              for (int g4 = 0; g4 < 4; ++g4) { u32x2 wv; wv[0] = cvtpk(O[db][4 * g4] * inv, O[db][4 * g4 + 1] * inv); wv[1] = cvtpk(O[db][4 * g4 + 2] * inv, O[db][4 * g4 + 3] * inv);
                *(u32x2*)(orow + 32 * db + 8 * g4 + 4 * h) = wv; }
            if (h == 0) LSE[((size_t)pat * MT + tok) * 4 + head] = m_run + __log2f(lt);
          } else {
            const int i2 = it - 6400; const int g = i2 & 3; const int mt = i2 >> 2;
            int seq, s2, S2; if (mt < 512) { seq = mt >> 6; s2 = mt & 63; S2 = 64; } else { seq = 8 + ((mt - 512) >> 5); s2 = (mt - 512) & 31; S2 = 32; }
            int base, S; seq_info(seq, base, S);
            { const int row = tid >> 2, q4 = tid & 3;
              const bf16_t* src = ZC + (size_t)(base + S2 * row + s2) * 256 + g * 64 + 16 * q4;
              const u32x4 v0 = *(const u32x4*)src, v1 = *(const u32x4*)(src + 8);
              bf16_t* trow = (bf16_t*)(lds + row * 320);
#pragma unroll
              for (int k = 0; k < 16; ++k) { const unsigned wd = (k < 8) ? v0[k >> 1] : v1[(k - 8) >> 1]; const bf16_t v = (bf16_t)((k & 1) ? (wd >> 16) : (wd & 0xffffu));
                const int j = 16 * q4 + k;
                if (j <= 32) { trow[j] = v; if (j >= 1 && j <= 31) trow[64 - j] = v; if (j == 0) trow[64] = 0; if (j == 32) trow[96] = 0; }
                else { const int cp = j - 32; trow[64 + cp] = v; trow[128 - cp] = (bf16_t)(v ^ 0x8000u); } } }
            __syncthreads();
            const int kb1 = w & 3, nb = w >> 2;
            f32x16 Ar = zero16(), Ai = zero16();
            const bf16_t* C1 = (const bf16_t*)(tab + T_C128) + (32 * kb1 + r32) * 128 + 8 * h; const bf16_t* S1t = (const bf16_t*)(tab + T_S128) + (32 * kb1 + r32) * 128 + 8 * h;
#pragma unroll
            for (int ks = 0; ks < 8; ++ks) {
              const bf16x8 aC = *(const bf16x8*)(C1 + 16 * ks), aS = *(const bf16x8*)(S1t + 16 * ks);
              const int rowA = 16 * ks + 8 * h;
              const bf16x8 zr = tr_frag(lds, 320, rowA, rowA + 4, nb * 32, lane), zi = tr_frag(lds, 320, rowA, rowA + 4, 64 + nb * 32, lane);
              const bf16x8 zrn = zr ^ (short)0x8000;
              Ar = mfma32(aC, zr, Ar); Ar = mfma32(aS, zi, Ar);
              Ai = mfma32(aC, zi, Ai); Ai = mfma32(aS, zrn, Ai);
            }
            const int twm = 8192 / S;
#pragma unroll
            for (int r = 0; r < 16; ++r) { const int k1 = 32 * kb1 + crow(r, h); const int ai = ((k1 * s2) & (S - 1)) * twm;
              const float cs = ((const float*)(tab + T_TW_C))[ai], sn = ((const float*)(tab + T_TW_S))[ai];
              bf16_t* orow = BF + (size_t)(base + k1 * S2 + s2) * 512 + g * 128;
              const float br = Ar[r] * cs + Ai[r] * sn, bi = Ai[r] * cs - Ar[r] * sn;
              orow[nb * 32 + r32] = (bf16_t)cvtpk(br, 0.f); orow[64 + nb * 32 + r32] = (bf16_t)cvtpk(bi, 0.f); }
            __syncthreads();
          }
          }
        }
      } else if (sub == 2 && PHEN(3)) {
        for (int it = blk; it < 1536 + 1280; it += nblk) {
          if (it < 1536) {
            int seq, kq, g, S2;
            if (it < 1024) { seq = it >> 7; kq = (it >> 2) & 31; g = it & 3; S2 = 64; } else { const int i2 = it - 1024; seq = 8 + (i2 >> 7); kq = (i2 >> 2) & 31; g = i2 & 3; S2 = 32; }
            int base, S; seq_info(seq, base, S);
            const int nch = 4 * S2 * 16;
            for (int c = tid; c < nch; c += 512) { const int sb = c / (S2 * 16), rc = c % (S2 * 16), row = rc >> 4, ch = rc & 15;
              *(u32x4*)(lds + sb * 20480 + row * 320 + ch * 16) = *(const u32x4*)(BF + (size_t)(base + (4 * kq + sb) * S2 + row) * 512 + g * 128 + ch * 8); }
            __syncthreads();
            const bool act = (S2 == 64) || (w < 4);
            if (act) {
              const int sb = (S2 == 64) ? (w >> 1) : w, mb = (S2 == 64) ? (w & 1) : 0;
              const char* tile = lds + sb * 20480;
              const bf16_t* Ct = (const bf16_t*)(tab + (S2 == 64 ? T_C64 : T_C32)) + (32 * mb + r32) * S2 + 8 * h;
              const bf16_t* St = (const bf16_t*)(tab + (S2 == 64 ? T_S64 : T_S32)) + (32 * mb + r32) * S2 + 8 * h;
              f32x16 Y[2]; Y[0] = zero16(); Y[1] = zero16();
              const int nks = S2 >> 4;
              for (int ks = 0; ks < nks; ++ks) {
                const bf16x8 aC = *(const bf16x8*)(Ct + 16 * ks), aS = *(const bf16x8*)(St + 16 * ks);
                const int rowA = 16 * ks + 8 * h;
#pragma unroll
                for (int nb = 0; nb < 2; ++nb) { const bf16x8 br = tr_frag(tile, 320, rowA, rowA + 4, nb * 32, lane), bi = tr_frag(tile, 320, rowA, rowA + 4, 64 + nb * 32, lane);
                  Y[nb] = mfma32(aC, br, Y[nb]); Y[nb] = mfma32(aS, bi, Y[nb]); }
              }
              const int k1 = 4 * kq + sb;
#pragma unroll
              for (int r = 0; r < 16; ++r) { float ss = Y[0][r] * Y[0][r] + Y[1][r] * Y[1][r];
                ss += __shfl_xor(ss, 1); ss += __shfl_xor(ss, 2); ss += __shfl_xor(ss, 4); ss += __shfl_xor(ss, 8); ss += __shfl_xor(ss, 16);
                const float rr = rsqrtf(ss * (1.0f / 64.0f) + EPS);
                const int tok = base + k1 + 128 * (32 * mb + crow(r, h));
                bf16_t* orow = OB + (size_t)tok * DM + 768 + g * 64;
                orow[r32] = (bf16_t)cvtpk(Y[0][r] * rr, 0.f); orow[32 + r32] = (bf16_t)cvtpk(Y[1][r] * rr, 0.f); }
            }
            __syncthreads();
          } else {
            const int t0 = (it - 1536) * 64;
            for (int pp = 0; pp < 4; ++pp) { const int idx = pp * 512 + tid; const int tok = t0 + (idx >> 5), head = (idx >> 3) & 3, dch = idx & 7;
              float ls[3]; u32x4 pv[3];
#pragma unroll
              for (int q = 0; q < 3; ++q) { ls[q] = LSE[((size_t)q * MT + tok) * 4 + head]; pv[q] = *(const u32x4*)(PART + ((size_t)q * MT + tok) * 256 + head * 64 + dch * 8); }
              const float mx = fmaxf(ls[0], fmaxf(ls[1], ls[2]));
              float wq[3]; float wsum = 0.f;
#pragma unroll
              for (int q = 0; q < 3; ++q) { wq[q] = fexp2(ls[q] - mx); wsum += wq[q]; }
              const float iw = 1.0f / wsum;
              float o[8];
#pragma unroll
              for (int e = 0; e < 8; ++e) o[e] = 0.f;
#pragma unroll
              for (int q = 0; q < 3; ++q) { const float ww = wq[q] * iw;
#pragma unroll
                for (int e2 = 0; e2 < 4; ++e2) { o[2 * e2] += ww * bflo(pv[q][e2]); o[2 * e2 + 1] += ww * bfhi(pv[q][e2]); } }
              float ss = 0.f;
#pragma unroll
              for (int e = 0; e < 8; ++e) ss += o[e] * o[e];
              ss += __shfl_xor(ss, 1); ss += __shfl_xor(ss, 2); ss += __shfl_xor(ss, 4);
              const float rr = rsqrtf(ss * (1.0f / 64.0f) + EPS);
#pragma unroll
              for (int e = 0; e < 8; ++e) o[e] *= rr;
              *(u32x4*)(OB + (size_t)tok * DM + head * 64 + dch * 8) = pack8(o); }
          }
        }
      } else if ((sub == 3 || sub == 6) && PHEN(4)) {
        const bf16_t* A = (sub == 3) ? OB : ACT; const int K = (sub == 3) ? DM : DFF;
        const bf16_t* Bt = (const bf16_t*)(wl + (sub == 3 ? W_OUT : W_DOWN));
        bf16_t* dst = (sub == 3) ? MIX : FF;
        for (int vr = blk; vr < 256 * 5; vr += nblk) { const int rnd = vr >> 8, vb = vr & 255;
          int mt, nt; if (!tile_map(rnd, vb, 320, 4, 8, 4, mt, nt)) continue;
          const pg8::Gemm g{A, Bt, MT, DM, K};
          const OneUnit S1{(long)mt * 256, nt};
          const EpiPlain E{tid, mt * 256, nt * 256, dst, tab};
          pg8::gemm_phase<EpiPlain, OneUnit, false, true>((PG8_LAS unsigned char*)lds, g, S1, E);
        }
      } else if ((sub == 4 || sub == 7) && PHEN(5)) {
        const bool first = (sub == 4);
        const float* gpost = (first ? p.g_mix_post : p.g_ffn_post) + l * DM;
        const bf16_t* add = first ? MIX : FF;
        const bool need_xn = !(l == 1 && sub == 7);
#pragma unroll 4
      for (int row = blk * 8 + w; row < MT; row += nblk * 8) {
          const bool last = (l == 1 && sub == 7);
          rowpass(lane, XN + (size_t)row * DM, RS[row], nullptr, add + (size_t)row * DM, gpost, last ? p.out + (size_t)row * DM : nullptr, last ? nullptr : XN + (size_t)row * DM, RS + row);
        }
      } else if (sub == 5 && PHEN(6)) {
        const bf16_t* Bt = (const bf16_t*)(wl + W_GU);
        const float* cw = p.conv_w + (size_t)l * 3 * DFF; const float* cb = p.conv_b + (size_t)l * DFF;
        for (int vr = blk; vr < 256 * 41; vr += nblk) { const int rnd = vr >> 8, vb = vr & 255;
          int mt, nt; if (!tile_map(rnd, vb, 323, 32, 4, 8, mt, nt)) continue;
          const int p0 = 254 * mt - 1;
          const pg8::Gemm g{XN, Bt, MT, 2 * DFF, DM};
          const OneUnit S1{(long)p0, nt};
          const EpiP4 E{tid, p0, nt, cw, cb, ACT};
          pg8::gemm_phase<EpiP4, OneUnit, false, true>((PG8_LAS unsigned char*)lds, g, S1, E);
        }
      }
    }
  }
    if (step < p.phi) { if (step == p.plo) cg::this_grid().sync(); else xcd_barrier(xbar); }
  }
}

extern "C" void kernel_launch(void* const* d_in, const int* in_sizes, int n_in, void* d_out, int out_size, void* d_ws, size_t ws_size, hipStream_t stream) {
  (void)in_sizes; (void)n_in; (void)out_size; (void)ws_size;
  static int grid_blocks = 0;
  if (!grid_blocks) {
    int dev = 0, cus = 0, per_cu = 0;
    hipGetDevice(&dev);
    hipDeviceGetAttribute(&cus, hipDeviceAttributeMultiprocessorCount, dev);
    hipOccupancyMaxActiveBlocksPerMultiprocessor(&per_cu, mega, NTHREADS, 0);
    if (per_cu > 1) per_cu = 1;
    if (per_cu < 1) per_cu = 1;
    grid_blocks = cus * per_cu; if (grid_blocks > 256) grid_blocks = 256;
  }
  Params p{};
  p.x_prompt = (const float*)d_in[0]; p.x_sample = (const float*)d_in[1];
  p.g_mix_pre = (const float*)d_in[2]; p.g_mix_post = (const float*)d_in[3]; p.w_in = (const float*)d_in[4]; p.g_q = (const float*)d_in[5]; p.g_k = (const float*)d_in[6];
  p.g_heads = (const float*)d_in[7]; p.w_out = (const float*)d_in[8]; p.g_ffn_pre = (const float*)d_in[9]; p.g_ffn_post = (const float*)d_in[10];
  p.w_gate = (const float*)d_in[11]; p.w_up = (const float*)d_in[12]; p.conv_w = (const float*)d_in[13]; p.conv_b = (const float*)d_in[14]; p.w_down = (const float*)d_in[15];
  p.out = (float*)d_out; p.ws = (char*)d_ws;
  hipMemsetAsync(d_ws, 0, 65536, stream);
#if MULTI_LAUNCH
  for (int ph = 0; ph <= 16; ++ph) p.seq[ph] = ph;
  for (int ph = 0; ph <= 16; ++ph) { p.plo = ph; p.phi = ph; hipLaunchKernelGGL(mega, dim3(grid_blocks), dim3(NTHREADS), 0, stream, p); }
#else
  int ns = 0;
  for (int ph = 0; ph <= 16; ++ph) { p.seq[ns++] = ph; if (ph >= 1 && ((ph - 1) & 7) == DUPSUB) p.seq[ns++] = ph; if (ph == DUPPH) p.seq[ns++] = ph; }
  p.plo = 0; p.phi = ns - 1;
  void* args[] = {&p};
  hipError_t e = hipLaunchCooperativeKernel((void*)mega, dim3(grid_blocks), dim3(NTHREADS), args, 0, stream);
  if (e != hipSuccess) fprintf(stderr, "cooperative launch failed: %s (grid %d)\n", hipGetErrorString(e), grid_blocks);
#endif
}
```

```cpp
#include <hip/hip_runtime.h>
#include <hip/hip_cooperative_groups.h>
#include <cstdio>
#include <cstdint>
namespace cg = cooperative_groups;

#define DI __device__ __forceinline__
typedef unsigned short bf16_t;
typedef short bf16x8 __attribute__((ext_vector_type(8)));
typedef short s16x4 __attribute__((ext_vector_type(4)));
typedef float f32x16 __attribute__((ext_vector_type(16)));
typedef float f32x4 __attribute__((ext_vector_type(4)));
typedef float f32x2 __attribute__((ext_vector_type(2)));
typedef unsigned u32x4 __attribute__((ext_vector_type(4)));
typedef unsigned u32x2 __attribute__((ext_vector_type(2)));
typedef __bf16 bf16x2_t __attribute__((ext_vector_type(2)));
typedef short v4i16_t __attribute__((ext_vector_type(4)));

#ifndef USE_TR
#define USE_TR 1
#endif
#ifndef PHMASK
#define PHMASK 0x1ff
#endif
#define PHEN(b) ((PHMASK>>(b))&1)
#ifndef DUPSUB
#define DUPSUB -1
#endif
#ifndef DUPPH
#define DUPPH -1
#endif
#ifndef MULTI_LAUNCH
#define MULTI_LAUNCH 0
#endif

constexpr int DM = 1024, DFF = 4096;
constexpr int MP = 65536, MS = 16384, MT = MP + MS;
constexpr int NIN = 1792;
constexpr float EPS = 1e-6f;
constexpr float QSCALE = 0.125f * 1.4426950408889634f;
constexpr int NTHREADS = 512;
constexpr int CST = 260;
constexpr int LDS_BYTES = 129 * CST * 4;

constexpr size_t MiB = 1ull << 20;
constexpr size_t WS_CTL = 0;
constexpr size_t WS_TAB = 1 * MiB;
constexpr size_t WS_W = 4 * MiB;
constexpr size_t W_LAYER = 30 * MiB, W_IN = 0, W_OUT = 4 * MiB, W_GU = 6 * MiB, W_DOWN = 22 * MiB;
constexpr size_t WS_XN = 64 * MiB;
constexpr size_t WS_O = 224 * MiB;
constexpr size_t WS_QA = 384 * MiB, WS_KA = 424 * MiB, WS_VA = 464 * MiB, WS_QB = 504 * MiB, WS_KB = 584 * MiB, WS_VB = 604 * MiB;
constexpr size_t WS_ZC = 624 * MiB, WS_BF = 704 * MiB, WS_PART = 784 * MiB, WS_LSE = 904 * MiB;
constexpr size_t WS_MIX = 384 * MiB;
constexpr size_t WS_ACT = 224 * MiB;
constexpr size_t WS_FF = 864 * MiB;
constexpr size_t WS_RS = 3 * MiB;
constexpr size_t WS_END = 1024 * MiB;
constexpr size_t T_ROPET_C = 0, T_ROPET_S = 256 * 1024;
constexpr size_t T_ROPER_C = 512 * 1024, T_ROPER_S = T_ROPER_C + 8192;
constexpr size_t T_ROPEC_C = T_ROPER_S + 8192, T_ROPEC_S = T_ROPEC_C + 4096;
constexpr size_t T_TW_C = 640 * 1024, T_TW_S = T_TW_C + 32768;
constexpr size_t T_C128 = 768 * 1024, T_S128 = T_C128 + 32768;
constexpr size_t T_C64 = T_S128 + 32768, T_S64 = T_C64 + 8192;
constexpr size_t T_C32 = T_S64 + 8192, T_S32 = T_C32 + 2048;

struct Params {
  const float* x_prompt; const float* x_sample;
  const float* g_mix_pre; const float* g_mix_post; const float* w_in; const float* g_q; const float* g_k; const float* g_heads; const float* w_out;
  const float* g_ffn_pre; const float* g_ffn_post; const float* w_gate; const float* w_up; const float* conv_w; const float* conv_b; const float* w_down;
  float* out; char* ws;
  int plo, phi;
  int seq[30];
};

DI unsigned cvtpk(float lo, float hi) { f32x2 v = {lo, hi}; bf16x2_t b = __builtin_convertvector(v, bf16x2_t); return __builtin_bit_cast(unsigned, b); }
DI float bflo(unsigned u) { return __uint_as_float(u << 16); }
DI float bfhi(unsigned u) { return __uint_as_float(u & 0xffff0000u); }
DI int crow(int reg, int h) { return (reg & 3) + 8 * (reg >> 2) + 4 * h; }
DI f32x16 mfma32(bf16x8 a, bf16x8 b, f32x16 c) { return __builtin_amdgcn_mfma_f32_32x32x16_bf16(a, b, c, 0, 0, 0); }
DI float fexp2(float x) { return __builtin_amdgcn_exp2f(x); }
DI f32x16 zero16() { f32x16 z;
#pragma unroll
  for (int i = 0; i < 16; ++i) z[i] = 0.f; return z; }
DI int seq_of_token(int tok, int& base, int& S) { if (tok < MP) { int s = tok >> 13; base = s << 13; S = 8192; return s; } int j = (tok - MP) >> 12; base = MP + (j << 12); S = 4096; return 8 + j; }
DI void seq_info(int seq, int& base, int& S) { if (seq < 8) { base = seq << 13; S = 8192; } else { base = MP + ((seq - 8) << 12); S = 4096; } }

DI void sincos_d(double a, float& s, float& c) {
  const double TWO_PI = 6.283185307179586476925286766559;
  a -= TWO_PI * __builtin_rint(a / TWO_PI);
  const double x2 = a * a;
  double ts = 1.0, tc = 1.0, ss = 1.0, cc = 1.0;
#pragma unroll
  for (int n = 1; n <= 13; ++n) { tc *= -x2 / (double)((2 * n - 1) * (2 * n)); ts *= -x2 / (double)((2 * n) * (2 * n + 1)); cc += tc; ss += ts; }
  s = (float)(a * ss); c = (float)cc;
}

DI bf16x8 tr_frag(const char* tile, int rs, int rowA, int rowB, int n0, int lane) {
#if USE_TR
  const int i16 = lane & 15, q4 = i16 >> 2, p4 = i16 & 3, nh = (lane >> 4) & 1;
  const char* a1 = tile + (rowA + q4) * rs + (n0 + 16 * nh + 4 * p4) * 2;
  const char* a2 = tile + (rowB + q4) * rs + (n0 + 16 * nh + 4 * p4) * 2;
  v4i16_t lo = __builtin_amdgcn_ds_read_tr16_b64_v4i16((__attribute__((address_space(3))) v4i16_t*)a1);
  v4i16_t hi = __builtin_amdgcn_ds_read_tr16_b64_v4i16((__attribute__((address_space(3))) v4i16_t*)a2);
  return (bf16x8){lo[0], lo[1], lo[2], lo[3], hi[0], hi[1], hi[2], hi[3]};
#else
  const int c = n0 + (lane & 31);
  bf16x8 f;
#pragma unroll
  for (int j = 0; j < 4; ++j) { f[j] = *(const short*)(tile + (rowA + j) * rs + c * 2); f[4 + j] = *(const short*)(tile + (rowB + j) * rs + c * 2); }
  return f;
#endif
}

DI float wave_sum(float v) {
#pragma unroll
  for (int o = 32; o >= 1; o >>= 1) v += __shfl_xor(v, o);
  return v;
}

DI void rowpass(int lane, const bf16_t* xn_in_row, float s_in, const float* xin_row, const bf16_t* add_row, const float* gpost, float* xout_row, bf16_t* xn_row, float* s_out) {
  float x[16];
  if (xin_row) {
#pragma unroll
    for (int i = 0; i < 4; ++i) { const f32x4 v = *(const f32x4*)(xin_row + i * 256 + lane * 4); x[4 * i] = v[0]; x[4 * i + 1] = v[1]; x[4 * i + 2] = v[2]; x[4 * i + 3] = v[3]; }
  } else {
#pragma unroll
    for (int i = 0; i < 4; ++i) { const u32x2 v = *(const u32x2*)(xn_in_row + i * 256 + lane * 4); x[4 * i] = bflo(v[0]) * s_in; x[4 * i + 1] = bfhi(v[0]) * s_in; x[4 * i + 2] = bflo(v[1]) * s_in; x[4 * i + 3] = bfhi(v[1]) * s_in; }
  }
  if (add_row) {
    float a[16]; float ss = 0.f;
#pragma unroll
    for (int i = 0; i < 4; ++i) { const u32x2 v = *(const u32x2*)(add_row + i * 256 + lane * 4); a[4 * i] = bflo(v[0]); a[4 * i + 1] = bfhi(v[0]); a[4 * i + 2] = bflo(v[1]); a[4 * i + 3] = bfhi(v[1]); }
#pragma unroll
    for (int i = 0; i < 16; ++i) ss += a[i] * a[i];
    ss = wave_sum(ss);
    const float ra = rsqrtf(ss * (1.0f / 1024.0f) + EPS);
#pragma unroll
    for (int i = 0; i < 4; ++i) { const f32x4 g = *(const f32x4*)(gpost + i * 256 + lane * 4);
#pragma unroll
      for (int e = 0; e < 4; ++e) x[4 * i + e] += a[4 * i + e] * ra * g[e]; }
  }
  if (xout_row) {
#pragma unroll
    for (int i = 0; i < 4; ++i) *(f32x4*)(xout_row + i * 256 + lane * 4) = (f32x4){x[4 * i], x[4 * i + 1], x[4 * i + 2], x[4 * i + 3]};
  }
  if (xn_row) {
    float ss = 0.f;
#pragma unroll
    for (int i = 0; i < 16; ++i) ss += x[i] * x[i];
    ss = wave_sum(ss);
    const float ms = ss * (1.0f / 1024.0f) + EPS;
    const float rx = rsqrtf(ms);
#pragma unroll
    for (int i = 0; i < 4; ++i) { u32x2 w; w[0] = cvtpk(x[4 * i] * rx, x[4 * i + 1] * rx); w[1] = cvtpk(x[4 * i + 2] * rx, x[4 * i + 3] * rx); *(u32x2*)(xn_row + i * 256 + lane * 4) = w; }
    if (lane == 0) *s_out = __builtin_sqrtf(ms);
  }
}

namespace pg8 {
#define PG8_LAS __attribute__((address_space(3)))
typedef unsigned short bf16_t;
typedef short bf16x8 __attribute__((ext_vector_type(8)));
typedef float f32x4 __attribute__((ext_vector_type(4)));
typedef unsigned u32x4 __attribute__((ext_vector_type(4)));
constexpr int BM = 256, BK = 64, HALF = 128, HTB = HALF * BK * 2  , STAGE_BYTES = 8 * HTB, NXCD = 8, WGM = 8;

__host__ __device__ __forceinline__ int lds_byte(int r, int c) { const int st = (r >> 4) * 2 + (c >> 5), rr = r & 15, cc = c & 31, ob = rr * 64 + cc * 2; return st * 1024 + (ob ^ (((ob >> 9) & 1) << 5)); }
__host__ __device__ __forceinline__ void stage_rc(int b, int& R, int& C) { const int st = b / 1024, sb = b % 1024, swz = sb ^ (((sb >> 9) & 1) << 5); R = (st >> 1) * 16 + swz / 64; C = (st & 1) * 32 + (swz % 64) / 2; }
__host__ __device__ __forceinline__ int perm32(int rho) { const int n = rho >> 4, i = rho & 15; return 8 * (i >> 2) + 4 * n + (i & 3); }

struct Unit { int pm, pn; long arow; };
struct Gemm { const bf16_t* A; const bf16_t* Bt; int M, N, K; };
template <class Epi, class Sched, bool ALIGN_EPI = false, bool SP2 = false>
__device__ __forceinline__ void gemm_phase(PG8_LAS unsigned char* lds, const Gemm g, const Sched& S, const Epi& E) {
    int tid_ = threadIdx.x; asm volatile("" : "+v"(tid_));
    const int tid = tid_, wid = __builtin_amdgcn_readfirstlane(tid >> 6), lane = tid & 63, wr = wid >> 2, wc = wid & 3, fr = lane & 15, fq = lane >> 4;
    const int K = g.K, nt = K / BK;
    unsigned voffA[2], voffB[2];
#pragma unroll
    for (int i = 0; i < 2; ++i) { int R, C; stage_rc(tid * 16 + i * 8192, R, C); const int Rb = Epi::PERM ? ((R & ~31) + perm32(R & 31)) : R;
        voffA[i] = (unsigned)(R * K + C) * 2u; voffB[i] = (unsigned)(Rb * K + C) * 2u; }
    const size_t kstep = (size_t)(BK * 2);
    const size_t hstep = (size_t)HALF * K * 2;
    const size_t tstep = 2 * hstep;
    const unsigned ldsw = (unsigned)wid * 1024u;
    const int aoff = lds_byte(wr * 64 + fr, fq * 8), boff = lds_byte(wc * 32 + fr, fq * 8);
#define PG8_SA(b, h) (((b) * 2 + (h)) * HTB)
#define PG8_SB(b, h) ((4 + (b) * 2 + (h)) * HTB)
#define PG8_STAGE(bufoff, gbase, voff) do { _Pragma("unroll") for (int _i = 0; _i < 2; ++_i) \
        __builtin_amdgcn_global_load_lds((const unsigned*)((const char*)(gbase) + (voff)[_i]), (PG8_LAS unsigned*)(lds + (bufoff) + ldsw + _i * 8192), 16, 0, 0); } while (0)
#define PG8_LDA(dst, b, h) do { _Pragma("unroll") for (int m = 0; m < 4; ++m) _Pragma("unroll") for (int k = 0; k < 2; ++k) dst[m][k] = *(const PG8_LAS bf16x8*)(lds + PG8_SA(b, h) + aoff + m * 2048 + k * 1024); } while (0)
#define PG8_LDB(dst, b, h) do { _Pragma("unroll") for (int n = 0; n < 2; ++n) _Pragma("unroll") for (int k = 0; k < 2; ++k) dst[n][k] = *(const PG8_LAS bf16x8*)(lds + PG8_SB(b, h) + boff + n * 2048 + k * 1024); } while (0)
#define PG8_MMA(ai, bj, At, Bt) do { __builtin_amdgcn_s_setprio(1); _Pragma("unroll") for (int m = 0; m < 4; ++m) _Pragma("unroll") for (int n = 0; n < 2; ++n) _Pragma("unroll") for (int k = 0; k < 2; ++k) \
        acc[ai][bj][m][n] = __builtin_amdgcn_mfma_f32_16x16x32_bf16(Bt[n][k], At[m][k], acc[ai][bj][m][n], 0, 0, 0); __builtin_amdgcn_s_setprio(0); } while (0)
#define PG8_WAIT_V(n) asm volatile("s_waitcnt vmcnt(" #n ")" ::: "memory")
#define PG8_WAIT_L(n) asm volatile("s_waitcnt lgkmcnt(" #n ")" ::: "memory")
#define PG8_BAR __builtin_amdgcn_s_barrier()
#define PG8_SCHED __builtin_amdgcn_sched_barrier(0)
    Unit cur, nxt; int ui = 0;
    if (!S.next(0, cur)) return;
    f32x4 acc[2][2][4][2];
#pragma unroll
    for (int a = 0; a < 2; ++a)
#pragma unroll
        for (int b = 0; b < 2; ++b)
#pragma unroll
            for (int m = 0; m < 4; ++m)
#pragma unroll
                for (int n = 0; n < 2; ++n) acc[a][b][m][n] = (f32x4){0.f, 0.f, 0.f, 0.f};
    bf16x8 At[4][2], B0[2][2], B1[2][2];
    const char* cA = (const char*)g.A + cur.arow * (long)(K * 2); const char* cB = (const char*)g.Bt + (size_t)cur.pn * tstep;
    S.a_ready(cur);
    if constexpr (SP2) {
        PG8_STAGE(PG8_SB(0, 0), cB, voffB); PG8_STAGE(PG8_SB(0, 1), cB + hstep, voffB); PG8_STAGE(PG8_SA(0, 0), cA, voffA); PG8_STAGE(PG8_SA(0, 1), cA + hstep, voffA);
        if (wr == 1) PG8_BAR;
        PG8_WAIT_V(2); PG8_BAR;
        PG8_STAGE(PG8_SB(1, 0), cB + kstep, voffB); PG8_STAGE(PG8_SA(1, 0), cA + kstep, voffA); PG8_STAGE(PG8_SB(1, 1), cB + hstep + kstep, voffB);
        PG8_WAIT_V(6); PG8_BAR;
    } else {
        PG8_STAGE(PG8_SB(0, 0), cB, voffB); PG8_STAGE(PG8_SA(0, 0), cA, voffA); PG8_STAGE(PG8_SB(0, 1), cB + hstep, voffB); PG8_STAGE(PG8_SA(0, 1), cA + hstep, voffA);
        if (wr == 1) PG8_BAR;
        PG8_WAIT_V(4); PG8_BAR;
        PG8_STAGE(PG8_SB(1, 0), cB + kstep, voffB); PG8_STAGE(PG8_SA(1, 0), cA + kstep, voffA); PG8_STAGE(PG8_SB(1, 1), cB + hstep + kstep, voffB);
        PG8_WAIT_V(6); PG8_BAR;
    }
    for (;;) {
        const bool has_next = S.next(ui + 1, nxt);
        const char* nA = has_next ? (const char*)g.A + nxt.arow * (long)(K * 2) : cA; const char* nB = has_next ? (const char*)g.Bt + (size_t)nxt.pn * tstep : cB;
        for (int t = 0; t < nt; t += 2) {
            const bool last = (t == nt - 2);
            const char* a1 = cA + (size_t)(t + 1) * kstep;
            const char* a2 = last ? nA : cA + (size_t)(t + 2) * kstep; const char* b2 = last ? nB : cB + (size_t)(t + 2) * kstep;
            const char* a3 = a2 + kstep; const char* b3 = b2 + kstep;
            if (last && has_next) S.a_ready(nxt);
            if constexpr (SP2) {
            PG8_LDB(B0, 0, 0); PG8_LDB(B1, 0, 1); PG8_SCHED; PG8_LDA(At, 0, 0); PG8_STAGE(PG8_SA(1, 1), a1 + hstep, voffA);
            PG8_WAIT_V(8); PG8_WAIT_L(0); PG8_BAR; PG8_MMA(0, 0, At, B0); PG8_MMA(0, 1, At, B1); PG8_BAR; PG8_SCHED;
            PG8_LDA(At, 0, 1); PG8_STAGE(PG8_SB(0, 0), b2, voffB); PG8_STAGE(PG8_SB(0, 1), b2 + hstep, voffB); PG8_STAGE(PG8_SA(0, 0), a2, voffA);
            PG8_WAIT_V(8); PG8_WAIT_L(0); PG8_BAR; PG8_MMA(1, 0, At, B0); PG8_MMA(1, 1, At, B1); PG8_BAR; PG8_SCHED;
            PG8_LDB(B0, 1, 0); PG8_LDB(B1, 1, 1); PG8_SCHED; PG8_LDA(At, 1, 0); PG8_STAGE(PG8_SA(0, 1), a2 + hstep, voffA);
            PG8_WAIT_V(8); PG8_WAIT_L(0); PG8_BAR; PG8_MMA(0, 0, At, B0); PG8_MMA(0, 1, At, B1); PG8_BAR; PG8_SCHED;
            PG8_LDA(At, 1, 1); PG8_STAGE(PG8_SB(1, 0), b3, voffB); PG8_STAGE(PG8_SB(1, 1), b3 + hstep, voffB); PG8_STAGE(PG8_SA(1, 0), a3, voffA);
            PG8_WAIT_V(8); PG8_WAIT_L(0); PG8_BAR; PG8_MMA(1, 0, At, B0); PG8_MMA(1, 1, At, B1); PG8_BAR; PG8_SCHED;
            } else {
            PG8_LDB(B0, 0, 0); PG8_SCHED; PG8_LDA(At, 0, 0); PG8_STAGE(PG8_SA(1, 1), a1 + hstep, voffA);
            PG8_WAIT_L(8); PG8_BAR; PG8_WAIT_L(0); PG8_MMA(0, 0, At, B0); PG8_BAR; PG8_SCHED;
            PG8_LDB(B1, 0, 1); PG8_STAGE(PG8_SB(0, 0), b2, voffB);
            PG8_BAR; PG8_WAIT_L(0); PG8_MMA(0, 1, At, B1); PG8_BAR;
            PG8_LDA(At, 0, 1); PG8_STAGE(PG8_SA(0, 0), a2, voffA);
            PG8_BAR; PG8_WAIT_L(0); PG8_MMA(1, 0, At, B0); PG8_BAR; PG8_SCHED;
            PG8_STAGE(PG8_SB(0, 1), b2 + hstep, voffB);
            PG8_WAIT_V(6); PG8_BAR; PG8_MMA(1, 1, At, B1); PG8_BAR;
            PG8_LDB(B0, 1, 0); PG8_SCHED; PG8_LDA(At, 1, 0); PG8_STAGE(PG8_SA(0, 1), a2 + hstep, voffA);
            PG8_WAIT_L(8); PG8_BAR; PG8_WAIT_L(0); PG8_MMA(0, 0, At, B0); PG8_BAR; PG8_SCHED;
            PG8_LDB(B1, 1, 1); PG8_STAGE(PG8_SB(1, 0), b3, voffB);
            PG8_BAR; PG8_WAIT_L(0); PG8_MMA(0, 1, At, B1); PG8_BAR;
            PG8_LDA(At, 1, 1); PG8_STAGE(PG8_SA(1, 0), a3, voffA);
            PG8_BAR; PG8_WAIT_L(0); PG8_MMA(1, 0, At, B0); PG8_BAR; PG8_SCHED;
            PG8_STAGE(PG8_SB(1, 1), b3 + hstep, voffB);
            PG8_WAIT_V(6); PG8_BAR; PG8_MMA(1, 1, At, B1); PG8_BAR;
            }
        }
        if constexpr (ALIGN_EPI) { if (wr == 0) PG8_BAR; }
        if constexpr (!Epi::AFTER_DRAIN) { E(acc, cur, wr, wc, fr, fq); S.done(cur); }
        if (!has_next) break;
#pragma unroll
        for (int a = 0; a < 2; ++a)
#pragma unroll
            for (int b = 0; b < 2; ++b)
#pragma unroll
                for (int m = 0; m < 4; ++m)
#pragma unroll
                    for (int n = 0; n < 2; ++n) acc[a][b][m][n] = (f32x4){0.f, 0.f, 0.f, 0.f};
        cur = nxt; cA = nA; cB = nB; ++ui;
        if constexpr (ALIGN_EPI) { if (wr == 1) PG8_BAR; }
    }
    PG8_WAIT_V(0);
    if constexpr (!ALIGN_EPI) { if (wr == 0) PG8_BAR; }
    PG8_BAR;
    if constexpr (Epi::AFTER_DRAIN) { E.fused(acc, cur, wr, wc, fr, fq, lds, wid, lane); S.done(cur); }
#undef PG8_SA
#undef PG8_SB
#undef PG8_STAGE
#undef PG8_LDA
#undef PG8_LDB
#undef PG8_MMA
#undef PG8_WAIT_V
#undef PG8_WAIT_L
#undef PG8_BAR
#undef PG8_SCHED
}
}

DI int swz(int row, int ch) { return row * 128 + ((ch ^ ((row >> 1) & 7)) << 4); }
template <int AI> DI void stage_t(char* lds, const pg8::f32x4 (&acc)[2][2][4][2], int wr, int wc, int fr, int fq, int shift) {
  float* sC = (float*)lds;
#pragma unroll
  for (int bj = 0; bj < 2; ++bj)
#pragma unroll
    for (int m = 0; m < 4; ++m)
#pragma unroll
      for (int n = 0; n < 2; ++n) *(pg8::f32x4*)(sC + (64 * wr + 16 * m + fr + shift) * CST + 128 * bj + 32 * wc + 16 * n + 4 * fq) = acc[AI][bj][m][n];
}
DI void ld8(const float* p, float (&v)[8]) { const f32x4 a = *(const f32x4*)p, b = *(const f32x4*)(p + 4); v[0] = a[0]; v[1] = a[1]; v[2] = a[2]; v[3] = a[3]; v[4] = b[0]; v[5] = b[1]; v[6] = b[2]; v[7] = b[3]; }
DI u32x4 pack8(const float (&v)[8]) { u32x4 w; w[0] = cvtpk(v[0], v[1]); w[1] = cvtpk(v[2], v[3]); w[2] = cvtpk(v[4], v[5]); w[3] = cvtpk(v[6], v[7]); return w; }

enum { EPI_PLAIN = 0, EPI_ROPEA = 1, EPI_NRB = 2 };
DI void ld4(const float* p, float (&v)[4]) { const f32x4 a = *(const f32x4*)p; v[0] = a[0]; v[1] = a[1]; v[2] = a[2]; v[3] = a[3]; }
DI void epi_rows(char* lds, int tid, int kind, int tok0, int sc0, bf16_t* dst, int pitch, int col0, float scale, const float* gain, const char* tab) {
  const float* sC = (const float*)lds + sc0;
  const int lane = tid & 63, w = tid >> 6, j = lane & 31, jj = j & 15;
#pragma unroll 2
  for (int pass = 0; pass < 8; ++pass) {
    const int row = pass * 16 + w * 2 + (lane >> 5);
    const int tok = tok0 + row;
    float v[4]; ld4(sC + row * CST + 4 * j, v);
    if (kind == EPI_ROPEA) {
      if (jj < 4) {
        const int pos = (tok < MP) ? (tok & 8191) : (tok & 4095);
        float o[4]; ld4(sC + row * CST + 4 * (j ^ 2), o);
        float cs[4], sn[4]; ld4((const float*)(tab + T_ROPET_C) + pos * 8 + 4 * (jj & 1), cs); ld4((const float*)(tab + T_ROPET_S) + pos * 8 + 4 * (jj & 1), sn);
#pragma unroll
        for (int e = 0; e < 4; ++e) v[e] = (jj < 2) ? (v[e] * cs[e] - o[e] * sn[e]) : (v[e] * cs[e] + o[e] * sn[e]);
      }
    } else if (kind == EPI_NRB) {
      float ss = v[0] * v[0] + v[1] * v[1] + v[2] * v[2] + v[3] * v[3];
      ss += __shfl_xor(ss, 1); ss += __shfl_xor(ss, 2); ss += __shfl_xor(ss, 4); ss += __shfl_xor(ss, 8);
      const float rr = rsqrtf(ss * (1.0f / 64.0f) + EPS);
      float o[4]; ld4(sC + row * CST + 4 * (j ^ 4), o);
      float go[4], gp[4]; ld4(gain + 4 * jj, go); ld4(gain + 4 * (jj ^ 4), gp);
      const int pos = (tok < MP) ? (tok & 8191) : (tok & 4095);
      const float* tc = (jj < 8) ? ((const float*)(tab + T_ROPER_C) + (pos >> 6) * 16) : ((const float*)(tab + T_ROPEC_C) + (pos & 63) * 16);
      const float* ts = (jj < 8) ? ((const float*)(tab + T_ROPER_S) + (pos >> 6) * 16) : ((const float*)(tab + T_ROPEC_S) + (pos & 63) * 16);
      float cs[4], sn[4]; ld4(tc + 4 * (jj & 3), cs); ld4(ts + 4 * (jj & 3), sn);
#pragma unroll
      for (int e = 0; e < 4; ++e) { const float yo = v[e] * rr * go[e], yp = o[e] * rr * gp[e]; v[e] = ((jj & 4) == 0) ? (yo * cs[e] - yp * sn[e]) : (yo * cs[e] + yp * sn[e]); }
    }
    u32x2 wv; wv[0] = cvtpk(v[0] * scale, v[1] * scale); wv[1] = cvtpk(v[2] * scale, v[3] * scale);
    *(u32x2*)(dst + (size_t)tok * pitch + col0 + 4 * j) = wv;
  }
}

DI float gelu_tanh(float x) { const float u = x * x; const float t = x * (-2.302208198f + -0.1029432397f * u); return x * __builtin_amdgcn_rcpf(1.0f + fexp2(t)); }

constexpr float ATT_THR = 6.0f;
template <bool MASKED>
DI void flash_core(char* lds, int tid, const bf16_t* Qp, int qpitch, const bf16_t* Kp, int kpitch, const bf16_t* Vp, int vpitch,
                   int base, int dil, int L, int iq0, int kt0, int ntiles, f32x16 (&O)[2], float& m_run, float& l_run) {
  const int lane = tid & 63, w = tid >> 6, r32 = lane & 31, h = lane >> 5;
  const int iq = iq0 + 32 * w + r32;
  bf16x8 qf[4];
  { const bf16_t* qrow = Qp + (size_t)(base + dil * iq) * qpitch;
#pragma unroll
    for (int ks = 0; ks < 4; ++ks) qf[ks] = *(const bf16x8*)(qrow + 16 * ks + 8 * h); }
  const int lrow = tid >> 3, lch = tid & 7;
  const int kso = swz(lrow, lch), vso = 8192 + (lch >> 2) * 4096 + lrow * 64 + (lch & 3) * 16;
  u32x4 kreg, vreg;
#define FA_GLOAD(t) do { int ik = kt0 + 64 * (t) + lrow; ik = ik < 0 ? 0 : (ik > L - 1 ? L - 1 : ik); const size_t tok = (size_t)(base + dil * ik); \
    kreg = *(const u32x4*)(Kp + tok * kpitch + lch * 8); vreg = *(const u32x4*)(Vp + tok * vpitch + lch * 8); } while (0)
#define FA_LSTORE(b) do { *(u32x4*)(lds + (b) * 16384 + kso) = kreg; *(u32x4*)(lds + (b) * 16384 + vso) = vreg; } while (0)
  FA_GLOAD(0); FA_LSTORE(0); __syncthreads();
  O[0] = zero16(); O[1] = zero16(); m_run = 0.f; l_run = 0.f;
  f32x16 negm = zero16();
  const int iqw = iq0 + 32 * w;
  for (int t = 0; t < ntiles; ++t) {
    const bool more = (t + 1 < ntiles);
    if (more) FA_GLOAD(t + 1);
    const char* kb = lds + (t & 1) * 16384; const char* vb = kb + 8192;
    bool need = true;
    if (MASKED) { const int k_lo = kt0 + 64 * t; need = (k_lo + 63 >= iqw - 64) && (k_lo <= iqw + 31 + 64); }
    if (need) {
      f32x16 S0 = negm, S1 = negm;
#pragma unroll
      for (int ks = 0; ks < 4; ++ks) {
        const bf16x8 k0 = *(const bf16x8*)(kb + swz(r32, 2 * ks + h));
        const bf16x8 k1 = *(const bf16x8*)(kb + swz(32 + r32, 2 * ks + h));
        S0 = mfma32(k0, qf[ks], S0); S1 = mfma32(k1, qf[ks], S1);
      }
      if (MASKED) {
#pragma unroll
        for (int r = 0; r < 16; ++r) { const int ik0 = kt0 + 64 * t + crow(r, h), ik1 = ik0 + 32; const int d0 = ik0 - iq, d1 = ik1 - iq;
          const bool v0 = (ik0 >= 0) && (ik0 < L) && (d0 <= 64) && (d0 >= -64); const bool v1 = (ik1 >= 0) && (ik1 < L) && (d1 <= 64) && (d1 >= -64);
          S0[r] = v0 ? S0[r] : -1e30f; S1[r] = v1 ? S1[r] : -1e30f; }
      }
      float mx = __builtin_fmaxf(__builtin_fmaxf(S0[0], S0[1]), S1[0]);
      mx = __builtin_fmaxf(__builtin_fmaxf(mx, S1[1]), S0[2]);
#pragma unroll
      for (int r = 2; r < 16; r += 2) { mx = __builtin_fmaxf(__builtin_fmaxf(mx, S1[r]), S1[r + 1]); if (r + 2 < 16) mx = __builtin_fmaxf(__builtin_fmaxf(mx, S0[r + 1]), S0[r + 2]); else mx = __builtin_fmaxf(mx, S0[r + 1]); }
      mx = __builtin_fmaxf(mx, __shfl_xor(mx, 32));
      if (__builtin_amdgcn_ballot_w64(mx > ATT_THR) != 0ull) {
        const float dl = __builtin_fmaxf(mx, 0.f); m_run += dl; const float alpha = fexp2(-dl); l_run *= alpha;
#pragma unroll
        for (int r = 0; r < 16; ++r) { O[0][r] *= alpha; O[1][r] *= alpha; S0[r] -= dl; S1[r] -= dl; negm[r] = -m_run; }
      }
      float ps0 = 0.f, ps1 = 0.f;
#pragma unroll
      for (int r = 0; r < 16; ++r) { S0[r] = fexp2(S0[r]); S1[r] = fexp2(S1[r]); ps0 += S0[r]; ps1 += S1[r]; }
      l_run += ps0 + ps1;
#pragma unroll
      for (int s = 0; s < 4; ++s) {
        const int kvb = s >> 1, sp = s & 1;
        u32x4 pw;
        if (kvb == 0) { pw[0] = cvtpk(S0[8 * sp], S0[8 * sp + 1]); pw[1] = cvtpk(S0[8 * sp + 2], S0[8 * sp + 3]); pw[2] = cvtpk(S0[8 * sp + 4], S0[8 * sp + 5]); pw[3] = cvtpk(S0[8 * sp + 6], S0[8 * sp + 7]); }
        else          { pw[0] = cvtpk(S1[8 * sp], S1[8 * sp + 1]); pw[1] = cvtpk(S1[8 * sp + 2], S1[8 * sp + 3]); pw[2] = cvtpk(S1[8 * sp + 4], S1[8 * sp + 5]); pw[3] = cvtpk(S1[8 * sp + 6], S1[8 * sp + 7]); }
        const bf16x8 xs = __builtin_bit_cast(bf16x8, pw);
        const int rowA = 32 * kvb + 16 * sp + 4 * h;
#pragma unroll
        for (int db = 0; db < 2; ++db) { const bf16x8 vf = tr_frag(vb + db * 4096, 64, rowA, rowA + 8, 0, lane); O[db] = mfma32(vf, xs, O[db]); }
      }
    }
    if (more) FA_LSTORE((t + 1) & 1);
    __syncthreads();
  }
#undef FA_GLOAD
#undef FA_LSTORE
}

DI void flash_grid(char* lds, int tid, const bf16_t* Qp, const bf16_t* Kp, const bf16_t* Vp, int base, int iq0, int ntiles, float kbound, f32x16 (&O)[2], float& l_out) {
  const int lane = tid & 63, w = tid >> 6, r32 = lane & 31, h = lane >> 5;
  bf16x8 qf[4];
  { const bf16_t* qrow = Qp + (size_t)(base + iq0 + 32 * w + r32) * 512;
#pragma unroll
    for (int ks = 0; ks < 4; ++ks) qf[ks] = *(const bf16x8*)(qrow + 16 * ks + 8 * h); }
  float qn2 = 0.f;
#pragma unroll
  for (int ks = 0; ks < 4; ++ks)
#pragma unroll
    for (int e = 0; e < 8; ++e) { const float qv = __uint_as_float(((unsigned)(unsigned short)qf[ks][e]) << 16); qn2 += qv * qv; }
  qn2 += __shfl_xor(qn2, 32);
  const float m_row = __builtin_sqrtf(qn2) * kbound;
  const int lrow = tid >> 3, lch = tid & 7;
  const int kso = swz(lrow, lch), vso = 16384 + (lch >> 2) * 4096 + lrow * 64 + (lch & 3) * 16;
  const unsigned goff = (unsigned)(((base + lrow) * 128 + lch * 8) * 2);
#define KG(t) ((const char*)Kp + (size_t)(goff + (unsigned)(t) * (64u * 128u * 2u)))
#define VG(t) ((const char*)Vp + (size_t)(goff + (unsigned)(t) * (64u * 128u * 2u)))
  u32x4 kreg, vreg;
  int kfo[4];
#pragma unroll
  for (int ks = 0; ks < 4; ++ks) kfo[ks] = r32 * 128 + (((2 * ks + h) ^ ((r32 >> 1) & 7)) << 4);
  float l_run = 0.f;
  f32x16 negm;
#pragma unroll
  for (int r = 0; r < 16; ++r) negm[r] = -m_row;
  O[0] = zero16(); O[1] = zero16();
#define SB() __builtin_amdgcn_sched_barrier(0)
#define FG_QK(SN0, SN1, kb) do { bf16x8 kf[8]; \
    _Pragma("unroll") for (int ks = 0; ks < 4; ++ks) { kf[2 * ks] = *(const bf16x8*)((kb) + kfo[ks]); kf[2 * ks + 1] = *(const bf16x8*)((kb) + 4096 + kfo[ks]); } \
    SN0 = mfma32(kf[0], qf[0], negm); SN1 = mfma32(kf[1], qf[0], negm); \
    _Pragma("unroll") for (int ks = 1; ks < 4; ++ks) { SN0 = mfma32(kf[2 * ks], qf[ks], SN0); SN1 = mfma32(kf[2 * ks + 1], qf[ks], SN1); } } while (0)
  kreg = *(const u32x4*)KG(0); vreg = *(const u32x4*)VG(0);
  *(u32x4*)(lds + kso) = kreg; *(u32x4*)(lds + vso) = vreg;
  kreg = *(const u32x4*)KG(1);
  __syncthreads();
  f32x16 SA0, SA1, SB0, SB1;
  FG_QK(SA0, SA1, lds);
#pragma unroll
  for (int r = 0; r < 16; ++r) { SA0[r] = fexp2(SA0[r]); SA1[r] = fexp2(SA1[r]); }
  *(u32x4*)(lds + 8192 + kso) = kreg;
  __syncthreads();
#define FG_STEP(SC0, SC1, SN0, SN1, t, HASN, HASK) do { \
    const int cur_ = (t) & 1; \
    if (HASK) kreg = *(const u32x4*)KG((t) + 2); \
    if (HASN) vreg = *(const u32x4*)VG((t) + 1); \
    const char* kb_ = lds + (cur_ ^ 1) * 8192; const char* vb_ = lds + 16384 + cur_ * 8192; \
    bf16x8 kf_[8]; \
    if (HASN) { _Pragma("unroll") for (int ks = 0; ks < 2; ++ks) { kf_[2 * ks] = *(const bf16x8*)(kb_ + kfo[ks]); kf_[2 * ks + 1] = *(const bf16x8*)(kb_ + 4096 + kfo[ks]); } } \
    SB(); \
      \
    float ps_ = 0.f; u32x4 pw_[4]; \
    _Pragma("unroll") for (int g = 0; g < 8; ++g) { \
      if (HASN && g == 2) { _Pragma("unroll") for (int ks = 2; ks < 4; ++ks) { kf_[2 * ks] = *(const bf16x8*)(kb_ + kfo[ks]); kf_[2 * ks + 1] = *(const bf16x8*)(kb_ + 4096 + kfo[ks]); } } \
      if (HASN) { __builtin_amdgcn_s_setprio(1); if (g == 0) SN0 = mfma32(kf_[0], qf[0], negm); else if (g == 1) SN1 = mfma32(kf_[1], qf[0], negm); \
                  else if ((g & 1) == 0) SN0 = mfma32(kf_[g], qf[g >> 1], SN0); else SN1 = mfma32(kf_[g], qf[g >> 1], SN1); __builtin_amdgcn_s_setprio(0); } \
      if (g < 4) { ps_ += (SC0[4 * g] + SC0[4 * g + 1]) + (SC0[4 * g + 2] + SC0[4 * g + 3]); pw_[g >> 1][2 * (g & 1)] = cvtpk(SC0[4 * g], SC0[4 * g + 1]); pw_[g >> 1][2 * (g & 1) + 1] = cvtpk(SC0[4 * g + 2], SC0[4 * g + 3]); } \
      else { const int g2 = g - 4; ps_ += (SC1[4 * g2] + SC1[4 * g2 + 1]) + (SC1[4 * g2 + 2] + SC1[4 * g2 + 3]); pw_[2 + (g2 >> 1)][2 * (g2 & 1)] = cvtpk(SC1[4 * g2], SC1[4 * g2 + 1]); pw_[2 + (g2 >> 1)][2 * (g2 & 1) + 1] = cvtpk(SC1[4 * g2 + 2], SC1[4 * g2 + 3]); } \
      asm volatile("" : "+v"(ps_)); asm volatile("" : "+v"(pw_[g >> 1])); \
      SB(); } \
    l_run += ps_; \
      \
    bf16x8 vf_[8]; \
    _Pragma("unroll") for (int s = 0; s < 2; ++s) { const int rowA = 16 * s + 4 * h; \
      vf_[2 * s] = tr_frag(vb_, 64, rowA, rowA + 8, 0, lane); vf_[2 * s + 1] = tr_frag(vb_ + 4096, 64, rowA, rowA + 8, 0, lane); } \
    SB(); \
      \
    _Pragma("unroll") for (int g = 0; g < 8; ++g) { \
      if (g == 2) { _Pragma("unroll") for (int s = 2; s < 4; ++s) { const int rowA = 16 * s + 4 * h; \
        vf_[2 * s] = tr_frag(vb_, 64, rowA, rowA + 8, 0, lane); vf_[2 * s + 1] = tr_frag(vb_ + 4096, 64, rowA, rowA + 8, 0, lane); } } \
      __builtin_amdgcn_s_setprio(1); O[g & 1] = mfma32(vf_[g], __builtin_bit_cast(bf16x8, pw_[g >> 1]), O[g & 1]); __builtin_amdgcn_s_setprio(0); \
      if (HASN) { if (g < 4) { SN0[4 * g] = fexp2(SN0[4 * g]); SN0[4 * g + 1] = fexp2(SN0[4 * g + 1]); SN0[4 * g + 2] = fexp2(SN0[4 * g + 2]); SN0[4 * g + 3] = fexp2(SN0[4 * g + 3]); } \
                  else { const int g2 = g - 4; SN1[4 * g2] = fexp2(SN1[4 * g2]); SN1[4 * g2 + 1] = fexp2(SN1[4 * g2 + 1]); SN1[4 * g2 + 2] = fexp2(SN1[4 * g2 + 2]); SN1[4 * g2 + 3] = fexp2(SN1[4 * g2 + 3]); } \
                  if (g < 4) asm volatile("" : "+v"(SN0)); else asm volatile("" : "+v"(SN1)); } \
      SB(); } \
    if (HASK) *(u32x4*)(lds + cur_ * 8192 + kso) = kreg; \
    if (HASN) *(u32x4*)(lds + (cur_ ^ 1) * 8192 + vso) = vreg; \
    __syncthreads(); } while (0)
  int t = 0;
  for (; t + 3 < ntiles; t += 2) { FG_STEP(SA0, SA1, SB0, SB1, t, true, true); FG_STEP(SB0, SB1, SA0, SA1, t + 1, true, true); }
  FG_STEP(SA0, SA1, SB0, SB1, t, true, false);
  FG_STEP(SB0, SB1, SA0, SA1, t + 1, false, false);
#undef KG
#undef VG
#undef FG_STEP
#undef FG_QK
#undef SB
  l_out = l_run;
}

DI void flash_dil(char* lds, int tid, const bf16_t* Qp, const bf16_t* Kp, const bf16_t* Vp, int base, int dil, int L, int i0, f32x16 (&O)[2], float& m_out, float& l_out) {
  const int lane = tid & 63, w = tid >> 6, r32 = lane & 31, h = lane >> 5;
  const int kt0 = i0 - 64;
#pragma unroll
  for (int i = 0; i < 6; ++i) { const int c = tid + 512 * i, row = c >> 3, ch = c & 7; int ik = kt0 + row; ik = ik < 0 ? 0 : (ik > L - 1 ? L - 1 : ik);
    const size_t tok = (size_t)(base + dil * ik);
    const u32x4 kreg = *(const u32x4*)(Kp + tok * 256 + ch * 8), vreg = *(const u32x4*)(Vp + tok * 256 + ch * 8);
    *(u32x4*)(lds + swz(row, ch)) = kreg;
    *(u32x4*)(lds + 49152 + (ch >> 2) * 24576 + row * 64 + (ch & 3) * 16) = vreg; }
  const int iq = i0 + 32 * w + r32;
  bf16x8 qf[4];
  { const bf16_t* qrow = Qp + (size_t)(base + dil * iq) * 256;
#pragma unroll
    for (int ks = 0; ks < 4; ++ks) qf[ks] = *(const bf16x8*)(qrow + 16 * ks + 8 * h); }
  __syncthreads();
  O[0] = zero16(); O[1] = zero16();
  float m_run = -1e30f, l_run = 0.f;
#pragma unroll 1
  for (int b = 0; b < 5; ++b) {
    const int rb = 32 * w + 32 * b;
    f32x16 S = zero16();
#pragma unroll
    for (int ks = 0; ks < 4; ++ks) { const bf16x8 kf = *(const bf16x8*)(lds + swz(rb + r32, 2 * ks + h)); S = mfma32(kf, qf[ks], S); }
#pragma unroll
    for (int r = 0; r < 16; ++r) { const int ik = kt0 + rb + crow(r, h); const int d = ik - iq; const bool v = (ik >= 0) && (ik < L) && (d <= 64) && (d >= -64); S[r] = v ? S[r] : -1e30f; }
    float mx = S[0];
#pragma unroll
    for (int r = 1; r < 16; ++r) mx = __builtin_fmaxf(mx, S[r]);
    mx = __builtin_fmaxf(mx, __shfl_xor(mx, 32));
    const float m_new = __builtin_fmaxf(m_run, mx); const float alpha = fexp2(m_run - m_new); m_run = m_new;
    float ps = 0.f;
#pragma unroll
    for (int r = 0; r < 16; ++r) { S[r] = fexp2(S[r] - m_new); ps += S[r]; }
    l_run = l_run * alpha + ps;
#pragma unroll
    for (int r = 0; r < 16; ++r) { O[0][r] *= alpha; O[1][r] *= alpha; }
#pragma unroll
    for (int sp = 0; sp < 2; ++sp) {
      u32x4 pw; pw[0] = cvtpk(S[8 * sp], S[8 * sp + 1]); pw[1] = cvtpk(S[8 * sp + 2], S[8 * sp + 3]); pw[2] = cvtpk(S[8 * sp + 4], S[8 * sp + 5]); pw[3] = cvtpk(S[8 * sp + 6], S[8 * sp + 7]);
      const bf16x8 xs = __builtin_bit_cast(bf16x8, pw);
      const int rowA = rb + 16 * sp + 4 * h;
#pragma unroll
      for (int db = 0; db < 2; ++db) { const bf16x8 vf = tr_frag(lds + 49152 + db * 24576, 64, rowA, rowA + 8, 0, lane); O[db] = mfma32(vf, xs, O[db]); }
    }
  }
  m_out = m_run; l_out = l_run;
  __syncthreads();
}

struct OneUnit { long arow; int pn;
  DI bool next(int i, pg8::Unit& u) const { if (i != 0) return false; u.pm = 0; u.pn = pn; u.arow = arow; return true; }
  DI void a_ready(const pg8::Unit&) const {}
  DI void done(const pg8::Unit&) const {} };
struct EpiP1 { static constexpr bool PERM = false, AFTER_DRAIN = true;
  int tid, tok_tile0, nt; char* ws; const float* gq; const float* gk;
  template <int AI> DI void pass(char* lds, const pg8::f32x4 (&acc)[2][2][4][2], int wr, int wc, int fr, int fq) const {
    stage_t<AI>(lds, acc, wr, wc, fr, fq, 0); __syncthreads();
    int tid = this->tid; asm volatile("" : "+v"(tid));
    const int tok0 = tok_tile0 + AI * 128;
    const char* tab = ws + WS_TAB;
    bf16_t* QA = (bf16_t*)(ws + WS_QA); bf16_t* KA = (bf16_t*)(ws + WS_KA); bf16_t* VA = (bf16_t*)(ws + WS_VA);
    bf16_t* QB = (bf16_t*)(ws + WS_QB); bf16_t* KB = (bf16_t*)(ws + WS_KB); bf16_t* VB = (bf16_t*)(ws + WS_VB); bf16_t* ZC = (bf16_t*)(ws + WS_ZC);
    for (int hf = 0; hf < 2; ++hf) { const int c128 = nt * 2 + hf;
      int kind = EPI_PLAIN; bf16_t* dst = ZC; int pitch = 256, col0 = (c128 - 12) * 128; float scale = 1.0f; const float* gain = nullptr;
      if (c128 < 2) { kind = EPI_ROPEA; dst = QA; pitch = 256; col0 = c128 * 128; scale = QSCALE; }
      else if (c128 < 4) { kind = EPI_ROPEA; dst = KA; pitch = 256; col0 = (c128 - 2) * 128; }
      else if (c128 < 6) { dst = VA; pitch = 256; col0 = (c128 - 4) * 128; }
      else if (c128 < 10) { kind = EPI_NRB; dst = QB; pitch = 512; col0 = (c128 - 6) * 128; scale = QSCALE; gain = gq; }
      else if (c128 == 10) { kind = EPI_NRB; dst = KB; pitch = 128; col0 = 0; gain = gk; }
      else if (c128 == 11) { dst = VB; pitch = 128; col0 = 0; }
      epi_rows(lds, tid, kind, tok0, hf * 128, dst, pitch, col0, scale, gain, tab); }
    __syncthreads();
  }
  DI void fused(pg8::f32x4 (&acc)[2][2][4][2], const pg8::Unit&, int wr, int wc, int fr, int fq, PG8_LAS unsigned char* lds3, int, int) const {
    char* lds = (char*)lds3; pass<0>(lds, acc, wr, wc, fr, fq); pass<1>(lds, acc, wr, wc, fr, fq); }
};
struct EpiPlain { static constexpr bool PERM = false, AFTER_DRAIN = true;
  int tid, tok_tile0, col_tile0; bf16_t* dst; const char* tab;
  template <int AI> DI void pass(char* lds, const pg8::f32x4 (&acc)[2][2][4][2], int wr, int wc, int fr, int fq) const {
    stage_t<AI>(lds, acc, wr, wc, fr, fq, 0); __syncthreads();
    int tid = this->tid; asm volatile("" : "+v"(tid));
    for (int hf = 0; hf < 2; ++hf) epi_rows(lds, tid, EPI_PLAIN, tok_tile0 + AI * 128, hf * 128, dst, DM, col_tile0 + hf * 128, 1.0f, nullptr, tab);
    __syncthreads();
  }
  DI void fused(pg8::f32x4 (&acc)[2][2][4][2], const pg8::Unit&, int wr, int wc, int fr, int fq, PG8_LAS unsigned char* lds3, int, int) const {
    char* lds = (char*)lds3; pass<0>(lds, acc, wr, wc, fr, fq); pass<1>(lds, acc, wr, wc, fr, fq); }
};
struct EpiP4 { static constexpr bool PERM = false, AFTER_DRAIN = true;
  int tid, p0, nt; const float* cw; const float* cb; bf16_t* ACT;
  template <int PS> DI void pass(char* lds, const pg8::f32x4 (&acc)[2][2][4][2], int wr, int wc, int fr, int fq) const {
    float* sCw = (float*)lds;
    stage_t<PS>(lds, acc, wr, wc, fr, fq, PS);
    if (PS == 0) { if (wr == 0 && fr == 0) {
#pragma unroll
        for (int bj = 0; bj < 2; ++bj)
#pragma unroll
          for (int n = 0; n < 2; ++n) *(pg8::f32x4*)(sCw + 128 * CST + 128 * bj + 32 * wc + 16 * n + 4 * fq) = acc[1][bj][0][n]; } }
    else { if (wr == 1 && fr == 15) {
#pragma unroll
        for (int bj = 0; bj < 2; ++bj)
#pragma unroll
          for (int n = 0; n < 2; ++n) *(pg8::f32x4*)(sCw + 128 * bj + 32 * wc + 16 * n + 4 * fq) = acc[0][bj][3][n]; } }
    __syncthreads();
    const float* sC = (const float*)lds;
    int tid = this->tid; asm volatile("" : "+v"(tid));
    const int lane = tid & 63, w = tid >> 6, jj = lane & 15; const int f0 = nt * 128 + 8 * jj;
    float c0[8], c1[8], c2[8], bb[8]; ld8(cw + f0, c0); ld8(cw + DFF + f0, c1); ld8(cw + 2 * DFF + f0, c2); ld8(cb + f0, bb);
#pragma unroll 2
    for (int ps = 0; ps < 4; ++ps) {
      const int q = ps * 32 + w * 4 + (lane >> 4);
      const int i = 1 + q;
      const int tok = p0 + 127 * PS + i;
      if (q < 127 && tok < MT) {
        const int pos = (tok < MP) ? (tok & 8191) : (tok & 4095); const int S = (tok < MP) ? 8192 : 4096;
        float gm[8], gc[8], gp[8], up[8];
        ld8(sC + (i - 1) * CST + 8 * jj, gm); ld8(sC + i * CST + 8 * jj, gc); ld8(sC + (i + 1) * CST + 8 * jj, gp); ld8(sC + i * CST + 128 + 8 * jj, up);
        if (pos - 1 < 0) {
#pragma unroll
          for (int e = 0; e < 8; ++e) gm[e] = 0.f; }
        if (pos + 1 >= S) {
#pragma unroll
          for (int e = 0; e < 8; ++e) gp[e] = 0.f; }
        float o[8];
#pragma unroll
        for (int e = 0; e < 8; e += 2) {
          const f32x2 a = {gm[e], gm[e + 1]}, b = {gc[e], gc[e + 1]}, c = {gp[e], gp[e + 1]};
          const f32x2 k0 = {c0[e], c0[e + 1]}, k1 = {c1[e], c1[e + 1]}, k2 = {c2[e], c2[e + 1]}, kb = {bb[e], bb[e + 1]}, uu = {up[e], up[e + 1]};
          const f32x2 x = k0 * a + (k1 * b + (k2 * c + kb));
          const f32x2 u = x * x;
          const f32x2 t = x * (u * -0.1029432397f + -2.302208198f);
          f32x2 d; d.x = fexp2(t.x); d.y = fexp2(t.y); d = d + 1.0f;
          f32x2 r; r.x = __builtin_amdgcn_rcpf(d.x); r.y = __builtin_amdgcn_rcpf(d.y);
          const f32x2 y = (x * r) * uu;
          o[e] = y.x; o[e + 1] = y.y; }
        *(u32x4*)(ACT + (size_t)tok * DFF + f0) = pack8(o);
      }
    }
    __syncthreads();
  }
  DI void fused(pg8::f32x4 (&acc)[2][2][4][2], const pg8::Unit&, int wr, int wc, int fr, int fq, PG8_LAS unsigned char* lds3, int, int) const {
    char* lds = (char*)lds3; pass<0>(lds, acc, wr, wc, fr, fq); pass<1>(lds, acc, wr, wc, fr, fq); }
};

#define XB_TMO      128
#define XB_XCNT(j)  (256  + 64 * (j))
#define XB_XSUB(j)  (1280 + 64 * (j))
#define XB_XGEN(j)  (2304 + 64 * (j))
#define XB_TOP      3328
#define XB_TOPGEN   3392
#define XCD_BAR_WORDS 3456
#define XB_SPIN_CAP (1u << 22)

__device__ __forceinline__ unsigned xb_ld(unsigned* p)              { return __hip_atomic_load(p, __ATOMIC_RELAXED, __HIP_MEMORY_SCOPE_AGENT); }
__device__ __forceinline__ unsigned xb_add(unsigned* p, unsigned v) { return __hip_atomic_fetch_add(p, v, __ATOMIC_RELAXED, __HIP_MEMORY_SCOPE_AGENT); }
__device__ __forceinline__ unsigned xb_xcc_id() { return (unsigned)__builtin_amdgcn_s_getreg((3 << 11) | 20) & 0xFu; }
#define XB_SPIN(cond, bar) do { unsigned _sp = 0; while (cond) { __builtin_amdgcn_s_sleep(1); \
    if ((++_sp & 255u) == 0u) { if (xb_ld(&(bar)[XB_TMO])) break; if (_sp > XB_SPIN_CAP) { atomicAdd(&(bar)[XB_TMO], 1u); break; } } } } while (0)

struct XcdBarrier {
    unsigned* bar; unsigned x;
    volatile __attribute__((address_space(3))) unsigned* st;
};

__device__ __forceinline__ XcdBarrier xcd_barrier_post(unsigned* bar, volatile __attribute__((address_space(3))) unsigned* st) {
    XcdBarrier b; b.bar = bar; b.x = xb_xcc_id(); b.st = st;
    if (threadIdx.x == 0) (void)xb_add(&bar[XB_XCNT(b.x)], 1u);
    return b;
}
__device__ __forceinline__ void xcd_barrier_complete(unsigned* bar, unsigned x, unsigned& nloc, unsigned& nx) {
    const unsigned G = gridDim.x * gridDim.y * gridDim.z;
    unsigned sum, cnt, mine, sp = 0u;
    for (;;) {
        sum = 0u; cnt = 0u; mine = 0u;
#pragma unroll
        for (unsigned j = 0; j < 16; ++j) { const unsigned c = xb_ld(&bar[XB_XCNT(j)]); sum += c; cnt += (c > 0u) ? 1u : 0u; mine = (j == x) ? c : mine; }
        if (sum == G) break;
        __builtin_amdgcn_s_sleep(1);
        if ((++sp & 255u) == 0u) { if (xb_ld(&bar[XB_TMO])) break; if (sp > XB_SPIN_CAP) { atomicAdd(&bar[XB_TMO], 1u); break; } }
    }
    nloc = mine > 0u ? mine : 1u; nx = cnt > 0u ? cnt : 1u;
}

__device__ __forceinline__ void xcd_barrier(const XcdBarrier& b) {
    asm volatile("s_waitcnt vmcnt(0)" ::: "memory");
    __syncthreads();
    if (threadIdx.x == 0) {
        unsigned* bar = b.bar;
        __builtin_amdgcn_s_waitcnt(0);
        unsigned nloc = b.st[0], nx = b.st[1];
        if (nloc == 0u) { xcd_barrier_complete(bar, b.x, nloc, nx); b.st[0] = nloc; b.st[1] = nx; }
        const unsigned old = xb_add(&bar[XB_XSUB(b.x)], 1u);
        const unsigned gen = old / nloc;
        if (old + 1u == (gen + 1u) * nloc) {
            __builtin_amdgcn_fence(__ATOMIC_RELEASE, "agent");
            asm volatile("s_waitcnt vmcnt(0)" ::: "memory");
            const unsigned og = xb_add(&bar[XB_TOP], 1u);
            const unsigned tg = og / nx;
            if (og + 1u == (tg + 1u) * nx) xb_add(&bar[XB_TOPGEN], 1u);
            else XB_SPIN(xb_ld(&bar[XB_TOPGEN]) == tg, bar);
            __builtin_amdgcn_fence(__ATOMIC_ACQUIRE, "agent");
            xb_add(&bar[XB_XGEN(b.x)], 1u);
            asm volatile("s_waitcnt vmcnt(0)" ::: "memory");
        } else {
            XB_SPIN(xb_ld(&bar[XB_XGEN(b.x)]) == gen, bar);
            __builtin_amdgcn_fence(__ATOMIC_ACQUIRE, "agent");
            asm volatile("s_waitcnt vmcnt(0)" ::: "memory");
        }
    }
    __syncthreads();
}

DI bool tile_map(int round, int blk, int MTn, int NTn, int gm, int gn, int& mt, int& nt) {
  const int xcd = blk & 7, slot = blk >> 3, ngn = NTn / gn;
  const int gidx = round * 8 + xcd, mg = gidx / ngn, ng = gidx % ngn;
  mt = mg * gm + slot / gn; nt = ng * gn + slot % gn;
  return mt < MTn;
}
__global__ void __launch_bounds__(NTHREADS, 2) mega(Params p) {
  __shared__ __attribute__((aligned(16))) char lds[LDS_BYTES];
  __shared__ int s_item;
  __shared__ unsigned s_xb[2];
  const int nblk = gridDim.x, blk = blockIdx.x;
  if (threadIdx.x < 2) s_xb[threadIdx.x] = 0u;
  __syncthreads();
  const XcdBarrier xbar = xcd_barrier_post((unsigned*)(p.ws + WS_CTL) + 4096, (volatile __attribute__((address_space(3))) unsigned*)s_xb);
  for (int step = p.plo; step <= p.phi; ++step) {
  const int ph = p.seq[step];
  int tid = threadIdx.x; asm volatile("" : "+v"(tid));
  const int lane = tid & 63, w = tid >> 6, r32 = lane & 31, h = lane >> 5;
  size_t zoff = 0; asm volatile("" : "+s"(zoff));
  char* ws = p.ws + zoff;
  const char* tab = ws + WS_TAB;
  bf16_t* XN = (bf16_t*)(ws + WS_XN); bf16_t* OB = (bf16_t*)(ws + WS_O);
  bf16_t* QA = (bf16_t*)(ws + WS_QA); bf16_t* KA = (bf16_t*)(ws + WS_KA); bf16_t* VA = (bf16_t*)(ws + WS_VA);
  bf16_t* QB = (bf16_t*)(ws + WS_QB); bf16_t* KB = (bf16_t*)(ws + WS_KB); bf16_t* VB = (bf16_t*)(ws + WS_VB);
  bf16_t* ZC = (bf16_t*)(ws + WS_ZC); bf16_t* BF = (bf16_t*)(ws + WS_BF); bf16_t* PART = (bf16_t*)(ws + WS_PART); float* LSE = (float*)(ws + WS_LSE);
  bf16_t* MIX = (bf16_t*)(ws + WS_MIX); bf16_t* ACT = (bf16_t*)(ws + WS_ACT); bf16_t* FF = (bf16_t*)(ws + WS_FF); float* RS = (float*)(ws + WS_RS);
  unsigned* ctl = (unsigned*)(ws + WS_CTL);
  {
    if (ph == 0) { if (PHEN(0)) {
      const int gt = blk * NTHREADS + tid, gn = nblk * NTHREADS;
      for (int i = gt; i < 8192 * 8; i += gn) { const int pos = i >> 3, f = i & 7;
        const float inv[8] = {1.0f, 0.1939227432012558f, 0.03760603070259094f, 0.007292664609849453f, 0.0014142135623842478f, 0.00027424818836152554f, 5.3182957344688475e-05f, 1.0313385246263351e-05f};
        float iv = inv[0];
#pragma unroll
        for (int q = 1; q < 8; ++q) iv = (f == q) ? inv[q] : iv;
        const float ang = (float)pos * iv; float s, c; sincos_d((double)ang, s, c);
        ((float*)(tab + T_ROPET_C))[i] = c; ((float*)(tab + T_ROPET_S))[i] = s; }
      for (int i = gt; i < 192 * 16; i += gn) { const int pr = i >> 4, f = i & 15;
        const float inv[16] = {1.0f, 0.5623413324356079f, 0.3162277638912201f, 0.17782793939113617f, 0.10000000149011612f, 0.05623413249850273f, 0.03162277489900589f, 0.017782794311642647f,
                               0.009999999776482582f, 0.005623413249850273f, 0.003162277629598975f, 0.0017782794311642647f, 0.0010000000474974513f, 0.000562341301701963f, 0.0003162277571391314f, 0.00017782794020604342f};
        float iv = inv[0];
#pragma unroll
        for (int q = 1; q < 16; ++q) iv = (f == q) ? inv[q] : iv;
        const int pos = pr < 128 ? pr : pr - 128; const float ang = (float)pos * iv; float s, c; sincos_d((double)ang, s, c);
        if (pr < 128) { ((float*)(tab + T_ROPER_C))[pos * 16 + f] = c; ((float*)(tab + T_ROPER_S))[pos * 16 + f] = s; }
        else { ((float*)(tab + T_ROPEC_C))[pos * 16 + f] = c; ((float*)(tab + T_ROPEC_S))[pos * 16 + f] = s; } }
      for (int i = gt; i < 8192; i += gn) { float s, c; sincos_d(6.283185307179586476925286766559 * (double)i / 8192.0, s, c); ((float*)(tab + T_TW_C))[i] = c; ((float*)(tab + T_TW_S))[i] = s; }
      for (int i = gt; i < 128 * 128; i += gn) { const int a = i >> 7, b = i & 127; float s, c; sincos_d(6.283185307179586476925286766559 * (double)((a * b) & 127) / 128.0, s, c);
        ((bf16_t*)(tab + T_C128))[i] = (bf16_t)cvtpk(c, 0.f); ((bf16_t*)(tab + T_S128))[i] = (bf16_t)cvtpk(s, 0.f); }
      for (int i = gt; i < 64 * 64; i += gn) { const int a = i >> 6, b = i & 63; float s, c; sincos_d(6.283185307179586476925286766559 * (double)((a * b) & 63) / 64.0, s, c);
        ((bf16_t*)(tab + T_C64))[i] = (bf16_t)cvtpk(c, 0.f); ((bf16_t*)(tab + T_S64))[i] = (bf16_t)cvtpk(s, 0.f); }
      for (int i = gt; i < 32 * 32; i += gn) { const int a = i >> 5, b = i & 31; float s, c; sincos_d(6.283185307179586476925286766559 * (double)((a * b) & 31) / 32.0, s, c);
        ((bf16_t*)(tab + T_C32))[i] = (bf16_t)cvtpk(c, 0.f); ((bf16_t*)(tab + T_S32))[i] = (bf16_t)cvtpk(s, 0.f); }
      float* tl = (float*)lds;
      float* ctab = tl + 64 * 65;
      for (int it = blk; it < 2 * 3776; it += nblk) {
        const int l = it / 3776; int r = it % 3776;
        int mat, kt_, nt_;
        if (r < 384) { mat = 0; kt_ = r / 24; nt_ = r % 24; }
        else if (r < 640) { r -= 384; mat = 1; kt_ = r / 16; nt_ = r % 16; }
        else if (r < 1664) { r -= 640; mat = 2; kt_ = r / 64; nt_ = r % 64; }
        else if (r < 2688) { r -= 1664; mat = 3; kt_ = r / 64; nt_ = r % 64; }
        else if (r < 3712) { r -= 2688; mat = 4; kt_ = r / 16; nt_ = r % 16; }
        else { r -= 3712; mat = 5; kt_ = r / 4; nt_ = r % 4; }
        const float* src; int ld; const float* gain; bf16_t* dst; int dld;
        char* wl = ws + WS_W + (size_t)l * W_LAYER;
        int scol0 = nt_ * 64;
        if (mat == 0) { src = p.w_in + (size_t)l * DM * 1792; ld = 1792; gain = p.g_mix_pre + l * DM; dst = (bf16_t*)(wl + W_IN); dld = DM; }
        else if (mat == 1) { src = p.w_out + (size_t)l * DM * DM; ld = DM; gain = p.g_heads + l * DM; dst = (bf16_t*)(wl + W_OUT); dld = DM; }
        else if (mat == 2) { src = p.w_gate + (size_t)l * DM * DFF; ld = DFF; gain = p.g_ffn_pre + l * DM; dst = (bf16_t*)(wl + W_GU); dld = DM; }
        else if (mat == 3) { src = p.w_up + (size_t)l * DM * DFF; ld = DFF; gain = p.g_ffn_pre + l * DM; dst = (bf16_t*)(wl + W_GU); dld = DM; }
        else if (mat == 4) { src = p.w_down + (size_t)l * DFF * DM; ld = DM; gain = nullptr; dst = (bf16_t*)(wl + W_DOWN); dld = DFF; }
        else { src = p.w_in + (size_t)l * DM * 1792; ld = 1792; gain = p.g_mix_pre + l * DM; dst = (bf16_t*)(wl + W_IN); dld = DM; scol0 = 1536 + nt_ * 64; }
        const int k0 = kt_ * 64;
#pragma unroll
        for (int i = 0; i < 2; ++i) { const int kk = (tid >> 4) + 32 * i, n4 = (tid & 15) * 4; const f32x4 v = *(const f32x4*)(src + (size_t)(k0 + kk) * ld + scol0 + n4);
          tl[kk * 65 + n4] = v[0]; tl[kk * 65 + n4 + 1] = v[1]; tl[kk * 65 + n4 + 2] = v[2]; tl[kk * 65 + n4 + 3] = v[3]; }
        if (mat == 5 && tid < 64) { float s, c; sincos_d(6.283185307179586476925286766559 * (double)tid / 64.0, s, c); ctab[tid] = c; ctab[64 + tid] = s; }
        __syncthreads();
        if (mat != 5) {
          { const int nn = tid >> 3, k8 = (tid & 7) * 8;
            float v[8];
#pragma unroll
            for (int e = 0; e < 8; ++e) v[e] = tl[(k8 + e) * 65 + nn] * (gain ? gain[k0 + k8 + e] : 1.0f);
            int drow = nt_ * 64 + nn;
            if (mat == 2) drow = (nt_ >> 1) * 256 + (nt_ & 1) * 64 + nn; else if (mat == 3) drow = (nt_ >> 1) * 256 + 128 + (nt_ & 1) * 64 + nn;
            *(u32x4*)(dst + (size_t)drow * dld + k0 + k8) = pack8(v); }
        } else {
          for (int i = 0; i < 8; ++i) { const int idx = tid + 512 * i, np = idx >> 6, kk = idx & 63;
            const int ri = np > 32, cp = ri ? np - 32 : np; float a = 0.f;
            for (int c = 0; c < 64; ++c) { const int m = (c * cp) & 63; const float t = ri ? -ctab[64 + m] : ctab[m]; a += tl[kk * 65 + c] * t; }
            dst[(size_t)(1536 + nt_ * 64 + np) * dld + k0 + kk] = (bf16_t)cvtpk(a * gain[k0 + kk], 0.f); }
        }
        __syncthreads();
      }
#pragma unroll 2
      for (int row = blk * 8 + w; row < MT; row += nblk * 8) {
        const float* xr = row < MP ? p.x_prompt + (size_t)row * DM : p.x_sample + (size_t)(row - MP) * DM;
        rowpass(lane, nullptr, 0.f, xr, nullptr, nullptr, nullptr, XN + (size_t)row * DM, RS + row);
      }
    } } else {
      const int l = (ph - 1) >> 3, sub = (ph - 1) & 7;
      char* wl = ws + WS_W + (size_t)l * W_LAYER;
      if (sub == 0 && PHEN(1)) {
        const bf16_t* Bt = (const bf16_t*)(wl + W_IN);
        for (int vr = blk; vr < 256 * 9; vr += nblk) { const int rnd = vr >> 8, vb = vr & 255;
          const int li = (vb >> 3) + 32 * rnd; if (li >= 280) continue;
          const int mt = 8 * (li / 7) + (vb & 7), nt = li % 7;
          const pg8::Gemm g{XN, Bt, MT, NIN, DM};
          const OneUnit S1{(long)mt * 256, nt};
          const EpiP1 E{tid, mt * 256, nt, ws, p.g_q + l * 64, p.g_k + l * 64};
          pg8::gemm_phase<EpiP1, OneUnit, false, true>((PG8_LAS unsigned char*)lds, g, S1, E);
        }
      } else if (sub == 1 && PHEN(2)) {
        unsigned* ctr = ctl + 64 * (1 + step);
        for (;;) {
          if (tid == 0) s_item = (int)atomicAdd(ctr, 1u);
          __syncthreads();
          const int it = s_item;
          __syncthreads();
          if (it >= 8960) break;
          int tid_item = tid; asm volatile("" : "+v"(tid_item));
          { const int tid = tid_item, lane = tid & 63, w = tid >> 6, r32 = lane & 31, h = lane >> 5;
          if (it < 2560) {
            int seq, kvh, qblk, rh;
            if (it < 2048) { const int combo = it >> 7, wi = it & 127; seq = combo >> 1; kvh = combo & 1; qblk = wi >> 2; rh = wi & 3; }
            else { const int i2 = it - 2048; const int combo = i2 >> 6, wi = i2 & 63; seq = 8 + (combo >> 1); kvh = combo & 1; qblk = wi >> 2; rh = wi & 3; }
            int base, S; seq_info(seq, base, S);
            const int hq = kvh * 4 + rh;
            f32x16 O[2]; float m_run, l_run;
            float gk = __builtin_fabsf(p.g_k[l * 64 + lane]);
#pragma unroll
            for (int o = 32; o >= 1; o >>= 1) gk = __builtin_fmaxf(gk, __shfl_xor(gk, o));
            flash_grid(lds, tid, QB + hq * 64, KB + kvh * 64, VB + kvh * 64, base, qblk * 256, S >> 6, gk * 8.0f * 1.01f, O, l_run); m_run = 0.f;
            const float lt = l_run + __shfl_xor(l_run, 32); const float inv = 1.0f / lt;
            float ss = 0.f;
#pragma unroll
            for (int r = 0; r < 16; ++r) { O[0][r] *= inv; O[1][r] *= inv; ss += O[0][r] * O[0][r] + O[1][r] * O[1][r]; }
            ss += __shfl_xor(ss, 32);
            const float rr = rsqrtf(ss * (1.0f / 64.0f) + EPS);
            const int tok = base + qblk * 256 + 32 * w + r32;
            bf16_t* orow = OB + (size_t)tok * DM + 256 + hq * 64;
#pragma unroll
            for (int db = 0; db < 2; ++db)
#pragma unroll
              for (int g4 = 0; g4 < 4; ++g4) { u32x2 wv; wv[0] = cvtpk(O[db][4 * g4] * rr, O[db][4 * g4 + 1] * rr); wv[1] = cvtpk(O[db][4 * g4 + 2] * rr, O[db][4 * g4 + 3] * rr);
                *(u32x2*)(orow + 32 * db + 8 * g4 + 4 * h) = wv; }
          } else if (it < 6400) {
            const int i2 = it - 2560; const int pat = i2 / 1280; const int rem = i2 % 1280; const int head = rem & 3; const int tb = rem >> 2;
            int seq, ub; if (tb < 256) { seq = tb >> 5; ub = tb & 31; } else { seq = 8 + ((tb - 256) >> 4); ub = (tb - 256) & 15; }
            int base, S; seq_info(seq, base, S);
            const int dil = pat == 0 ? 1 : (pat == 1 ? 4 : 16); const int L = S / dil;
            const int u0 = ub * 256; const int res = u0 / L; const int i0 = u0 % L;
            f32x16 O[2]; float m_run, l_run;
            flash_dil(lds, tid, QA + head * 64, KA + head * 64, VA + head * 64, base + res, dil, L, i0, O, m_run, l_run);
            const float lt = l_run + __shfl_xor(l_run, 32); const float inv = 1.0f / lt;
            const int tok = base + res + dil * (i0 + 32 * w + r32);
            bf16_t* orow = PART + ((size_t)pat * MT + tok) * 256 + head * 64;
#pragma unroll
            for (int db = 0; db < 2; ++db)
#pragma unroll
              for (int g4 = 0; g4 < 4; ++g4) { u32x2 wv; wv[0] = cvtpk(O[db][4 * g4] * inv, O[db][4 * g4 + 1] * inv); wv[1] = cvtpk(O[db][4 * g4 + 2] * inv, O[db][4 * g4 + 3] * inv);
                *(u32x2*)(orow + 32 * db + 8 * g4 + 4 * h) = wv; }
            if (h == 0) LSE[((size_t)pat * MT + tok) * 4 + head] = m_run + __log2f(lt);
          } else {
            const int i2 = it - 6400; const int g = i2 & 3; const int mt = i2 >> 2;
            int seq, s2, S2; if (mt < 512) { seq = mt >> 6; s2 = mt & 63; S2 = 64; } else { seq = 8 + ((mt - 512) >> 5); s2 = (mt - 512) & 31; S2 = 32; }
            int base, S; seq_info(seq, base, S);
            { const int row = tid >> 2, q4 = tid & 3;
              const bf16_t* src = ZC + (size_t)(base + S2 * row + s2) * 256 + g * 64 + 16 * q4;
              const u32x4 v0 = *(const u32x4*)src, v1 = *(const u32x4*)(src + 8);
              bf16_t* trow = (bf16_t*)(lds + row * 320);
#pragma unroll
              for (int k = 0; k < 16; ++k) { const unsigned wd = (k < 8) ? v0[k >> 1] : v1[(k - 8) >> 1]; const bf16_t v = (bf16_t)((k & 1) ? (wd >> 16) : (wd & 0xffffu));
                const int j = 16 * q4 + k;
                if (j <= 32) { trow[j] = v; if (j >= 1 && j <= 31) trow[64 - j] = v; if (j == 0) trow[64] = 0; if (j == 32) trow[96] = 0; }
                else { const int cp = j - 32; trow[64 + cp] = v; trow[128 - cp] = (bf16_t)(v ^ 0x8000u); } } }
            __syncthreads();
            const int kb1 = w & 3, nb = w >> 2;
            f32x16 Ar = zero16(), Ai = zero16();
            const bf16_t* C1 = (const bf16_t*)(tab + T_C128) + (32 * kb1 + r32) * 128 + 8 * h; const bf16_t* S1t = (const bf16_t*)(tab + T_S128) + (32 * kb1 + r32) * 128 + 8 * h;
#pragma unroll
            for (int ks = 0; ks < 8; ++ks) {
              const bf16x8 aC = *(const bf16x8*)(C1 + 16 * ks), aS = *(const bf16x8*)(S1t + 16 * ks);
              const int rowA = 16 * ks + 8 * h;
              const bf16x8 zr = tr_frag(lds, 320, rowA, rowA + 4, nb * 32, lane), zi = tr_frag(lds, 320, rowA, rowA + 4, 64 + nb * 32, lane);
              const bf16x8 zrn = zr ^ (short)0x8000;
              Ar = mfma32(aC, zr, Ar); Ar = mfma32(aS, zi, Ar);
              Ai = mfma32(aC, zi, Ai); Ai = mfma32(aS, zrn, Ai);
            }
            const int twm = 8192 / S;
#pragma unroll
            for (int r = 0; r < 16; ++r) { const int k1 = 32 * kb1 + crow(r, h); const int ai = ((k1 * s2) & (S - 1)) * twm;
              const float cs = ((const float*)(tab + T_TW_C))[ai], sn = ((const float*)(tab + T_TW_S))[ai];
              bf16_t* orow = BF + (size_t)(base + k1 * S2 + s2) * 512 + g * 128;
              const float br = Ar[r] * cs + Ai[r] * sn, bi = Ai[r] * cs - Ar[r] * sn;
              orow[nb * 32 + r32] = (bf16_t)cvtpk(br, 0.f); orow[64 + nb * 32 + r32] = (bf16_t)cvtpk(bi, 0.f); }
            __syncthreads();
          }
          }
        }
      } else if (sub == 2 && PHEN(3)) {
        for (int it = blk; it < 1536 + 1280; it += nblk) {
          if (it < 1536) {
            int seq, kq, g, S2;
            if (it < 1024) { seq = it >> 7; kq = (it >> 2) & 31; g = it & 3; S2 = 64; } else { const int i2 = it - 1024; seq = 8 + (i2 >> 7); kq = (i2 >> 2) & 31; g = i2 & 3; S2 = 32; }
            int base, S; seq_info(seq, base, S);
            const int nch = 4 * S2 * 16;
            for (int c = tid; c < nch; c += 512) { const int sb = c / (S2 * 16), rc = c % (S2 * 16), row = rc >> 4, ch = rc & 15;
              *(u32x4*)(lds + sb * 20480 + row * 320 + ch * 16) = *(const u32x4*)(BF + (size_t)(base + (4 * kq + sb) * S2 + row) * 512 + g * 128 + ch * 8); }
            __syncthreads();
            const bool act = (S2 == 64) || (w < 4);
            if (act) {
              const int sb = (S2 == 64) ? (w >> 1) : w, mb = (S2 == 64) ? (w & 1) : 0;
              const char* tile = lds + sb * 20480;
              const bf16_t* Ct = (const bf16_t*)(tab + (S2 == 64 ? T_C64 : T_C32)) + (32 * mb + r32) * S2 + 8 * h;
              const bf16_t* St = (const bf16_t*)(tab + (S2 == 64 ? T_S64 : T_S32)) + (32 * mb + r32) * S2 + 8 * h;
              f32x16 Y[2]; Y[0] = zero16(); Y[1] = zero16();
              const int nks = S2 >> 4;
              for (int ks = 0; ks < nks; ++ks) {
                const bf16x8 aC = *(const bf16x8*)(Ct + 16 * ks), aS = *(const bf16x8*)(St + 16 * ks);
                const int rowA = 16 * ks + 8 * h;
#pragma unroll
                for (int nb = 0; nb < 2; ++nb) { const bf16x8 br = tr_frag(tile, 320, rowA, rowA + 4, nb * 32, lane), bi = tr_frag(tile, 320, rowA, rowA + 4, 64 + nb * 32, lane);
                  Y[nb] = mfma32(aC, br, Y[nb]); Y[nb] = mfma32(aS, bi, Y[nb]); }
              }
              const int k1 = 4 * kq + sb;
#pragma unroll
              for (int r = 0; r < 16; ++r) { float ss = Y[0][r] * Y[0][r] + Y[1][r] * Y[1][r];
                ss += __shfl_xor(ss, 1); ss += __shfl_xor(ss, 2); ss += __shfl_xor(ss, 4); ss += __shfl_xor(ss, 8); ss += __shfl_xor(ss, 16);
                const float rr = rsqrtf(ss * (1.0f / 64.0f) + EPS);
                const int tok = base + k1 + 128 * (32 * mb + crow(r, h));
                bf16_t* orow = OB + (size_t)tok * DM + 768 + g * 64;
                orow[r32] = (bf16_t)cvtpk(Y[0][r] * rr, 0.f); orow[32 + r32] = (bf16_t)cvtpk(Y[1][r] * rr, 0.f); }
            }
            __syncthreads();
          } else {
            const int t0 = (it - 1536) * 64;
            for (int pp = 0; pp < 4; ++pp) { const int idx = pp * 512 + tid; const int tok = t0 + (idx >> 5), head = (idx >> 3) & 3, dch = idx & 7;
              float ls[3]; u32x4 pv[3];
#pragma unroll
              for (int q = 0; q < 3; ++q) { ls[q] = LSE[((size_t)q * MT + tok) * 4 + head]; pv[q] = *(const u32x4*)(PART + ((size_t)q * MT + tok) * 256 + head * 64 + dch * 8); }
              const float mx = fmaxf(ls[0], fmaxf(ls[1], ls[2]));
              float wq[3]; float wsum = 0.f;
#pragma unroll
              for (int q = 0; q < 3; ++q) { wq[q] = fexp2(ls[q] - mx); wsum += wq[q]; }
              const float iw = 1.0f / wsum;
              float o[8];
#pragma unroll
              for (int e = 0; e < 8; ++e) o[e] = 0.f;
#pragma unroll
              for (int q = 0; q < 3; ++q) { const float ww = wq[q] * iw;
#pragma unroll
                for (int e2 = 0; e2 < 4; ++e2) { o[2 * e2] += ww * bflo(pv[q][e2]); o[2 * e2 + 1] += ww * bfhi(pv[q][e2]); } }
              float ss = 0.f;
#pragma unroll
              for (int e = 0; e < 8; ++e) ss += o[e] * o[e];
              ss += __shfl_xor(ss, 1); ss += __shfl_xor(ss, 2); ss += __shfl_xor(ss, 4);
              const float rr = rsqrtf(ss * (1.0f / 64.0f) + EPS);
#pragma unroll
              for (int e = 0; e < 8; ++e) o[e] *= rr;
              *(u32x4*)(OB + (size_t)tok * DM + head * 64 + dch * 8) = pack8(o); }
          }
        }
      } else if ((sub == 3 || sub == 6) && PHEN(4)) {
        const bf16_t* A = (sub == 3) ? OB : ACT; const int K = (sub == 3) ? DM : DFF;
        const bf16_t* Bt = (const bf16_t*)(wl + (sub == 3 ? W_OUT : W_DOWN));
        bf16_t* dst = (sub == 3) ? MIX : FF;
        for (int vr = blk; vr < 256 * 5; vr += nblk) { const int rnd = vr >> 8, vb = vr & 255;
          int mt, nt; if (!tile_map(rnd, vb, 320, 4, 8, 4, mt, nt)) continue;
          const pg8::Gemm g{A, Bt, MT, DM, K};
          const OneUnit S1{(long)mt * 256, nt};
          const EpiPlain E{tid, mt * 256, nt * 256, dst, tab};
          pg8::gemm_phase<EpiPlain, OneUnit, false, true>((PG8_LAS unsigned char*)lds, g, S1, E);
        }
      } else if ((sub == 4 || sub == 7) && PHEN(5)) {
        const bool first = (sub == 4);
        const float* gpost = (first ? p.g_mix_post : p.g_ffn_post) + l * DM;
        const bf16_t* add = first ? MIX : FF;
        const bool need_xn = !(l == 1 && sub == 7);
#pragma unroll 4
      for (int row = blk * 8 + w; row < MT; row += nblk * 8) {
          const bool last = (l == 1 && sub == 7);
          rowpass(lane, XN + (size_t)row * DM, RS[row], nullptr, add + (size_t)row * DM, gpost, last ? p.out + (size_t)row * DM : nullptr, last ? nullptr : XN + (size_t)row * DM, RS + row);
        }
      } else if (sub == 5 && PHEN(6)) {
        const bf16_t* Bt = (const bf16_t*)(wl + W_GU);
        const float* cw = p.conv_w + (size_t)l * 3 * DFF; const float* cb = p.conv_b + (size_t)l * DFF;
        for (int vr = blk; vr < 256 * 41; vr += nblk) { const int rnd = vr >> 8, vb = vr & 255;
          int mt, nt; if (!tile_map(rnd, vb, 323, 32, 4, 8, mt, nt)) continue;
          const int p0 = 254 * mt - 1;
          const pg8::Gemm g{XN, Bt, MT, 2 * DFF, DM};
          const OneUnit S1{(long)p0, nt};
          const EpiP4 E{tid, p0, nt, cw, cb, ACT};
          pg8::gemm_phase<EpiP4, OneUnit, false, true>((PG8_LAS unsigned char*)lds, g, S1, E);
        }
      }
    }
  }
    if (step < p.phi) { if (p.plo < 0) cg::this_grid().sync(); else xcd_barrier(xbar); }
  }
}

extern "C" void kernel_launch(void* const* d_in, const int* in_sizes, int n_in, void* d_out, int out_size, void* d_ws, size_t ws_size, hipStream_t stream) {
  (void)in_sizes; (void)n_in; (void)out_size; (void)ws_size;
  static int grid_blocks = 0;
  if (!grid_blocks) {
    int dev = 0, cus = 0, per_cu = 0;
    hipGetDevice(&dev);
    hipDeviceGetAttribute(&cus, hipDeviceAttributeMultiprocessorCount, dev);
    hipOccupancyMaxActiveBlocksPerMultiprocessor(&per_cu, mega, NTHREADS, 0);
    if (per_cu > 1) per_cu = 1;
    if (per_cu < 1) per_cu = 1;
    grid_blocks = cus * per_cu; if (grid_blocks > 256) grid_blocks = 256;
  }
  Params p{};
  p.x_prompt = (const float*)d_in[0]; p.x_sample = (const float*)d_in[1];
  p.g_mix_pre = (const float*)d_in[2]; p.g_mix_post = (const float*)d_in[3]; p.w_in = (const float*)d_in[4]; p.g_q = (const float*)d_in[5]; p.g_k = (const float*)d_in[6];
  p.g_heads = (const float*)d_in[7]; p.w_out = (const float*)d_in[8]; p.g_ffn_pre = (const float*)d_in[9]; p.g_ffn_post = (const float*)d_in[10];
  p.w_gate = (const float*)d_in[11]; p.w_up = (const float*)d_in[12]; p.conv_w = (const float*)d_in[13]; p.conv_b = (const float*)d_in[14]; p.w_down = (const float*)d_in[15];
  p.out = (float*)d_out; p.ws = (char*)d_ws;
  hipMemsetAsync(d_ws, 0, 65536, stream);
#if MULTI_LAUNCH
  for (int ph = 0; ph <= 16; ++ph) p.seq[ph] = ph;
  for (int ph = 0; ph <= 16; ++ph) { p.plo = ph; p.phi = ph; hipLaunchKernelGGL(mega, dim3(grid_blocks), dim3(NTHREADS), 0, stream, p); }
#else
  int ns = 0;
  for (int ph = 0; ph <= 16; ++ph) { p.seq[ns++] = ph; if (ph >= 1 && ((ph - 1) & 7) == DUPSUB) p.seq[ns++] = ph; if (ph == DUPPH) p.seq[ns++] = ph; }
  p.plo = 0; p.phi = ns - 1;
  void* args[] = {&p};
  hipError_t e = hipLaunchCooperativeKernel((void*)mega, dim3(grid_blocks), dim3(NTHREADS), args, 0, stream);
  if (e != hipSuccess) fprintf(stderr, "cooperative launch failed: %s (grid %d)\n", hipGetErrorString(e), grid_blocks);
#endif
}
```

```cpp
#include <hip/hip_runtime.h>
#include <hip/hip_cooperative_groups.h>
#include <cstdio>
#include <cstdint>
namespace cg = cooperative_groups;

#define DI __device__ __forceinline__
typedef unsigned short bf16_t;
typedef short bf16x8 __attribute__((ext_vector_type(8)));
typedef short s16x4 __attribute__((ext_vector_type(4)));
typedef float f32x16 __attribute__((ext_vector_type(16)));
typedef float f32x4 __attribute__((ext_vector_type(4)));
typedef float f32x2 __attribute__((ext_vector_type(2)));
typedef unsigned u32x4 __attribute__((ext_vector_type(4)));
typedef unsigned u32x2 __attribute__((ext_vector_type(2)));
typedef __bf16 bf16x2_t __attribute__((ext_vector_type(2)));
typedef short v4i16_t __attribute__((ext_vector_type(4)));

#ifndef USE_TR
#define USE_TR 1
#endif
#ifndef PHMASK
#define PHMASK 0x1ff
#endif
#define PHEN(b) ((PHMASK>>(b))&1)
#ifndef DUPSUB
#define DUPSUB -1
#endif
#ifndef DUPPH
#define DUPPH -1
#endif
#ifndef MULTI_LAUNCH
#define MULTI_LAUNCH 0
#endif

constexpr int DM = 1024, DFF = 4096;
constexpr int MP = 65536, MS = 16384, MT = MP + MS;
constexpr int NIN = 1792;
constexpr float EPS = 1e-6f;
constexpr float QSCALE = 0.125f * 1.4426950408889634f;
constexpr int NTHREADS = 512;
constexpr int CST = 260;
constexpr int LDS_BYTES = 129 * CST * 4;

constexpr size_t MiB = 1ull << 20;
constexpr size_t WS_CTL = 0;
constexpr size_t WS_TAB = 1 * MiB;
constexpr size_t WS_W = 4 * MiB;
constexpr size_t W_LAYER = 30 * MiB, W_IN = 0, W_OUT = 4 * MiB, W_GU = 6 * MiB, W_DOWN = 22 * MiB;
constexpr size_t WS_XN = 64 * MiB;
constexpr size_t WS_O = 224 * MiB;
constexpr size_t WS_QA = 384 * MiB, WS_KA = 424 * MiB, WS_VA = 464 * MiB, WS_QB = 504 * MiB, WS_KB = 584 * MiB, WS_VB = 604 * MiB;
constexpr size_t WS_ZC = 624 * MiB, WS_BF = 704 * MiB, WS_PART = 784 * MiB, WS_LSE = 904 * MiB;
constexpr size_t WS_MIX = 384 * MiB;
constexpr size_t WS_ACT = 224 * MiB;
constexpr size_t WS_FF = 864 * MiB;
constexpr size_t WS_RS = 3 * MiB;
constexpr size_t WS_END = 1024 * MiB;
constexpr size_t T_ROPET_C = 0, T_ROPET_S = 256 * 1024;
constexpr size_t T_ROPER_C = 512 * 1024, T_ROPER_S = T_ROPER_C + 8192;
constexpr size_t T_ROPEC_C = T_ROPER_S + 8192, T_ROPEC_S = T_ROPEC_C + 4096;
constexpr size_t T_TW_C = 640 * 1024, T_TW_S = T_TW_C + 32768;
constexpr size_t T_C128 = 768 * 1024, T_S128 = T_C128 + 32768;
constexpr size_t T_C64 = T_S128 + 32768, T_S64 = T_C64 + 8192;
constexpr size_t T_C32 = T_S64 + 8192, T_S32 = T_C32 + 2048;

struct Params {
  const float* x_prompt; const float* x_sample;
  const float* g_mix_pre; const float* g_mix_post; const float* w_in; const float* g_q; const float* g_k; const float* g_heads; const float* w_out;
  const float* g_ffn_pre; const float* g_ffn_post; const float* w_gate; const float* w_up; const float* conv_w; const float* conv_b; const float* w_down;
  float* out; char* ws;
  int plo, phi;
  int seq[30];
};

DI unsigned cvtpk(float lo, float hi) { f32x2 v = {lo, hi}; bf16x2_t b = __builtin_convertvector(v, bf16x2_t); return __builtin_bit_cast(unsigned, b); }
DI float bflo(unsigned u) { return __uint_as_float(u << 16); }
DI float bfhi(unsigned u) { return __uint_as_float(u & 0xffff0000u); }
DI int crow(int reg, int h) { return (reg & 3) + 8 * (reg >> 2) + 4 * h; }
DI f32x16 mfma32(bf16x8 a, bf16x8 b, f32x16 c) { return __builtin_amdgcn_mfma_f32_32x32x16_bf16(a, b, c, 0, 0, 0); }
DI float fexp2(float x) { return __builtin_amdgcn_exp2f(x); }
DI f32x16 zero16() { f32x16 z;
#pragma unroll
  for (int i = 0; i < 16; ++i) z[i] = 0.f; return z; }
DI int seq_of_token(int tok, int& base, int& S) { if (tok < MP) { int s = tok >> 13; base = s << 13; S = 8192; return s; } int j = (tok - MP) >> 12; base = MP + (j << 12); S = 4096; return 8 + j; }
DI void seq_info(int seq, int& base, int& S) { if (seq < 8) { base = seq << 13; S = 8192; } else { base = MP + ((seq - 8) << 12); S = 4096; } }

DI void sincos_d(double a, float& s, float& c) {
  const double TWO_PI = 6.283185307179586476925286766559;
  a -= TWO_PI * __builtin_rint(a / TWO_PI);
  const double x2 = a * a;
  double ts = 1.0, tc = 1.0, ss = 1.0, cc = 1.0;
#pragma unroll
  for (int n = 1; n <= 13; ++n) { tc *= -x2 / (double)((2 * n - 1) * (2 * n)); ts *= -x2 / (double)((2 * n) * (2 * n + 1)); cc += tc; ss += ts; }
  s = (float)(a * ss); c = (float)cc;
}

DI bf16x8 tr_frag(const char* tile, int rs, int rowA, int rowB, int n0, int lane) {
#if USE_TR
  const int i16 = lane & 15, q4 = i16 >> 2, p4 = i16 & 3, nh = (lane >> 4) & 1;
  const char* a1 = tile + (rowA + q4) * rs + (n0 + 16 * nh + 4 * p4) * 2;
  const char* a2 = tile + (rowB + q4) * rs + (n0 + 16 * nh + 4 * p4) * 2;
  v4i16_t lo = __builtin_amdgcn_ds_read_tr16_b64_v4i16((__attribute__((address_space(3))) v4i16_t*)a1);
  v4i16_t hi = __builtin_amdgcn_ds_read_tr16_b64_v4i16((__attribute__((address_space(3))) v4i16_t*)a2);
  return (bf16x8){lo[0], lo[1], lo[2], lo[3], hi[0], hi[1], hi[2], hi[3]};
#else
  const int c = n0 + (lane & 31);
  bf16x8 f;
#pragma unroll
  for (int j = 0; j < 4; ++j) { f[j] = *(const short*)(tile + (rowA + j) * rs + c * 2); f[4 + j] = *(const short*)(tile + (rowB + j) * rs + c * 2); }
  return f;
#endif
}

DI float wave_sum(float v) {
#pragma unroll
  for (int o = 32; o >= 1; o >>= 1) v += __shfl_xor(v, o);
  return v;
}

DI void rowpass(int lane, const bf16_t* xn_in_row, float s_in, const float* xin_row, const bf16_t* add_row, const float* gpost, float* xout_row, bf16_t* xn_row, float* s_out) {
  float x[16];
  if (xin_row) {
#pragma unroll
    for (int i = 0; i < 4; ++i) { const f32x4 v = *(const f32x4*)(xin_row + i * 256 + lane * 4); x[4 * i] = v[0]; x[4 * i + 1] = v[1]; x[4 * i + 2] = v[2]; x[4 * i + 3] = v[3]; }
  } else {
#pragma unroll
    for (int i = 0; i < 4; ++i) { const u32x2 v = *(const u32x2*)(xn_in_row + i * 256 + lane * 4); x[4 * i] = bflo(v[0]) * s_in; x[4 * i + 1] = bfhi(v[0]) * s_in; x[4 * i + 2] = bflo(v[1]) * s_in; x[4 * i + 3] = bfhi(v[1]) * s_in; }
  }
  if (add_row) {
    float a[16]; float ss = 0.f;
#pragma unroll
    for (int i = 0; i < 4; ++i) { const u32x2 v = *(const u32x2*)(add_row + i * 256 + lane * 4); a[4 * i] = bflo(v[0]); a[4 * i + 1] = bfhi(v[0]); a[4 * i + 2] = bflo(v[1]); a[4 * i + 3] = bfhi(v[1]); }
#pragma unroll
    for (int i = 0; i < 16; ++i) ss += a[i] * a[i];
    ss = wave_sum(ss);
    const float ra = rsqrtf(ss * (1.0f / 1024.0f) + EPS);
#pragma unroll
    for (int i = 0; i < 4; ++i) { const f32x4 g = *(const f32x4*)(gpost + i * 256 + lane * 4);
#pragma unroll
      for (int e = 0; e < 4; ++e) x[4 * i + e] += a[4 * i + e] * ra * g[e]; }
  }
  if (xout_row) {
#pragma unroll
    for (int i = 0; i < 4; ++i) *(f32x4*)(xout_row + i * 256 + lane * 4) = (f32x4){x[4 * i], x[4 * i + 1], x[4 * i + 2], x[4 * i + 3]};
  }
  if (xn_row) {
    float ss = 0.f;
#pragma unroll
    for (int i = 0; i < 16; ++i) ss += x[i] * x[i];
    ss = wave_sum(ss);
    const float ms = ss * (1.0f / 1024.0f) + EPS;
    const float rx = rsqrtf(ms);
#pragma unroll
    for (int i = 0; i < 4; ++i) { u32x2 w; w[0] = cvtpk(x[4 * i] * rx, x[4 * i + 1] * rx); w[1] = cvtpk(x[4 * i + 2] * rx, x[4 * i + 3] * rx); *(u32x2*)(xn_row + i * 256 + lane * 4) = w; }
    if (lane == 0) *s_out = __builtin_sqrtf(ms);
  }
}

namespace pg8 {
#define PG8_LAS __attribute__((address_space(3)))
typedef unsigned short bf16_t;
typedef short bf16x8 __attribute__((ext_vector_type(8)));
typedef float f32x4 __attribute__((ext_vector_type(4)));
typedef unsigned u32x4 __attribute__((ext_vector_type(4)));
constexpr int BM = 256, BK = 64, HALF = 128, HTB = HALF * BK * 2  , STAGE_BYTES = 8 * HTB, NXCD = 8, WGM = 8;

__host__ __device__ __forceinline__ int lds_byte(int r, int c) { const int st = (r >> 4) * 2 + (c >> 5), rr = r & 15, cc = c & 31, ob = rr * 64 + cc * 2; return st * 1024 + (ob ^ (((ob >> 9) & 1) << 5)); }
__host__ __device__ __forceinline__ void stage_rc(int b, int& R, int& C) { const int st = b / 1024, sb = b % 1024, swz = sb ^ (((sb >> 9) & 1) << 5); R = (st >> 1) * 16 + swz / 64; C = (st & 1) * 32 + (swz % 64) / 2; }
__host__ __device__ __forceinline__ int perm32(int rho) { const int n = rho >> 4, i = rho & 15; return 8 * (i >> 2) + 4 * n + (i & 3); }

struct Unit { int pm, pn; long arow; };
struct Gemm { const bf16_t* A; const bf16_t* Bt; int M, N, K; };
template <class Epi, class Sched, bool ALIGN_EPI = false, bool SP2 = false>
__device__ __forceinline__ void gemm_phase(PG8_LAS unsigned char* lds, const Gemm g, const Sched& S, const Epi& E) {
    int tid_ = threadIdx.x; asm volatile("" : "+v"(tid_));
    const int tid = tid_, wid = __builtin_amdgcn_readfirstlane(tid >> 6), lane = tid & 63, wr = wid >> 2, wc = wid & 3, fr = lane & 15, fq = lane >> 4;
    const int K = g.K, nt = K / BK;
    unsigned voffA[2], voffB[2];
#pragma unroll
    for (int i = 0; i < 2; ++i) { int R, C; stage_rc(tid * 16 + i * 8192, R, C); const int Rb = Epi::PERM ? ((R & ~31) + perm32(R & 31)) : R;
        voffA[i] = (unsigned)(R * K + C) * 2u; voffB[i] = (unsigned)(Rb * K + C) * 2u; }
    const size_t kstep = (size_t)(BK * 2);
    const size_t hstep = (size_t)HALF * K * 2;
    const size_t tstep = 2 * hstep;
    const unsigned ldsw = (unsigned)wid * 1024u;
    const int aoff = lds_byte(wr * 64 + fr, fq * 8), boff = lds_byte(wc * 32 + fr, fq * 8);
#define PG8_SA(b, h) (((b) * 2 + (h)) * HTB)
#define PG8_SB(b, h) ((4 + (b) * 2 + (h)) * HTB)
#define PG8_STAGE(bufoff, gbase, voff) do { _Pragma("unroll") for (int _i = 0; _i < 2; ++_i) \
        __builtin_amdgcn_global_load_lds((const unsigned*)((const char*)(gbase) + (voff)[_i]), (PG8_LAS unsigned*)(lds + (bufoff) + ldsw + _i * 8192), 16, 0, 0); } while (0)
#define PG8_LDA(dst, b, h) do { _Pragma("unroll") for (int m = 0; m < 4; ++m) _Pragma("unroll") for (int k = 0; k < 2; ++k) dst[m][k] = *(const PG8_LAS bf16x8*)(lds + PG8_SA(b, h) + aoff + m * 2048 + k * 1024); } while (0)
#define PG8_LDB(dst, b, h) do { _Pragma("unroll") for (int n = 0; n < 2; ++n) _Pragma("unroll") for (int k = 0; k < 2; ++k) dst[n][k] = *(const PG8_LAS bf16x8*)(lds + PG8_SB(b, h) + boff + n * 2048 + k * 1024); } while (0)
#define PG8_MMA(ai, bj, At, Bt) do { __builtin_amdgcn_s_setprio(1); _Pragma("unroll") for (int m = 0; m < 4; ++m) _Pragma("unroll") for (int n = 0; n < 2; ++n) _Pragma("unroll") for (int k = 0; k < 2; ++k) \
        acc[ai][bj][m][n] = __builtin_amdgcn_mfma_f32_16x16x32_bf16(Bt[n][k], At[m][k], acc[ai][bj][m][n], 0, 0, 0); __builtin_amdgcn_s_setprio(0); } while (0)
#define PG8_WAIT_V(n) asm volatile("s_waitcnt vmcnt(" #n ")" ::: "memory")
#define PG8_WAIT_L(n) asm volatile("s_waitcnt lgkmcnt(" #n ")" ::: "memory")
#define PG8_BAR __builtin_amdgcn_s_barrier()
#define PG8_SCHED __builtin_amdgcn_sched_barrier(0)
    Unit cur, nxt; int ui = 0;
    if (!S.next(0, cur)) return;
    f32x4 acc[2][2][4][2];
#pragma unroll
    for (int a = 0; a < 2; ++a)
#pragma unroll
        for (int b = 0; b < 2; ++b)
#pragma unroll
            for (int m = 0; m < 4; ++m)
#pragma unroll
                for (int n = 0; n < 2; ++n) acc[a][b][m][n] = (f32x4){0.f, 0.f, 0.f, 0.f};
    bf16x8 At[4][2], B0[2][2], B1[2][2];
    const char* cA = (const char*)g.A + cur.arow * (long)(K * 2); const char* cB = (const char*)g.Bt + (size_t)cur.pn * tstep;
    S.a_ready(cur);
    if constexpr (SP2) {
        PG8_STAGE(PG8_SB(0, 0), cB, voffB); PG8_STAGE(PG8_SB(0, 1), cB + hstep, voffB); PG8_STAGE(PG8_SA(0, 0), cA, voffA); PG8_STAGE(PG8_SA(0, 1), cA + hstep, voffA);
        if (wr == 1) PG8_BAR;
        PG8_WAIT_V(2); PG8_BAR;
        PG8_STAGE(PG8_SB(1, 0), cB + kstep, voffB); PG8_STAGE(PG8_SA(1, 0), cA + kstep, voffA); PG8_STAGE(PG8_SB(1, 1), cB + hstep + kstep, voffB);
        PG8_WAIT_V(6); PG8_BAR;
    } else {
        PG8_STAGE(PG8_SB(0, 0), cB, voffB); PG8_STAGE(PG8_SA(0, 0), cA, voffA); PG8_STAGE(PG8_SB(0, 1), cB + hstep, voffB); PG8_STAGE(PG8_SA(0, 1), cA + hstep, voffA);
        if (wr == 1) PG8_BAR;
        PG8_WAIT_V(4); PG8_BAR;
        PG8_STAGE(PG8_SB(1, 0), cB + kstep, voffB); PG8_STAGE(PG8_SA(1, 0), cA + kstep, voffA); PG8_STAGE(PG8_SB(1, 1), cB + hstep + kstep, voffB);
        PG8_WAIT_V(6); PG8_BAR;
    }
    for (;;) {
        const bool has_next = S.next(ui + 1, nxt);
        const char* nA = has_next ? (const char*)g.A + nxt.arow * (long)(K * 2) : cA; const char* nB = has_next ? (const char*)g.Bt + (size_t)nxt.pn * tstep : cB;
        for (int t = 0; t < nt; t += 2) {
            const bool last = (t == nt - 2);
            const char* a1 = cA + (size_t)(t + 1) * kstep;
            const char* a2 = last ? nA : cA + (size_t)(t + 2) * kstep; const char* b2 = last ? nB : cB + (size_t)(t + 2) * kstep;
            const char* a3 = a2 + kstep; const char* b3 = b2 + kstep;
            if (last && has_next) S.a_ready(nxt);
            if constexpr (SP2) {
            PG8_LDB(B0, 0, 0); PG8_LDB(B1, 0, 1); PG8_SCHED; PG8_LDA(At, 0, 0); PG8_STAGE(PG8_SA(1, 1), a1 + hstep, voffA);
            PG8_WAIT_V(8); PG8_WAIT_L(0); PG8_BAR; PG8_MMA(0, 0, At, B0); PG8_MMA(0, 1, At, B1); PG8_BAR; PG8_SCHED;
            PG8_LDA(At, 0, 1); PG8_STAGE(PG8_SB(0, 0), b2, voffB); PG8_STAGE(PG8_SB(0, 1), b2 + hstep, voffB); PG8_STAGE(PG8_SA(0, 0), a2, voffA);
            PG8_WAIT_V(8); PG8_WAIT_L(0); PG8_BAR; PG8_MMA(1, 0, At, B0); PG8_MMA(1, 1, At, B1); PG8_BAR; PG8_SCHED;
            PG8_LDB(B0, 1, 0); PG8_LDB(B1, 1, 1); PG8_SCHED; PG8_LDA(At, 1, 0); PG8_STAGE(PG8_SA(0, 1), a2 + hstep, voffA);
            PG8_WAIT_V(8); PG8_WAIT_L(0); PG8_BAR; PG8_MMA(0, 0, At, B0); PG8_MMA(0, 1, At, B1); PG8_BAR; PG8_SCHED;
            PG8_LDA(At, 1, 1); PG8_STAGE(PG8_SB(1, 0), b3, voffB); PG8_STAGE(PG8_SB(1, 1), b3 + hstep, voffB); PG8_STAGE(PG8_SA(1, 0), a3, voffA);
            PG8_WAIT_V(8); PG8_WAIT_L(0); PG8_BAR; PG8_MMA(1, 0, At, B0); PG8_MMA(1, 1, At, B1); PG8_BAR; PG8_SCHED;
            } else {
            PG8_LDB(B0, 0, 0); PG8_SCHED; PG8_LDA(At, 0, 0); PG8_STAGE(PG8_SA(1, 1), a1 + hstep, voffA);
            PG8_WAIT_L(8); PG8_BAR; PG8_WAIT_L(0); PG8_MMA(0, 0, At, B0); PG8_BAR; PG8_SCHED;
            PG8_LDB(B1, 0, 1); PG8_STAGE(PG8_SB(0, 0), b2, voffB);
            PG8_BAR; PG8_WAIT_L(0); PG8_MMA(0, 1, At, B1); PG8_BAR;
            PG8_LDA(At, 0, 1); PG8_STAGE(PG8_SA(0, 0), a2, voffA);
            PG8_BAR; PG8_WAIT_L(0); PG8_MMA(1, 0, At, B0); PG8_BAR; PG8_SCHED;
            PG8_STAGE(PG8_SB(0, 1), b2 + hstep, voffB);
            PG8_WAIT_V(6); PG8_BAR; PG8_MMA(1, 1, At, B1); PG8_BAR;
            PG8_LDB(B0, 1, 0); PG8_SCHED; PG8_LDA(At, 1, 0); PG8_STAGE(PG8_SA(0, 1), a2 + hstep, voffA);
            PG8_WAIT_L(8); PG8_BAR; PG8_WAIT_L(0); PG8_MMA(0, 0, At, B0); PG8_BAR; PG8_SCHED;
            PG8_LDB(B1, 1, 1); PG8_STAGE(PG8_SB(1, 0), b3, voffB);
            PG8_BAR; PG8_WAIT_L(0); PG8_MMA(0, 1, At, B1); PG8_BAR;
            PG8_LDA(At, 1, 1); PG8_STAGE(PG8_SA(1, 0), a3, voffA);
            PG8_BAR; PG8_WAIT_L(0); PG8_MMA(1, 0, At, B0); PG8_BAR; PG8_SCHED;
            PG8_STAGE(PG8_SB(1, 1), b3 + hstep, voffB);
            PG8_WAIT_V(6); PG8_BAR; PG8_MMA(1, 1, At, B1); PG8_BAR;
            }
        }
        if constexpr (ALIGN_EPI) { if (wr == 0) PG8_BAR; }
        if constexpr (!Epi::AFTER_DRAIN) { E(acc, cur, wr, wc, fr, fq); S.done(cur); }
        if (!has_next) break;
#pragma unroll
        for (int a = 0; a < 2; ++a)
#pragma unroll
            for (int b = 0; b < 2; ++b)
#pragma unroll
                for (int m = 0; m < 4; ++m)
#pragma unroll
                    for (int n = 0; n < 2; ++n) acc[a][b][m][n] = (f32x4){0.f, 0.f, 0.f, 0.f};
        cur = nxt; cA = nA; cB = nB; ++ui;
        if constexpr (ALIGN_EPI) { if (wr == 1) PG8_BAR; }
    }
    PG8_WAIT_V(0);
    if constexpr (!ALIGN_EPI) { if (wr == 0) PG8_BAR; }
    PG8_BAR;
    if constexpr (Epi::AFTER_DRAIN) { E.fused(acc, cur, wr, wc, fr, fq, lds, wid, lane); S.done(cur); }
#undef PG8_SA
#undef PG8_SB
#undef PG8_STAGE
#undef PG8_LDA
#undef PG8_LDB
#undef PG8_MMA
#undef PG8_WAIT_V
#undef PG8_WAIT_L
#undef PG8_BAR
#undef PG8_SCHED
}
}

DI int swz(int row, int ch) { return row * 128 + ((ch ^ ((row >> 1) & 7)) << 4); }
template <int AI> DI void stage_t(char* lds, const pg8::f32x4 (&acc)[2][2][4][2], int wr, int wc, int fr, int fq, int shift) {
  float* sC = (float*)lds;
#pragma unroll
  for (int bj = 0; bj < 2; ++bj)
#pragma unroll
    for (int m = 0; m < 4; ++m)
#pragma unroll
      for (int n = 0; n < 2; ++n) *(pg8::f32x4*)(sC + (64 * wr + 16 * m + fr + shift) * CST + 128 * bj + 32 * wc + 16 * n + 4 * fq) = acc[AI][bj][m][n];
}
DI void ld8(const float* p, float (&v)[8]) { const f32x4 a = *(const f32x4*)p, b = *(const f32x4*)(p + 4); v[0] = a[0]; v[1] = a[1]; v[2] = a[2]; v[3] = a[3]; v[4] = b[0]; v[5] = b[1]; v[6] = b[2]; v[7] = b[3]; }
DI u32x4 pack8(const float (&v)[8]) { u32x4 w; w[0] = cvtpk(v[0], v[1]); w[1] = cvtpk(v[2], v[3]); w[2] = cvtpk(v[4], v[5]); w[3] = cvtpk(v[6], v[7]); return w; }

enum { EPI_PLAIN = 0, EPI_ROPEA = 1, EPI_NRB = 2 };
DI void ld4(const float* p, float (&v)[4]) { const f32x4 a = *(const f32x4*)p; v[0] = a[0]; v[1] = a[1]; v[2] = a[2]; v[3] = a[3]; }
DI void epi_rows(char* lds, int tid, int kind, int tok0, int sc0, bf16_t* dst, int pitch, int col0, float scale, const float* gain, const char* tab) {
  const float* sC = (const float*)lds + sc0;
  const int lane = tid & 63, w = tid >> 6, j = lane & 31, jj = j & 15;
#pragma unroll 2
  for (int pass = 0; pass < 8; ++pass) {
    const int row = pass * 16 + w * 2 + (lane >> 5);
    const int tok = tok0 + row;
    float v[4]; ld4(sC + row * CST + 4 * j, v);
    if (kind == EPI_ROPEA) {
      if (jj < 4) {
        const int pos = (tok < MP) ? (tok & 8191) : (tok & 4095);
        float o[4]; ld4(sC + row * CST + 4 * (j ^ 2), o);
        float cs[4], sn[4]; ld4((const float*)(tab + T_ROPET_C) + pos * 8 + 4 * (jj & 1), cs); ld4((const float*)(tab + T_ROPET_S) + pos * 8 + 4 * (jj & 1), sn);
#pragma unroll
        for (int e = 0; e < 4; ++e) v[e] = (jj < 2) ? (v[e] * cs[e] - o[e] * sn[e]) : (v[e] * cs[e] + o[e] * sn[e]);
      }
    } else if (kind == EPI_NRB) {
      float ss = v[0] * v[0] + v[1] * v[1] + v[2] * v[2] + v[3] * v[3];
      ss += __shfl_xor(ss, 1); ss += __shfl_xor(ss, 2); ss += __shfl_xor(ss, 4); ss += __shfl_xor(ss, 8);
      const float rr = rsqrtf(ss * (1.0f / 64.0f) + EPS);
      float o[4]; ld4(sC + row * CST + 4 * (j ^ 4), o);
      float go[4], gp[4]; ld4(gain + 4 * jj, go); ld4(gain + 4 * (jj ^ 4), gp);
      const int pos = (tok < MP) ? (tok & 8191) : (tok & 4095);
      const float* tc = (jj < 8) ? ((const float*)(tab + T_ROPER_C) + (pos >> 6) * 16) : ((const float*)(tab + T_ROPEC_C) + (pos & 63) * 16);
      const float* ts = (jj < 8) ? ((const float*)(tab + T_ROPER_S) + (pos >> 6) * 16) : ((const float*)(tab + T_ROPEC_S) + (pos & 63) * 16);
      float cs[4], sn[4]; ld4(tc + 4 * (jj & 3), cs); ld4(ts + 4 * (jj & 3), sn);
#pragma unroll
      for (int e = 0; e < 4; ++e) { const float yo = v[e] * rr * go[e], yp = o[e] * rr * gp[e]; v[e] = ((jj & 4) == 0) ? (yo * cs[e] - yp * sn[e]) : (yo * cs[e] + yp * sn[e]); }
    }
    u32x2 wv; wv[0] = cvtpk(v[0] * scale, v[1] * scale); wv[1] = cvtpk(v[2] * scale, v[3] * scale);
    *(u32x2*)(dst + (size_t)tok * pitch + col0 + 4 * j) = wv;
  }
}

DI float gelu_tanh(float x) { const float u = x * x; const float t = x * (-2.302208198f + -0.1029432397f * u); return x * __builtin_amdgcn_rcpf(1.0f + fexp2(t)); }

constexpr float ATT_THR = 6.0f;
template <bool MASKED>
DI void flash_core(char* lds, int tid, const bf16_t* Qp, int qpitch, const bf16_t* Kp, int kpitch, const bf16_t* Vp, int vpitch,
                   int base, int dil, int L, int iq0, int kt0, int ntiles, f32x16 (&O)[2], float& m_run, float& l_run) {
  const int lane = tid & 63, w = tid >> 6, r32 = lane & 31, h = lane >> 5;
  const int iq = iq0 + 32 * w + r32;
  bf16x8 qf[4];
  { const bf16_t* qrow = Qp + (size_t)(base + dil * iq) * qpitch;
#pragma unroll
    for (int ks = 0; ks < 4; ++ks) qf[ks] = *(const bf16x8*)(qrow + 16 * ks + 8 * h); }
  const int lrow = tid >> 3, lch = tid & 7;
  const int kso = swz(lrow, lch), vso = 8192 + (lch >> 2) * 4096 + lrow * 64 + (lch & 3) * 16;
  u32x4 kreg, vreg;
#define FA_GLOAD(t) do { int ik = kt0 + 64 * (t) + lrow; ik = ik < 0 ? 0 : (ik > L - 1 ? L - 1 : ik); const size_t tok = (size_t)(base + dil * ik); \
    kreg = *(const u32x4*)(Kp + tok * kpitch + lch * 8); vreg = *(const u32x4*)(Vp + tok * vpitch + lch * 8); } while (0)
#define FA_LSTORE(b) do { *(u32x4*)(lds + (b) * 16384 + kso) = kreg; *(u32x4*)(lds + (b) * 16384 + vso) = vreg; } while (0)
  FA_GLOAD(0); FA_LSTORE(0); __syncthreads();
  O[0] = zero16(); O[1] = zero16(); m_run = 0.f; l_run = 0.f;
  f32x16 negm = zero16();
  const int iqw = iq0 + 32 * w;
  for (int t = 0; t < ntiles; ++t) {
    const bool more = (t + 1 < ntiles);
    if (more) FA_GLOAD(t + 1);
    const char* kb = lds + (t & 1) * 16384; const char* vb = kb + 8192;
    bool need = true;
    if (MASKED) { const int k_lo = kt0 + 64 * t; need = (k_lo + 63 >= iqw - 64) && (k_lo <= iqw + 31 + 64); }
    if (need) {
      f32x16 S0 = negm, S1 = negm;
#pragma unroll
      for (int ks = 0; ks < 4; ++ks) {
        const bf16x8 k0 = *(const bf16x8*)(kb + swz(r32, 2 * ks + h));
        const bf16x8 k1 = *(const bf16x8*)(kb + swz(32 + r32, 2 * ks + h));
        S0 = mfma32(k0, qf[ks], S0); S1 = mfma32(k1, qf[ks], S1);
      }
      if (MASKED) {
#pragma unroll
        for (int r = 0; r < 16; ++r) { const int ik0 = kt0 + 64 * t + crow(r, h), ik1 = ik0 + 32; const int d0 = ik0 - iq, d1 = ik1 - iq;
          const bool v0 = (ik0 >= 0) && (ik0 < L) && (d0 <= 64) && (d0 >= -64); const bool v1 = (ik1 >= 0) && (ik1 < L) && (d1 <= 64) && (d1 >= -64);
          S0[r] = v0 ? S0[r] : -1e30f; S1[r] = v1 ? S1[r] : -1e30f; }
      }
      float mx = __builtin_fmaxf(__builtin_fmaxf(S0[0], S0[1]), S1[0]);
      mx = __builtin_fmaxf(__builtin_fmaxf(mx, S1[1]), S0[2]);
#pragma unroll
      for (int r = 2; r < 16; r += 2) { mx = __builtin_fmaxf(__builtin_fmaxf(mx, S1[r]), S1[r + 1]); if (r + 2 < 16) mx = __builtin_fmaxf(__builtin_fmaxf(mx, S0[r + 1]), S0[r + 2]); else mx = __builtin_fmaxf(mx, S0[r + 1]); }
      mx = __builtin_fmaxf(mx, __shfl_xor(mx, 32));
      if (__builtin_amdgcn_ballot_w64(mx > ATT_THR) != 0ull) {
        const float dl = __builtin_fmaxf(mx, 0.f); m_run += dl; const float alpha = fexp2(-dl); l_run *= alpha;
#pragma unroll
        for (int r = 0; r < 16; ++r) { O[0][r] *= alpha; O[1][r] *= alpha; S0[r] -= dl; S1[r] -= dl; negm[r] = -m_run; }
      }
      float ps0 = 0.f, ps1 = 0.f;
#pragma unroll
      for (int r = 0; r < 16; ++r) { S0[r] = fexp2(S0[r]); S1[r] = fexp2(S1[r]); ps0 += S0[r]; ps1 += S1[r]; }
      l_run += ps0 + ps1;
#pragma unroll
      for (int s = 0; s < 4; ++s) {
        const int kvb = s >> 1, sp = s & 1;
        u32x4 pw;
        if (kvb == 0) { pw[0] = cvtpk(S0[8 * sp], S0[8 * sp + 1]); pw[1] = cvtpk(S0[8 * sp + 2], S0[8 * sp + 3]); pw[2] = cvtpk(S0[8 * sp + 4], S0[8 * sp + 5]); pw[3] = cvtpk(S0[8 * sp + 6], S0[8 * sp + 7]); }
        else          { pw[0] = cvtpk(S1[8 * sp], S1[8 * sp + 1]); pw[1] = cvtpk(S1[8 * sp + 2], S1[8 * sp + 3]); pw[2] = cvtpk(S1[8 * sp + 4], S1[8 * sp + 5]); pw[3] = cvtpk(S1[8 * sp + 6], S1[8 * sp + 7]); }
        const bf16x8 xs = __builtin_bit_cast(bf16x8, pw);
        const int rowA = 32 * kvb + 16 * sp + 4 * h;
#pragma unroll
        for (int db = 0; db < 2; ++db) { const bf16x8 vf = tr_frag(vb + db * 4096, 64, rowA, rowA + 8, 0, lane); O[db] = mfma32(vf, xs, O[db]); }
      }
    }
    if (more) FA_LSTORE((t + 1) & 1);
    __syncthreads();
  }
#undef FA_GLOAD
#undef FA_LSTORE
}

DI void flash_grid(char* lds, int tid, const bf16_t* Qp, const bf16_t* Kp, const bf16_t* Vp, int base, int iq0, int ntiles, float kbound, f32x16 (&O)[2], float& l_out) {
  const int lane = tid & 63, w = tid >> 6, r32 = lane & 31, h = lane >> 5;
  bf16x8 qf[4];
  { const bf16_t* qrow = Qp + (size_t)(base + iq0 + 32 * w + r32) * 512;
#pragma unroll
    for (int ks = 0; ks < 4; ++ks) qf[ks] = *(const bf16x8*)(qrow + 16 * ks + 8 * h); }
  float qn2 = 0.f;
#pragma unroll
  for (int ks = 0; ks < 4; ++ks)
#pragma unroll
    for (int e = 0; e < 8; ++e) { const float qv = __uint_as_float(((unsigned)(unsigned short)qf[ks][e]) << 16); qn2 += qv * qv; }
  qn2 += __shfl_xor(qn2, 32);
  const float m_row = __builtin_sqrtf(qn2) * kbound;
  const int lrow = tid >> 3, lch = tid & 7;
  const int kso = swz(lrow, lch), vso = 16384 + (lch >> 2) * 4096 + lrow * 64 + (lch & 3) * 16;
  const unsigned goff = (unsigned)(((base + lrow) * 128 + lch * 8) * 2);
#define KG(t) ((const char*)Kp + (size_t)(goff + (unsigned)(t) * (64u * 128u * 2u)))
#define VG(t) ((const char*)Vp + (size_t)(goff + (unsigned)(t) * (64u * 128u * 2u)))
  u32x4 kreg, vreg;
  int kfo[4];
#pragma unroll
  for (int ks = 0; ks < 4; ++ks) kfo[ks] = r32 * 128 + (((2 * ks + h) ^ ((r32 >> 1) & 7)) << 4);
  float l_run = 0.f;
  f32x16 negm;
#pragma unroll
  for (int r = 0; r < 16; ++r) negm[r] = -m_row;
  O[0] = zero16(); O[1] = zero16();
#define SB() __builtin_amdgcn_sched_barrier(0)
#define FG_QK(SN0, SN1, kb) do { bf16x8 kf[8]; \
    _Pragma("unroll") for (int ks = 0; ks < 4; ++ks) { kf[2 * ks] = *(const bf16x8*)((kb) + kfo[ks]); kf[2 * ks + 1] = *(const bf16x8*)((kb) + 4096 + kfo[ks]); } \
    SN0 = mfma32(kf[0], qf[0], negm); SN1 = mfma32(kf[1], qf[0], negm); \
    _Pragma("unroll") for (int ks = 1; ks < 4; ++ks) { SN0 = mfma32(kf[2 * ks], qf[ks], SN0); SN1 = mfma32(kf[2 * ks + 1], qf[ks], SN1); } } while (0)
  kreg = *(const u32x4*)KG(0); vreg = *(const u32x4*)VG(0);
  *(u32x4*)(lds + kso) = kreg; *(u32x4*)(lds + vso) = vreg;
  kreg = *(const u32x4*)KG(1);
  __syncthreads();
  f32x16 SA0, SA1, SB0, SB1;
  FG_QK(SA0, SA1, lds);
#pragma unroll
  for (int r = 0; r < 16; ++r) { SA0[r] = fexp2(SA0[r]); SA1[r] = fexp2(SA1[r]); }
  *(u32x4*)(lds + 8192 + kso) = kreg;
  __syncthreads();
#define FG_STEP(SC0, SC1, SN0, SN1, t, HASN, HASK) do { \
    const int cur_ = (t) & 1; \
    if (HASK) kreg = *(const u32x4*)KG((t) + 2); \
    if (HASN) vreg = *(const u32x4*)VG((t) + 1); \
    const char* kb_ = lds + (cur_ ^ 1) * 8192; const char* vb_ = lds + 16384 + cur_ * 8192; \
    bf16x8 kf_[8]; \
    if (HASN) { _Pragma("unroll") for (int ks = 0; ks < 2; ++ks) { kf_[2 * ks] = *(const bf16x8*)(kb_ + kfo[ks]); kf_[2 * ks + 1] = *(const bf16x8*)(kb_ + 4096 + kfo[ks]); } } \
    SB(); \
      \
    float ps_ = 0.f; u32x4 pw_[4]; \
    _Pragma("unroll") for (int g = 0; g < 8; ++g) { \
      if (HASN && g == 2) { _Pragma("unroll") for (int ks = 2; ks < 4; ++ks) { kf_[2 * ks] = *(const bf16x8*)(kb_ + kfo[ks]); kf_[2 * ks + 1] = *(const bf16x8*)(kb_ + 4096 + kfo[ks]); } } \
      if (HASN) { __builtin_amdgcn_s_setprio(1); if (g == 0) SN0 = mfma32(kf_[0], qf[0], negm); else if (g == 1) SN1 = mfma32(kf_[1], qf[0], negm); \
                  else if ((g & 1) == 0) SN0 = mfma32(kf_[g], qf[g >> 1], SN0); else SN1 = mfma32(kf_[g], qf[g >> 1], SN1); __builtin_amdgcn_s_setprio(0); } \
      if (g < 4) { ps_ += (SC0[4 * g] + SC0[4 * g + 1]) + (SC0[4 * g + 2] + SC0[4 * g + 3]); pw_[g >> 1][2 * (g & 1)] = cvtpk(SC0[4 * g], SC0[4 * g + 1]); pw_[g >> 1][2 * (g & 1) + 1] = cvtpk(SC0[4 * g + 2], SC0[4 * g + 3]); } \
      else { const int g2 = g - 4; ps_ += (SC1[4 * g2] + SC1[4 * g2 + 1]) + (SC1[4 * g2 + 2] + SC1[4 * g2 + 3]); pw_[2 + (g2 >> 1)][2 * (g2 & 1)] = cvtpk(SC1[4 * g2], SC1[4 * g2 + 1]); pw_[2 + (g2 >> 1)][2 * (g2 & 1) + 1] = cvtpk(SC1[4 * g2 + 2], SC1[4 * g2 + 3]); } \
      asm volatile("" : "+v"(ps_)); asm volatile("" : "+v"(pw_[g >> 1])); \
      SB(); } \
    l_run += ps_; \
      \
    bf16x8 vf_[8]; \
    _Pragma("unroll") for (int s = 0; s < 2; ++s) { const int rowA = 16 * s + 4 * h; \
      vf_[2 * s] = tr_frag(vb_, 64, rowA, rowA + 8, 0, lane); vf_[2 * s + 1] = tr_frag(vb_ + 4096, 64, rowA, rowA + 8, 0, lane); } \
    SB(); \
      \
    _Pragma("unroll") for (int g = 0; g < 8; ++g) { \
      if (g == 2) { _Pragma("unroll") for (int s = 2; s < 4; ++s) { const int rowA = 16 * s + 4 * h; \
        vf_[2 * s] = tr_frag(vb_, 64, rowA, rowA + 8, 0, lane); vf_[2 * s + 1] = tr_frag(vb_ + 4096, 64, rowA, rowA + 8, 0, lane); } } \
      __builtin_amdgcn_s_setprio(1); O[g & 1] = mfma32(vf_[g], __builtin_bit_cast(bf16x8, pw_[g >> 1]), O[g & 1]); __builtin_amdgcn_s_setprio(0); \
      if (HASN) { if (g < 4) { SN0[4 * g] = fexp2(SN0[4 * g]); SN0[4 * g + 1] = fexp2(SN0[4 * g + 1]); SN0[4 * g + 2] = fexp2(SN0[4 * g + 2]); SN0[4 * g + 3] = fexp2(SN0[4 * g + 3]); } \
                  else { const int g2 = g - 4; SN1[4 * g2] = fexp2(SN1[4 * g2]); SN1[4 * g2 + 1] = fexp2(SN1[4 * g2 + 1]); SN1[4 * g2 + 2] = fexp2(SN1[4 * g2 + 2]); SN1[4 * g2 + 3] = fexp2(SN1[4 * g2 + 3]); } \
                  if (g < 4) asm volatile("" : "+v"(SN0)); else asm volatile("" : "+v"(SN1)); } \
      SB(); } \
    if (HASK) *(u32x4*)(lds + cur_ * 8192 + kso) = kreg; \
    if (HASN) *(u32x4*)(lds + (cur_ ^ 1) * 8192 + vso) = vreg; \
    __syncthreads(); } while (0)
  int t = 0;
  for (; t + 3 < ntiles; t += 2) { FG_STEP(SA0, SA1, SB0, SB1, t, true, true); FG_STEP(SB0, SB1, SA0, SA1, t + 1, true, true); }
  FG_STEP(SA0, SA1, SB0, SB1, t, true, false);
  FG_STEP(SB0, SB1, SA0, SA1, t + 1, false, false);
#undef KG
#undef VG
#undef FG_STEP
#undef FG_QK
#undef SB
  l_out = l_run;
}

DI void flash_dil(char* lds, int tid, const bf16_t* Qp, const bf16_t* Kp, const bf16_t* Vp, int base, int dil, int L, int i0, f32x16 (&O)[2], float& m_out, float& l_out) {
  const int lane = tid & 63, w = tid >> 6, r32 = lane & 31, h = lane >> 5;
  const int kt0 = i0 - 64;
#pragma unroll
  for (int i = 0; i < 6; ++i) { const int c = tid + 512 * i, row = c >> 3, ch = c & 7; int ik = kt0 + row; ik = ik < 0 ? 0 : (ik > L - 1 ? L - 1 : ik);
    const size_t tok = (size_t)(base + dil * ik);
    const u32x4 kreg = *(const u32x4*)(Kp + tok * 256 + ch * 8), vreg = *(const u32x4*)(Vp + tok * 256 + ch * 8);
    *(u32x4*)(lds + swz(row, ch)) = kreg;
    *(u32x4*)(lds + 49152 + (ch >> 2) * 24576 + row * 64 + (ch & 3) * 16) = vreg; }
  const int iq = i0 + 32 * w + r32;
  bf16x8 qf[4];
  { const bf16_t* qrow = Qp + (size_t)(base + dil * iq) * 256;
#pragma unroll
    for (int ks = 0; ks < 4; ++ks) qf[ks] = *(const bf16x8*)(qrow + 16 * ks + 8 * h); }
  __syncthreads();
  O[0] = zero16(); O[1] = zero16();
  float m_run = -1e30f, l_run = 0.f;
#pragma unroll
  for (int b = 0; b < 5; ++b) {
    const int rb = 32 * w + 32 * b;
    f32x16 S = zero16();
#pragma unroll
    for (int ks = 0; ks < 4; ++ks) { const bf16x8 kf = *(const bf16x8*)(lds + swz(rb + r32, 2 * ks + h)); S = mfma32(kf, qf[ks], S); }
#pragma unroll
    for (int r = 0; r < 16; ++r) { const int ik = kt0 + rb + crow(r, h); const int d = ik - iq; const bool v = (ik >= 0) && (ik < L) && (d <= 64) && (d >= -64); S[r] = v ? S[r] : -1e30f; }
    float mx = S[0];
#pragma unroll
    for (int r = 1; r < 16; ++r) mx = __builtin_fmaxf(mx, S[r]);
    mx = __builtin_fmaxf(mx, __shfl_xor(mx, 32));
    const float m_new = __builtin_fmaxf(m_run, mx); const float alpha = fexp2(m_run - m_new); m_run = m_new;
    float ps = 0.f;
#pragma unroll
    for (int r = 0; r < 16; ++r) { S[r] = fexp2(S[r] - m_new); ps += S[r]; }
    l_run = l_run * alpha + ps;
#pragma unroll
    for (int r = 0; r < 16; ++r) { O[0][r] *= alpha; O[1][r] *= alpha; }
#pragma unroll
    for (int sp = 0; sp < 2; ++sp) {
      u32x4 pw; pw[0] = cvtpk(S[8 * sp], S[8 * sp + 1]); pw[1] = cvtpk(S[8 * sp + 2], S[8 * sp + 3]); pw[2] = cvtpk(S[8 * sp + 4], S[8 * sp + 5]); pw[3] = cvtpk(S[8 * sp + 6], S[8 * sp + 7]);
      const bf16x8 xs = __builtin_bit_cast(bf16x8, pw);
      const int rowA = rb + 16 * sp + 4 * h;
#pragma unroll
      for (int db = 0; db < 2; ++db) { const bf16x8 vf = tr_frag(lds + 49152 + db * 24576, 64, rowA, rowA + 8, 0, lane); O[db] = mfma32(vf, xs, O[db]); }
    }
  }
  m_out = m_run; l_out = l_run;
  __syncthreads();
}

struct OneUnit { long arow; int pn;
  DI bool next(int i, pg8::Unit& u) const { if (i != 0) return false; u.pm = 0; u.pn = pn; u.arow = arow; return true; }
  DI void a_ready(const pg8::Unit&) const {}
  DI void done(const pg8::Unit&) const {} };
struct EpiP1 { static constexpr bool PERM = false, AFTER_DRAIN = true;
  int tid, tok_tile0, nt; char* ws; const float* gq; const float* gk;
  template <int AI> DI void pass(char* lds, const pg8::f32x4 (&acc)[2][2][4][2], int wr, int wc, int fr, int fq) const {
    stage_t<AI>(lds, acc, wr, wc, fr, fq, 0); __syncthreads();
    int tid = this->tid; asm volatile("" : "+v"(tid));
    const int tok0 = tok_tile0 + AI * 128;
    const char* tab = ws + WS_TAB;
    bf16_t* QA = (bf16_t*)(ws + WS_QA); bf16_t* KA = (bf16_t*)(ws + WS_KA); bf16_t* VA = (bf16_t*)(ws + WS_VA);
    bf16_t* QB = (bf16_t*)(ws + WS_QB); bf16_t* KB = (bf16_t*)(ws + WS_KB); bf16_t* VB = (bf16_t*)(ws + WS_VB); bf16_t* ZC = (bf16_t*)(ws + WS_ZC);
    for (int hf = 0; hf < 2; ++hf) { const int c128 = nt * 2 + hf;
      int kind = EPI_PLAIN; bf16_t* dst = ZC; int pitch = 256, col0 = (c128 - 12) * 128; float scale = 1.0f; const float* gain = nullptr;
      if (c128 < 2) { kind = EPI_ROPEA; dst = QA; pitch = 256; col0 = c128 * 128; scale = QSCALE; }
      else if (c128 < 4) { kind = EPI_ROPEA; dst = KA; pitch = 256; col0 = (c128 - 2) * 128; }
      else if (c128 < 6) { dst = VA; pitch = 256; col0 = (c128 - 4) * 128; }
      else if (c128 < 10) { kind = EPI_NRB; dst = QB; pitch = 512; col0 = (c128 - 6) * 128; scale = QSCALE; gain = gq; }
      else if (c128 == 10) { kind = EPI_NRB; dst = KB; pitch = 128; col0 = 0; gain = gk; }
      else if (c128 == 11) { dst = VB; pitch = 128; col0 = 0; }
      epi_rows(lds, tid, kind, tok0, hf * 128, dst, pitch, col0, scale, gain, tab); }
    __syncthreads();
  }
  DI void fused(pg8::f32x4 (&acc)[2][2][4][2], const pg8::Unit&, int wr, int wc, int fr, int fq, PG8_LAS unsigned char* lds3, int, int) const {
    char* lds = (char*)lds3; pass<0>(lds, acc, wr, wc, fr, fq); pass<1>(lds, acc, wr, wc, fr, fq); }
};
struct EpiPlain { static constexpr bool PERM = false, AFTER_DRAIN = true;
  int tid, tok_tile0, col_tile0; bf16_t* dst; const char* tab;
  template <int AI> DI void pass(char* lds, const pg8::f32x4 (&acc)[2][2][4][2], int wr, int wc, int fr, int fq) const {
    stage_t<AI>(lds, acc, wr, wc, fr, fq, 0); __syncthreads();
    int tid = this->tid; asm volatile("" : "+v"(tid));
    for (int hf = 0; hf < 2; ++hf) epi_rows(lds, tid, EPI_PLAIN, tok_tile0 + AI * 128, hf * 128, dst, DM, col_tile0 + hf * 128, 1.0f, nullptr, tab);
    __syncthreads();
  }
  DI void fused(pg8::f32x4 (&acc)[2][2][4][2], const pg8::Unit&, int wr, int wc, int fr, int fq, PG8_LAS unsigned char* lds3, int, int) const {
    char* lds = (char*)lds3; pass<0>(lds, acc, wr, wc, fr, fq); pass<1>(lds, acc, wr, wc, fr, fq); }
};
struct EpiP4 { static constexpr bool PERM = false, AFTER_DRAIN = true;
  int tid, p0, nt; const float* cw; const float* cb; bf16_t* ACT;
  template <int PS> DI void pass(char* lds, const pg8::f32x4 (&acc)[2][2][4][2], int wr, int wc, int fr, int fq) const {
    float* sCw = (float*)lds;
    stage_t<PS>(lds, acc, wr, wc, fr, fq, PS);
    if (PS == 0) { if (wr == 0 && fr == 0) {
#pragma unroll
        for (int bj = 0; bj < 2; ++bj)
#pragma unroll
          for (int n = 0; n < 2; ++n) *(pg8::f32x4*)(sCw + 128 * CST + 128 * bj + 32 * wc + 16 * n + 4 * fq) = acc[1][bj][0][n]; } }
    else { if (wr == 1 && fr == 15) {
#pragma unroll
        for (int bj = 0; bj < 2; ++bj)
#pragma unroll
          for (int n = 0; n < 2; ++n) *(pg8::f32x4*)(sCw + 128 * bj + 32 * wc + 16 * n + 4 * fq) = acc[0][bj][3][n]; } }
    __syncthreads();
    const float* sC = (const float*)lds;
    int tid = this->tid; asm volatile("" : "+v"(tid));
    const int lane = tid & 63, w = tid >> 6, jj = lane & 15; const int f0 = nt * 128 + 8 * jj;
    float c0[8], c1[8], c2[8], bb[8]; ld8(cw + f0, c0); ld8(cw + DFF + f0, c1); ld8(cw + 2 * DFF + f0, c2); ld8(cb + f0, bb);
#pragma unroll 2
    for (int ps = 0; ps < 4; ++ps) {
      const int q = ps * 32 + w * 4 + (lane >> 4);
      const int i = 1 + q;
      const int tok = p0 + 127 * PS + i;
      if (q < 127 && tok < MT) {
        const int pos = (tok < MP) ? (tok & 8191) : (tok & 4095); const int S = (tok < MP) ? 8192 : 4096;
        float gm[8], gc[8], gp[8], up[8];
        ld8(sC + (i - 1) * CST + 8 * jj, gm); ld8(sC + i * CST + 8 * jj, gc); ld8(sC + (i + 1) * CST + 8 * jj, gp); ld8(sC + i * CST + 128 + 8 * jj, up);
        if (pos - 1 < 0) {
#pragma unroll
          for (int e = 0; e < 8; ++e) gm[e] = 0.f; }
        if (pos + 1 >= S) {
#pragma unroll
          for (int e = 0; e < 8; ++e) gp[e] = 0.f; }
        float o[8];
#pragma unroll
        for (int e = 0; e < 8; e += 2) {
          const f32x2 a = {gm[e], gm[e + 1]}, b = {gc[e], gc[e + 1]}, c = {gp[e], gp[e + 1]};
          const f32x2 k0 = {c0[e], c0[e + 1]}, k1 = {c1[e], c1[e + 1]}, k2 = {c2[e], c2[e + 1]}, kb = {bb[e], bb[e + 1]}, uu = {up[e], up[e + 1]};
          const f32x2 x = k0 * a + (k1 * b + (k2 * c + kb));
          const f32x2 u = x * x;
          const f32x2 t = x * (u * -0.1029432397f + -2.302208198f);
          f32x2 d; d.x = fexp2(t.x); d.y = fexp2(t.y); d = d + 1.0f;
          f32x2 r; r.x = __builtin_amdgcn_rcpf(d.x); r.y = __builtin_amdgcn_rcpf(d.y);
          const f32x2 y = (x * r) * uu;
          o[e] = y.x; o[e + 1] = y.y; }
        *(u32x4*)(ACT + (size_t)tok * DFF + f0) = pack8(o);
      }
    }
    __syncthreads();
  }
  DI void fused(pg8::f32x4 (&acc)[2][2][4][2], const pg8::Unit&, int wr, int wc, int fr, int fq, PG8_LAS unsigned char* lds3, int, int) const {
    char* lds = (char*)lds3; pass<0>(lds, acc, wr, wc, fr, fq); pass<1>(lds, acc, wr, wc, fr, fq); }
};

#define XB_TMO      128
#define XB_XCNT(j)  (256  + 64 * (j))
#define XB_XSUB(j)  (1280 + 64 * (j))
#define XB_XGEN(j)  (2304 + 64 * (j))
#define XB_TOP      3328
#define XB_TOPGEN   3392
#define XCD_BAR_WORDS 3456
#define XB_SPIN_CAP (1u << 22)

__device__ __forceinline__ unsigned xb_ld(unsigned* p)              { return __hip_atomic_load(p, __ATOMIC_RELAXED, __HIP_MEMORY_SCOPE_AGENT); }
__device__ __forceinline__ unsigned xb_add(unsigned* p, unsigned v) { return __hip_atomic_fetch_add(p, v, __ATOMIC_RELAXED, __HIP_MEMORY_SCOPE_AGENT); }
__device__ __forceinline__ unsigned xb_xcc_id() { return (unsigned)__builtin_amdgcn_s_getreg((3 << 11) | 20) & 0xFu; }
#define XB_SPIN(cond, bar) do { unsigned _sp = 0; while (cond) { __builtin_amdgcn_s_sleep(1); \
    if ((++_sp & 255u) == 0u) { if (xb_ld(&(bar)[XB_TMO])) break; if (_sp > XB_SPIN_CAP) { atomicAdd(&(bar)[XB_TMO], 1u); break; } } } } while (0)

struct XcdBarrier {
    unsigned* bar; unsigned x;
    volatile __attribute__((address_space(3))) unsigned* st;
};

__device__ __forceinline__ XcdBarrier xcd_barrier_post(unsigned* bar, volatile __attribute__((address_space(3))) unsigned* st) {
    XcdBarrier b; b.bar = bar; b.x = xb_xcc_id(); b.st = st;
    if (threadIdx.x == 0) (void)xb_add(&bar[XB_XCNT(b.x)], 1u);
    return b;
}
__device__ __forceinline__ void xcd_barrier_complete(unsigned* bar, unsigned x, unsigned& nloc, unsigned& nx) {
    const unsigned G = gridDim.x * gridDim.y * gridDim.z;
    unsigned sum, cnt, mine, sp = 0u;
    for (;;) {
        sum = 0u; cnt = 0u; mine = 0u;
#pragma unroll
        for (unsigned j = 0; j < 16; ++j) { const unsigned c = xb_ld(&bar[XB_XCNT(j)]); sum += c; cnt += (c > 0u) ? 1u : 0u; mine = (j == x) ? c : mine; }
        if (sum == G) break;
        __builtin_amdgcn_s_sleep(1);
        if ((++sp & 255u) == 0u) { if (xb_ld(&bar[XB_TMO])) break; if (sp > XB_SPIN_CAP) { atomicAdd(&bar[XB_TMO], 1u); break; } }
    }
    nloc = mine > 0u ? mine : 1u; nx = cnt > 0u ? cnt : 1u;
}

__device__ __forceinline__ void xcd_barrier(const XcdBarrier& b) {
    asm volatile("s_waitcnt vmcnt(0)" ::: "memory");
    __syncthreads();
    if (threadIdx.x == 0) {
        unsigned* bar = b.bar;
        __builtin_amdgcn_s_waitcnt(0);
        unsigned nloc = b.st[0], nx = b.st[1];
        if (nloc == 0u) { xcd_barrier_complete(bar, b.x, nloc, nx); b.st[0] = nloc; b.st[1] = nx; }
        const unsigned old = xb_add(&bar[XB_XSUB(b.x)], 1u);
        const unsigned gen = old / nloc;
        if (old + 1u == (gen + 1u) * nloc) {
            __builtin_amdgcn_fence(__ATOMIC_RELEASE, "agent");
            asm volatile("s_waitcnt vmcnt(0)" ::: "memory");
            const unsigned og = xb_add(&bar[XB_TOP], 1u);
            const unsigned tg = og / nx;
            if (og + 1u == (tg + 1u) * nx) xb_add(&bar[XB_TOPGEN], 1u);
            else XB_SPIN(xb_ld(&bar[XB_TOPGEN]) == tg, bar);
            __builtin_amdgcn_fence(__ATOMIC_ACQUIRE, "agent");
            xb_add(&bar[XB_XGEN(b.x)], 1u);
            asm volatile("s_waitcnt vmcnt(0)" ::: "memory");
        } else {
            XB_SPIN(xb_ld(&bar[XB_XGEN(b.x)]) == gen, bar);
            __builtin_amdgcn_fence(__ATOMIC_ACQUIRE, "agent");
            asm volatile("s_waitcnt vmcnt(0)" ::: "memory");
        }
    }
    __syncthreads();
}

DI bool tile_map(int round, int blk, int MTn, int NTn, int gm, int gn, int& mt, int& nt) {
  const int xcd = blk & 7, slot = blk >> 3, ngn = NTn / gn;
  const int gidx = round * 8 + xcd, mg = gidx / ngn, ng = gidx % ngn;
  mt = mg * gm + slot / gn; nt = ng * gn + slot % gn;
  return mt < MTn;
}
__global__ void __launch_bounds__(NTHREADS, 2) mega(Params p) {
  __shared__ __attribute__((aligned(16))) char lds[LDS_BYTES];
  __shared__ int s_item;
  __shared__ unsigned s_xb[2];
  const int nblk = gridDim.x, blk = blockIdx.x;
  if (threadIdx.x < 2) s_xb[threadIdx.x] = 0u;
  __syncthreads();
  const XcdBarrier xbar = xcd_barrier_post((unsigned*)(p.ws + WS_CTL) + 4096, (volatile __attribute__((address_space(3))) unsigned*)s_xb);
  for (int step = p.plo; step <= p.phi; ++step) {
  const int ph = p.seq[step];
  int tid = threadIdx.x; asm volatile("" : "+v"(tid));
  const int lane = tid & 63, w = tid >> 6, r32 = lane & 31, h = lane >> 5;
  size_t zoff = 0; asm volatile("" : "+s"(zoff));
  char* ws = p.ws + zoff;
  const char* tab = ws + WS_TAB;
  bf16_t* XN = (bf16_t*)(ws + WS_XN); bf16_t* OB = (bf16_t*)(ws + WS_O);
  bf16_t* QA = (bf16_t*)(ws + WS_QA); bf16_t* KA = (bf16_t*)(ws + WS_KA); bf16_t* VA = (bf16_t*)(ws + WS_VA);
  bf16_t* QB = (bf16_t*)(ws + WS_QB); bf16_t* KB = (bf16_t*)(ws + WS_KB); bf16_t* VB = (bf16_t*)(ws + WS_VB);
  bf16_t* ZC = (bf16_t*)(ws + WS_ZC); bf16_t* BF = (bf16_t*)(ws + WS_BF); bf16_t* PART = (bf16_t*)(ws + WS_PART); float* LSE = (float*)(ws + WS_LSE);
  bf16_t* MIX = (bf16_t*)(ws + WS_MIX); bf16_t* ACT = (bf16_t*)(ws + WS_ACT); bf16_t* FF = (bf16_t*)(ws + WS_FF); float* RS = (float*)(ws + WS_RS);
  unsigned* ctl = (unsigned*)(ws + WS_CTL);
  {
    if (ph == 0) { if (PHEN(0)) {
      const int gt = blk * NTHREADS + tid, gn = nblk * NTHREADS;
      for (int i = gt; i < 8192 * 8; i += gn) { const int pos = i >> 3, f = i & 7;
        const float inv[8] = {1.0f, 0.1939227432012558f, 0.03760603070259094f, 0.007292664609849453f, 0.0014142135623842478f, 0.00027424818836152554f, 5.3182957344688475e-05f, 1.0313385246263351e-05f};
        float iv = inv[0];
#pragma unroll
        for (int q = 1; q < 8; ++q) iv = (f == q) ? inv[q] : iv;
        const float ang = (float)pos * iv; float s, c; sincos_d((double)ang, s, c);
        ((float*)(tab + T_ROPET_C))[i] = c; ((float*)(tab + T_ROPET_S))[i] = s; }
      for (int i = gt; i < 192 * 16; i += gn) { const int pr = i >> 4, f = i & 15;
        const float inv[16] = {1.0f, 0.5623413324356079f, 0.3162277638912201f, 0.17782793939113617f, 0.10000000149011612f, 0.05623413249850273f, 0.03162277489900589f, 0.017782794311642647f,
                               0.009999999776482582f, 0.005623413249850273f, 0.003162277629598975f, 0.0017782794311642647f, 0.0010000000474974513f, 0.000562341301701963f, 0.0003162277571391314f, 0.00017782794020604342f};
        float iv = inv[0];
#pragma unroll
        for (int q = 1; q < 16; ++q) iv = (f == q) ? inv[q] : iv;
        const int pos = pr < 128 ? pr : pr - 128; const float ang = (float)pos * iv; float s, c; sincos_d((double)ang, s, c);
        if (pr < 128) { ((float*)(tab + T_ROPER_C))[pos * 16 + f] = c; ((float*)(tab + T_ROPER_S))[pos * 16 + f] = s; }
        else { ((float*)(tab + T_ROPEC_C))[pos * 16 + f] = c; ((float*)(tab + T_ROPEC_S))[pos * 16 + f] = s; } }
      for (int i = gt; i < 8192; i += gn) { float s, c; sincos_d(6.283185307179586476925286766559 * (double)i / 8192.0, s, c); ((float*)(tab + T_TW_C))[i] = c; ((float*)(tab + T_TW_S))[i] = s; }
      for (int i = gt; i < 128 * 128; i += gn) { const int a = i >> 7, b = i & 127; float s, c; sincos_d(6.283185307179586476925286766559 * (double)((a * b) & 127) / 128.0, s, c);
        ((bf16_t*)(tab + T_C128))[i] = (bf16_t)cvtpk(c, 0.f); ((bf16_t*)(tab + T_S128))[i] = (bf16_t)cvtpk(s, 0.f); }
      for (int i = gt; i < 64 * 64; i += gn) { const int a = i >> 6, b = i & 63; float s, c; sincos_d(6.283185307179586476925286766559 * (double)((a * b) & 63) / 64.0, s, c);
        ((bf16_t*)(tab + T_C64))[i] = (bf16_t)cvtpk(c, 0.f); ((bf16_t*)(tab + T_S64))[i] = (bf16_t)cvtpk(s, 0.f); }
      for (int i = gt; i < 32 * 32; i += gn) { const int a = i >> 5, b = i & 31; float s, c; sincos_d(6.283185307179586476925286766559 * (double)((a * b) & 31) / 32.0, s, c);
        ((bf16_t*)(tab + T_C32))[i] = (bf16_t)cvtpk(c, 0.f); ((bf16_t*)(tab + T_S32))[i] = (bf16_t)cvtpk(s, 0.f); }
      float* tl = (float*)lds;
      float* ctab = tl + 64 * 65;
      for (int it = blk; it < 2 * 3776; it += nblk) {
        const int l = it / 3776; int r = it % 3776;
        int mat, kt_, nt_;
        if (r < 384) { mat = 0; kt_ = r / 24; nt_ = r % 24; }
        else if (r < 640) { r -= 384; mat = 1; kt_ = r / 16; nt_ = r % 16; }
        else if (r < 1664) { r -= 640; mat = 2; kt_ = r / 64; nt_ = r % 64; }
        else if (r < 2688) { r -= 1664; mat = 3; kt_ = r / 64; nt_ = r % 64; }
        else if (r < 3712) { r -= 2688; mat = 4; kt_ = r / 16; nt_ = r % 16; }
        else { r -= 3712; mat = 5; kt_ = r / 4; nt_ = r % 4; }
        const float* src; int ld; const float* gain; bf16_t* dst; int dld;
        char* wl = ws + WS_W + (size_t)l * W_LAYER;
        int scol0 = nt_ * 64;
        if (mat == 0) { src = p.w_in + (size_t)l * DM * 1792; ld = 1792; gain = p.g_mix_pre + l * DM; dst = (bf16_t*)(wl + W_IN); dld = DM; }
        else if (mat == 1) { src = p.w_out + (size_t)l * DM * DM; ld = DM; gain = p.g_heads + l * DM; dst = (bf16_t*)(wl + W_OUT); dld = DM; }
        else if (mat == 2) { src = p.w_gate + (size_t)l * DM * DFF; ld = DFF; gain = p.g_ffn_pre + l * DM; dst = (bf16_t*)(wl + W_GU); dld = DM; }
        else if (mat == 3) { src = p.w_up + (size_t)l * DM * DFF; ld = DFF; gain = p.g_ffn_pre + l * DM; dst = (bf16_t*)(wl + W_GU); dld = DM; }
        else if (mat == 4) { src = p.w_down + (size_t)l * DFF * DM; ld = DM; gain = nullptr; dst = (bf16_t*)(wl + W_DOWN); dld = DFF; }
        else { src = p.w_in + (size_t)l * DM * 1792; ld = 1792; gain = p.g_mix_pre + l * DM; dst = (bf16_t*)(wl + W_IN); dld = DM; scol0 = 1536 + nt_ * 64; }
        const int k0 = kt_ * 64;
#pragma unroll
        for (int i = 0; i < 2; ++i) { const int kk = (tid >> 4) + 32 * i, n4 = (tid & 15) * 4; const f32x4 v = *(const f32x4*)(src + (size_t)(k0 + kk) * ld + scol0 + n4);
          tl[kk * 65 + n4] = v[0]; tl[kk * 65 + n4 + 1] = v[1]; tl[kk * 65 + n4 + 2] = v[2]; tl[kk * 65 + n4 + 3] = v[3]; }
        if (mat == 5 && tid < 64) { float s, c; sincos_d(6.283185307179586476925286766559 * (double)tid / 64.0, s, c); ctab[tid] = c; ctab[64 + tid] = s; }
        __syncthreads();
        if (mat != 5) {
          { const int nn = tid >> 3, k8 = (tid & 7) * 8;
            float v[8];
#pragma unroll
            for (int e = 0; e < 8; ++e) v[e] = tl[(k8 + e) * 65 + nn] * (gain ? gain[k0 + k8 + e] : 1.0f);
            int drow = nt_ * 64 + nn;
            if (mat == 2) drow = (nt_ >> 1) * 256 + (nt_ & 1) * 64 + nn; else if (mat == 3) drow = (nt_ >> 1) * 256 + 128 + (nt_ & 1) * 64 + nn;
            *(u32x4*)(dst + (size_t)drow * dld + k0 + k8) = pack8(v); }
        } else {
          for (int i = 0; i < 8; ++i) { const int idx = tid + 512 * i, np = idx >> 6, kk = idx & 63;
            const int ri = np > 32, cp = ri ? np - 32 : np; float a = 0.f;
            for (int c = 0; c < 64; ++c) { const int m = (c * cp) & 63; const float t = ri ? -ctab[64 + m] : ctab[m]; a += tl[kk * 65 + c] * t; }
            dst[(size_t)(1536 + nt_ * 64 + np) * dld + k0 + kk] = (bf16_t)cvtpk(a * gain[k0 + kk], 0.f); }
        }
        __syncthreads();
      }
#pragma unroll 2
      for (int row = blk * 8 + w; row < MT; row += nblk * 8) {
        const float* xr = row < MP ? p.x_prompt + (size_t)row * DM : p.x_sample + (size_t)(row - MP) * DM;
        rowpass(lane, nullptr, 0.f, xr, nullptr, nullptr, nullptr, XN + (size_t)row * DM, RS + row);
      }
    } } else {
      const int l = (ph - 1) >> 3, sub = (ph - 1) & 7;
      char* wl = ws + WS_W + (size_t)l * W_LAYER;
      if (sub == 0 && PHEN(1)) {
        const bf16_t* Bt = (const bf16_t*)(wl + W_IN);
        for (int vr = blk; vr < 256 * 9; vr += nblk) { const int rnd = vr >> 8, vb = vr & 255;
          const int li = (vb >> 3) + 32 * rnd; if (li >= 280) continue;
          const int mt = 8 * (li / 7) + (vb & 7), nt = li % 7;
          const pg8::Gemm g{XN, Bt, MT, NIN, DM};
          const OneUnit S1{(long)mt * 256, nt};
          const EpiP1 E{tid, mt * 256, nt, ws, p.g_q + l * 64, p.g_k + l * 64};
          pg8::gemm_phase<EpiP1, OneUnit, false, true>((PG8_LAS unsigned char*)lds, g, S1, E);
        }
      } else if (sub == 1 && PHEN(2)) {
        unsigned* ctr = ctl + 64 * (1 + step);
        for (;;) {
          if (tid == 0) s_item = (int)atomicAdd(ctr, 1u);
          __syncthreads();
          const int it = s_item;
          __syncthreads();
          if (it >= 8960) break;
          int tid_item = tid; asm volatile("" : "+v"(tid_item));
          { const int tid = tid_item, lane = tid & 63, w = tid >> 6, r32 = lane & 31, h = lane >> 5;
          if (it < 2560) {
            int seq, kvh, qblk, rh;
            if (it < 2048) { const int combo = it >> 7, wi = it & 127; seq = combo >> 1; kvh = combo & 1; qblk = wi >> 2; rh = wi & 3; }
            else { const int i2 = it - 2048; const int combo = i2 >> 6, wi = i2 & 63; seq = 8 + (combo >> 1); kvh = combo & 1; qblk = wi >> 2; rh = wi & 3; }
            int base, S; seq_info(seq, base, S);
            const int hq = kvh * 4 + rh;
            f32x16 O[2]; float m_run, l_run;
            float gk = __builtin_fabsf(p.g_k[l * 64 + lane]);
#pragma unroll
            for (int o = 32; o >= 1; o >>= 1) gk = __builtin_fmaxf(gk, __shfl_xor(gk, o));
            flash_grid(lds, tid, QB + hq * 64, KB + kvh * 64, VB + kvh * 64, base, qblk * 256, S >> 6, gk * 8.0f * 1.01f, O, l_run); m_run = 0.f;
            const float lt = l_run + __shfl_xor(l_run, 32); const float inv = 1.0f / lt;
            float ss = 0.f;
#pragma unroll
            for (int r = 0; r < 16; ++r) { O[0][r] *= inv; O[1][r] *= inv; ss += O[0][r] * O[0][r] + O[1][r] * O[1][r]; }
            ss += __shfl_xor(ss, 32);
            const float rr = rsqrtf(ss * (1.0f / 64.0f) + EPS);
            const int tok = base + qblk * 256 + 32 * w + r32;
            bf16_t* orow = OB + (size_t)tok * DM + 256 + hq * 64;
#pragma unroll
            for (int db = 0; db < 2; ++db)
#pragma unroll
              for (int g4 = 0; g4 < 4; ++g4) { u32x2 wv; wv[0] = cvtpk(O[db][4 * g4] * rr, O[db][4 * g4 + 1] * rr); wv[1] = cvtpk(O[db][4 * g4 + 2] * rr, O[db][4 * g4 + 3] * rr);
                *(u32x2*)(orow + 32 * db + 8 * g4 + 4 * h) = wv; }
          } else if (it < 6400) {
            const int i2 = it - 2560; const int pat = i2 / 1280; const int rem = i2 % 1280; const int head = rem & 3; const int tb = rem >> 2;
            int seq, ub; if (tb < 256) { seq = tb >> 5; ub = tb & 31; } else { seq = 8 + ((tb - 256) >> 4); ub = (tb - 256) & 15; }
            int base, S; seq_info(seq, base, S);
            const int dil = pat == 0 ? 1 : (pat == 1 ? 4 : 16); const int L = S / dil;
            const int u0 = ub * 256; const int res = u0 / L; const int i0 = u0 % L;
            f32x16 O[2]; float m_run, l_run;
            flash_dil(lds, tid, QA + head * 64, KA + head * 64, VA + head * 64, base + res, dil, L, i0, O, m_run, l_run);
            const float lt = l_run + __shfl_xor(l_run, 32); const float inv = 1.0f / lt;
            const int tok = base + res + dil * (i0 + 32 * w + r32);
            bf16_t* orow = PART + ((size_t)pat * MT + tok) * 256 + head * 64;
#pragma unroll
            for (int db = 0; db < 2; ++db)
#pragma unroll
              for (int g4 = 0; g4 < 4; ++g4) { u32x2 wv; wv[0] = cvtpk(O[db][4 * g4] * inv, O[db][4 * g4 + 1] * inv); wv[1] = cvtpk(O[db][4 * g4 + 2] * inv, O[db][4 * g4 + 3] * inv);
                *(u32x2*)(orow + 32 * db + 8 * g4 + 4 * h) = wv; }
            if (h == 0) LSE[((size_t)pat * MT + tok) * 4 + head] = m_run + __log2f(lt);
          } else {
            const int i2 = it - 6400; const int g = i2 & 3; const int mt = i2 >> 2;
            int seq, s2, S2; if (mt < 512) { seq = mt >> 6; s2 = mt & 63; S2 = 64; } else { seq = 8 + ((mt - 512) >> 5); s2 = (mt - 512) & 31; S2 = 32; }
            int base, S; seq_info(seq, base, S);
            { const int row = tid >> 2, q4 = tid & 3;
              const bf16_t* src = ZC + (size_t)(base + S2 * row + s2) * 256 + g * 64 + 16 * q4;
              const u32x4 v0 = *(const u32x4*)src, v1 = *(const u32x4*)(src + 8);
              bf16_t* trow = (bf16_t*)(lds + row * 320);
#pragma unroll
              for (int k = 0; k < 16; ++k) { const unsigned wd = (k < 8) ? v0[k >> 1] : v1[(k - 8) >> 1]; const bf16_t v = (bf16_t)((k & 1) ? (wd >> 16) : (wd & 0xffffu));
                const int j = 16 * q4 + k;
                if (j <= 32) { trow[j] = v; if (j >= 1 && j <= 31) trow[64 - j] = v; if (j == 0) trow[64] = 0; if (j == 32) trow[96] = 0; }
                else { const int cp = j - 32; trow[64 + cp] = v; trow[128 - cp] = (bf16_t)(v ^ 0x8000u); } } }
            __syncthreads();
            const int kb1 = w & 3, nb = w >> 2;
            f32x16 Ar = zero16(), Ai = zero16();
            const bf16_t* C1 = (const bf16_t*)(tab + T_C128) + (32 * kb1 + r32) * 128 + 8 * h; const bf16_t* S1t = (const bf16_t*)(tab + T_S128) + (32 * kb1 + r32) * 128 + 8 * h;
#pragma unroll
            for (int ks = 0; ks < 8; ++ks) {
              const bf16x8 aC = *(const bf16x8*)(C1 + 16 * ks), aS = *(const bf16x8*)(S1t + 16 * ks);
              const int rowA = 16 * ks + 8 * h;
              const bf16x8 zr = tr_frag(lds, 320, rowA, rowA + 4, nb * 32, lane), zi = tr_frag(lds, 320, rowA, rowA + 4, 64 + nb * 32, lane);
              const bf16x8 zrn = zr ^ (short)0x8000;
              Ar = mfma32(aC, zr, Ar); Ar = mfma32(aS, zi, Ar);
              Ai = mfma32(aC, zi, Ai); Ai = mfma32(aS, zrn, Ai);
            }
            const int twm = 8192 / S;
#pragma unroll
            for (int r = 0; r < 16; ++r) { const int k1 = 32 * kb1 + crow(r, h); const int ai = ((k1 * s2) & (S - 1)) * twm;
              const float cs = ((const float*)(tab + T_TW_C))[ai], sn = ((const float*)(tab + T_TW_S))[ai];
              bf16_t* orow = BF + (size_t)(base + k1 * S2 + s2) * 512 + g * 128;
              const float br = Ar[r] * cs + Ai[r] * sn, bi = Ai[r] * cs - Ar[r] * sn;
              orow[nb * 32 + r32] = (bf16_t)cvtpk(br, 0.f); orow[64 + nb * 32 + r32] = (bf16_t)cvtpk(bi, 0.f); }
            __syncthreads();
          }
          }
        }
      } else if (sub == 2 && PHEN(3)) {
        for (int it = blk; it < 1536 + 1280; it += nblk) {
          if (it < 1536) {
            int seq, kq, g, S2;
            if (it < 1024) { seq = it >> 7; kq = (it >> 2) & 31; g = it & 3; S2 = 64; } else { const int i2 = it - 1024; seq = 8 + (i2 >> 7); kq = (i2 >> 2) & 31; g = i2 & 3; S2 = 32; }
            int base, S; seq_info(seq, base, S);
            const int nch = 4 * S2 * 16;
            for (int c = tid; c < nch; c += 512) { const int sb = c / (S2 * 16), rc = c % (S2 * 16), row = rc >> 4, ch = rc & 15;
              *(u32x4*)(lds + sb * 20480 + row * 320 + ch * 16) = *(const u32x4*)(BF + (size_t)(base + (4 * kq + sb) * S2 + row) * 512 + g * 128 + ch * 8); }
            __syncthreads();
            const bool act = (S2 == 64) || (w < 4);
            if (act) {
              const int sb = (S2 == 64) ? (w >> 1) : w, mb = (S2 == 64) ? (w & 1) : 0;
              const char* tile = lds + sb * 20480;
              const bf16_t* Ct = (const bf16_t*)(tab + (S2 == 64 ? T_C64 : T_C32)) + (32 * mb + r32) * S2 + 8 * h;
              const bf16_t* St = (const bf16_t*)(tab + (S2 == 64 ? T_S64 : T_S32)) + (32 * mb + r32) * S2 + 8 * h;
              f32x16 Y[2]; Y[0] = zero16(); Y[1] = zero16();
              const int nks = S2 >> 4;
#pragma unroll 2
              for (int ks = 0; ks < nks; ++ks) {
                const bf16x8 aC = *(const bf16x8*)(Ct + 16 * ks), aS = *(const bf16x8*)(St + 16 * ks);
                const int rowA = 16 * ks + 8 * h;
#pragma unroll
                for (int nb = 0; nb < 2; ++nb) { const bf16x8 br = tr_frag(tile, 320, rowA, rowA + 4, nb * 32, lane), bi = tr_frag(tile, 320, rowA, rowA + 4, 64 + nb * 32, lane);
                  Y[nb] = mfma32(aC, br, Y[nb]); Y[nb] = mfma32(aS, bi, Y[nb]); }
              }
              const int k1 = 4 * kq + sb;
#pragma unroll
              for (int r = 0; r < 16; ++r) { float ss = Y[0][r] * Y[0][r] + Y[1][r] * Y[1][r];
                ss += __shfl_xor(ss, 1); ss += __shfl_xor(ss, 2); ss += __shfl_xor(ss, 4); ss += __shfl_xor(ss, 8); ss += __shfl_xor(ss, 16);
                const float rr = rsqrtf(ss * (1.0f / 64.0f) + EPS);
                const int tok = base + k1 + 128 * (32 * mb + crow(r, h));
                bf16_t* orow = OB + (size_t)tok * DM + 768 + g * 64;
                orow[r32] = (bf16_t)cvtpk(Y[0][r] * rr, 0.f); orow[32 + r32] = (bf16_t)cvtpk(Y[1][r] * rr, 0.f); }
            }
            __syncthreads();
          } else {
            const int t0 = (it - 1536) * 64;
            for (int pp = 0; pp < 4; ++pp) { const int idx = pp * 512 + tid; const int tok = t0 + (idx >> 5), head = (idx >> 3) & 3, dch = idx & 7;
              float ls[3]; u32x4 pv[3];
#pragma unroll
              for (int q = 0; q < 3; ++q) { ls[q] = LSE[((size_t)q * MT + tok) * 4 + head]; pv[q] = *(const u32x4*)(PART + ((size_t)q * MT + tok) * 256 + head * 64 + dch * 8); }
              const float mx = fmaxf(ls[0], fmaxf(ls[1], ls[2]));
              float wq[3]; float wsum = 0.f;
#pragma unroll
              for (int q = 0; q < 3; ++q) { wq[q] = fexp2(ls[q] - mx); wsum += wq[q]; }
              const float iw = 1.0f / wsum;
              float o[8];
#pragma unroll
              for (int e = 0; e < 8; ++e) o[e] = 0.f;
#pragma unroll
              for (int q = 0; q < 3; ++q) { const float ww = wq[q] * iw;
#pragma unroll
                for (int e2 = 0; e2 < 4; ++e2) { o[2 * e2] += ww * bflo(pv[q][e2]); o[2 * e2 + 1] += ww * bfhi(pv[q][e2]); } }
              float ss = 0.f;
#pragma unroll
              for (int e = 0; e < 8; ++e) ss += o[e] * o[e];
              ss += __shfl_xor(ss, 1); ss += __shfl_xor(ss, 2); ss += __shfl_xor(ss, 4);
              const float rr = rsqrtf(ss * (1.0f / 64.0f) + EPS);
#pragma unroll
              for (int e = 0; e < 8; ++e) o[e] *= rr;
              *(u32x4*)(OB + (size_t)tok * DM + head * 64 + dch * 8) = pack8(o); }
          }
        }
      } else if ((sub == 3 || sub == 6) && PHEN(4)) {
        const bf16_t* A = (sub == 3) ? OB : ACT; const int K = (sub == 3) ? DM : DFF;
        const bf16_t* Bt = (const bf16_t*)(wl + (sub == 3 ? W_OUT : W_DOWN));
        bf16_t* dst = (sub == 3) ? MIX : FF;
        for (int vr = blk; vr < 256 * 5; vr += nblk) { const int rnd = vr >> 8, vb = vr & 255;
          int mt, nt; if (!tile_map(rnd, vb, 320, 4, 8, 4, mt, nt)) continue;
          const pg8::Gemm g{A, Bt, MT, DM, K};
          const OneUnit S1{(long)mt * 256, nt};
          const EpiPlain E{tid, mt * 256, nt * 256, dst, tab};
          pg8::gemm_phase<EpiPlain, OneUnit, false, true>((PG8_LAS unsigned char*)lds, g, S1, E);
        }
      } else if ((sub == 4 || sub == 7) && PHEN(5)) {
        const bool first = (sub == 4);
        const float* gpost = (first ? p.g_mix_post : p.g_ffn_post) + l * DM;
        const bf16_t* add = first ? MIX : FF;
        const bool need_xn = !(l == 1 && sub == 7);
#pragma unroll 4
      for (int row = blk * 8 + w; row < MT; row += nblk * 8) {
          const bool last = (l == 1 && sub == 7);
          rowpass(lane, XN + (size_t)row * DM, RS[row], nullptr, add + (size_t)row * DM, gpost, last ? p.out + (size_t)row * DM : nullptr, last ? nullptr : XN + (size_t)row * DM, RS + row);
        }
      } else if (sub == 5 && PHEN(6)) {
        const bf16_t* Bt = (const bf16_t*)(wl + W_GU);
        const float* cw = p.conv_w + (size_t)l * 3 * DFF; const float* cb = p.conv_b + (size_t)l * DFF;
        for (int vr = blk; vr < 256 * 41; vr += nblk) { const int rnd = vr >> 8, vb = vr & 255;
          int mt, nt; if (!tile_map(rnd, vb, 323, 32, 4, 8, mt, nt)) continue;
          const int p0 = 254 * mt - 1;
          const pg8::Gemm g{XN, Bt, MT, 2 * DFF, DM};
          const OneUnit S1{(long)p0, nt};
          const EpiP4 E{tid, p0, nt, cw, cb, ACT};
          pg8::gemm_phase<EpiP4, OneUnit, false, true>((PG8_LAS unsigned char*)lds, g, S1, E);
        }
      }
    }
  }
    if (step < p.phi) { if (p.plo < 0) cg::this_grid().sync(); else xcd_barrier(xbar); }
  }
}

extern "C" void kernel_launch(void* const* d_in, const int* in_sizes, int n_in, void* d_out, int out_size, void* d_ws, size_t ws_size, hipStream_t stream) {
  (void)in_sizes; (void)n_in; (void)out_size; (void)ws_size;
  static int grid_blocks = 0;
  if (!grid_blocks) {
    int dev = 0, cus = 0, per_cu = 0;
    hipGetDevice(&dev);
    hipDeviceGetAttribute(&cus, hipDeviceAttributeMultiprocessorCount, dev);
    hipOccupancyMaxActiveBlocksPerMultiprocessor(&per_cu, mega, NTHREADS, 0);
    if (per_cu > 1) per_cu = 1;
    if (per_cu < 1) per_cu = 1;
    grid_blocks = cus * per_cu; if (grid_blocks > 256) grid_blocks = 256;
  }
  Params p{};
  p.x_prompt = (const float*)d_in[0]; p.x_sample = (const float*)d_in[1];
  p.g_mix_pre = (const float*)d_in[2]; p.g_mix_post = (const float*)d_in[3]; p.w_in = (const float*)d_in[4]; p.g_q = (const float*)d_in[5]; p.g_k = (const float*)d_in[6];
  p.g_heads = (const float*)d_in[7]; p.w_out = (const float*)d_in[8]; p.g_ffn_pre = (const float*)d_in[9]; p.g_ffn_post = (const float*)d_in[10];
  p.w_gate = (const float*)d_in[11]; p.w_up = (const float*)d_in[12]; p.conv_w = (const float*)d_in[13]; p.conv_b = (const float*)d_in[14]; p.w_down = (const float*)d_in[15];
  p.out = (float*)d_out; p.ws = (char*)d_ws;
  hipMemsetAsync(d_ws, 0, 65536, stream);
#if MULTI_LAUNCH
  for (int ph = 0; ph <= 16; ++ph) p.seq[ph] = ph;
  for (int ph = 0; ph <= 16; ++ph) { p.plo = ph; p.phi = ph; hipLaunchKernelGGL(mega, dim3(grid_blocks), dim3(NTHREADS), 0, stream, p); }
#else
  int ns = 0;
  for (int ph = 0; ph <= 16; ++ph) { p.seq[ns++] = ph; if (ph >= 1 && ((ph - 1) & 7) == DUPSUB) p.seq[ns++] = ph; if (ph == DUPPH) p.seq[ns++] = ph; }
  p.plo = 0; p.phi = ns - 1;
  void* args[] = {&p};
  hipError_t e = hipLaunchCooperativeKernel((void*)mega, dim3(grid_blocks), dim3(NTHREADS), args, 0, stream);
  if (e != hipSuccess) fprintf(stderr, "cooperative launch failed: %s (grid %d)\n", hipGetErrorString(e), grid_blocks);
#endif
}
```

```cpp
#include <hip/hip_runtime.h>
#include <hip/hip_cooperative_groups.h>
#include <cstdio>
#include <cstdint>
namespace cg = cooperative_groups;

#define DI __device__ __forceinline__
typedef unsigned short bf16_t;
typedef short bf16x8 __attribute__((ext_vector_type(8)));
typedef short s16x4 __attribute__((ext_vector_type(4)));
typedef float f32x16 __attribute__((ext_vector_type(16)));
typedef float f32x4 __attribute__((ext_vector_type(4)));
typedef float f32x2 __attribute__((ext_vector_type(2)));
typedef unsigned u32x4 __attribute__((ext_vector_type(4)));
typedef unsigned u32x2 __attribute__((ext_vector_type(2)));
typedef __bf16 bf16x2_t __attribute__((ext_vector_type(2)));
typedef short v4i16_t __attribute__((ext_vector_type(4)));

#ifndef USE_TR
#define USE_TR 1
#endif
#ifndef PHMASK
#define PHMASK 0x1ff
#endif
#define PHEN(b) ((PHMASK>>(b))&1)
#ifndef DUPSUB
#define DUPSUB -1
#endif
#ifndef DUPPH
#define DUPPH -1
#endif
#ifndef MULTI_LAUNCH
#define MULTI_LAUNCH 0
#endif

constexpr int DM = 1024, DFF = 4096;
constexpr int MP = 65536, MS = 16384, MT = MP + MS;
constexpr int NIN = 1792;
constexpr float EPS = 1e-6f;
constexpr float QSCALE = 0.125f * 1.4426950408889634f;
constexpr int NTHREADS = 512;
constexpr int CST = 260;
constexpr int LDS_BYTES = 129 * CST * 4;

constexpr size_t MiB = 1ull << 20;
constexpr size_t WS_CTL = 0;
constexpr size_t WS_TAB = 1 * MiB;
constexpr size_t WS_W = 4 * MiB;
constexpr size_t W_LAYER = 30 * MiB, W_IN = 0, W_OUT = 4 * MiB, W_GU = 6 * MiB, W_DOWN = 22 * MiB;
constexpr size_t WS_XN = 64 * MiB;
constexpr size_t WS_O = 224 * MiB;
constexpr size_t WS_QA = 384 * MiB, WS_KA = 424 * MiB, WS_VA = 464 * MiB, WS_QB = 504 * MiB, WS_KB = 584 * MiB, WS_VB = 604 * MiB;
constexpr size_t WS_ZC = 624 * MiB, WS_BF = 704 * MiB, WS_PART = 784 * MiB, WS_LSE = 904 * MiB;
constexpr size_t WS_MIX = 384 * MiB;
constexpr size_t WS_ACT = 224 * MiB;
constexpr size_t WS_FF = 864 * MiB;
constexpr size_t WS_RS = 3 * MiB;
constexpr size_t WS_END = 1024 * MiB;
constexpr size_t T_ROPET_C = 0, T_ROPET_S = 256 * 1024;
constexpr size_t T_ROPER_C = 512 * 1024, T_ROPER_S = T_ROPER_C + 8192;
constexpr size_t T_ROPEC_C = T_ROPER_S + 8192, T_ROPEC_S = T_ROPEC_C + 4096;
constexpr size_t T_TW_C = 640 * 1024, T_TW_S = T_TW_C + 32768;
constexpr size_t T_C128 = 768 * 1024, T_S128 = T_C128 + 32768;
constexpr size_t T_C64 = T_S128 + 32768, T_S64 = T_C64 + 8192;
constexpr size_t T_C32 = T_S64 + 8192, T_S32 = T_C32 + 2048;

struct Params {
  const float* x_prompt; const float* x_sample;
  const float* g_mix_pre; const float* g_mix_post; const float* w_in; const float* g_q; const float* g_k; const float* g_heads; const float* w_out;
  const float* g_ffn_pre; const float* g_ffn_post; const float* w_gate; const float* w_up; const float* conv_w; const float* conv_b; const float* w_down;
  float* out; char* ws;
  int plo, phi;
  int seq[30];
};

DI unsigned cvtpk(float lo, float hi) { f32x2 v = {lo, hi}; bf16x2_t b = __builtin_convertvector(v, bf16x2_t); return __builtin_bit_cast(unsigned, b); }
DI float bflo(unsigned u) { return __uint_as_float(u << 16); }
DI float bfhi(unsigned u) { return __uint_as_float(u & 0xffff0000u); }
DI int crow(int reg, int h) { return (reg & 3) + 8 * (reg >> 2) + 4 * h; }
DI f32x16 mfma32(bf16x8 a, bf16x8 b, f32x16 c) { return __builtin_amdgcn_mfma_f32_32x32x16_bf16(a, b, c, 0, 0, 0); }
DI float fexp2(float x) { return __builtin_amdgcn_exp2f(x); }
DI f32x16 zero16() { f32x16 z;
#pragma unroll
  for (int i = 0; i < 16; ++i) z[i] = 0.f; return z; }
DI int seq_of_token(int tok, int& base, int& S) { if (tok < MP) { int s = tok >> 13; base = s << 13; S = 8192; return s; } int j = (tok - MP) >> 12; base = MP + (j << 12); S = 4096; return 8 + j; }
DI void seq_info(int seq, int& base, int& S) { if (seq < 8) { base = seq << 13; S = 8192; } else { base = MP + ((seq - 8) << 12); S = 4096; } }

DI void sincos_d(double a, float& s, float& c) {
  const double TWO_PI = 6.283185307179586476925286766559;
  a -= TWO_PI * __builtin_rint(a / TWO_PI);
  const double x2 = a * a;
  double ts = 1.0, tc = 1.0, ss = 1.0, cc = 1.0;
#pragma unroll
  for (int n = 1; n <= 13; ++n) { tc *= -x2 / (double)((2 * n - 1) * (2 * n)); ts *= -x2 / (double)((2 * n) * (2 * n + 1)); cc += tc; ss += ts; }
  s = (float)(a * ss); c = (float)cc;
}

DI bf16x8 tr_frag(const char* tile, int rs, int rowA, int rowB, int n0, int lane) {
#if USE_TR
  const int i16 = lane & 15, q4 = i16 >> 2, p4 = i16 & 3, nh = (lane >> 4) & 1;
  const char* a1 = tile + (rowA + q4) * rs + (n0 + 16 * nh + 4 * p4) * 2;
  const char* a2 = tile + (rowB + q4) * rs + (n0 + 16 * nh + 4 * p4) * 2;
  v4i16_t lo = __builtin_amdgcn_ds_read_tr16_b64_v4i16((__attribute__((address_space(3))) v4i16_t*)a1);
  v4i16_t hi = __builtin_amdgcn_ds_read_tr16_b64_v4i16((__attribute__((address_space(3))) v4i16_t*)a2);
  return (bf16x8){lo[0], lo[1], lo[2], lo[3], hi[0], hi[1], hi[2], hi[3]};
#else
  const int c = n0 + (lane & 31);
  bf16x8 f;
#pragma unroll
  for (int j = 0; j < 4; ++j) { f[j] = *(const short*)(tile + (rowA + j) * rs + c * 2); f[4 + j] = *(const short*)(tile + (rowB + j) * rs + c * 2); }
  return f;
#endif
}

DI float wave_sum(float v) {
#pragma unroll
  for (int o = 32; o >= 1; o >>= 1) v += __shfl_xor(v, o);
  return v;
}

DI void rowpass(int lane, const bf16_t* xn_in_row, float s_in, const float* xin_row, const bf16_t* add_row, const float* gpost, float* xout_row, bf16_t* xn_row, float* s_out) {
  float x[16];
  if (xin_row) {
#pragma unroll
    for (int i = 0; i < 4; ++i) { const f32x4 v = *(const f32x4*)(xin_row + i * 256 + lane * 4); x[4 * i] = v[0]; x[4 * i + 1] = v[1]; x[4 * i + 2] = v[2]; x[4 * i + 3] = v[3]; }
  } else {
#pragma unroll
    for (int i = 0; i < 4; ++i) { const u32x2 v = *(const u32x2*)(xn_in_row + i * 256 + lane * 4); x[4 * i] = bflo(v[0]) * s_in; x[4 * i + 1] = bfhi(v[0]) * s_in; x[4 * i + 2] = bflo(v[1]) * s_in; x[4 * i + 3] = bfhi(v[1]) * s_in; }
  }
  if (add_row) {
    float a[16]; float ss = 0.f;
#pragma unroll
    for (int i = 0; i < 4; ++i) { const u32x2 v = *(const u32x2*)(add_row + i * 256 + lane * 4); a[4 * i] = bflo(v[0]); a[4 * i + 1] = bfhi(v[0]); a[4 * i + 2] = bflo(v[1]); a[4 * i + 3] = bfhi(v[1]); }
#pragma unroll
    for (int i = 0; i < 16; ++i) ss += a[i] * a[i];
    ss = wave_sum(ss);
    const float ra = rsqrtf(ss * (1.0f / 1024.0f) + EPS);
#pragma unroll
    for (int i = 0; i < 4; ++i) { const f32x4 g = *(const f32x4*)(gpost + i * 256 + lane * 4);
#pragma unroll
      for (int e = 0; e < 4; ++e) x[4 * i + e] += a[4 * i + e] * ra * g[e]; }
  }
  if (xout_row) {
#pragma unroll
    for (int i = 0; i < 4; ++i) *(f32x4*)(xout_row + i * 256 + lane * 4) = (f32x4){x[4 * i], x[4 * i + 1], x[4 * i + 2], x[4 * i + 3]};
  }
  if (xn_row) {
    float ss = 0.f;
#pragma unroll
    for (int i = 0; i < 16; ++i) ss += x[i] * x[i];
    ss = wave_sum(ss);
    const float ms = ss * (1.0f / 1024.0f) + EPS;
    const float rx = rsqrtf(ms);
#pragma unroll
    for (int i = 0; i < 4; ++i) { u32x2 w; w[0] = cvtpk(x[4 * i] * rx, x[4 * i + 1] * rx); w[1] = cvtpk(x[4 * i + 2] * rx, x[4 * i + 3] * rx); *(u32x2*)(xn_row + i * 256 + lane * 4) = w; }
    if (lane == 0) *s_out = __builtin_sqrtf(ms);
  }
}

namespace pg8 {
#define PG8_LAS __attribute__((address_space(3)))
typedef unsigned short bf16_t;
typedef short bf16x8 __attribute__((ext_vector_type(8)));
typedef float f32x4 __attribute__((ext_vector_type(4)));
typedef unsigned u32x4 __attribute__((ext_vector_type(4)));
constexpr int BM = 256, BK = 64, HALF = 128, HTB = HALF * BK * 2  , STAGE_BYTES = 8 * HTB, NXCD = 8, WGM = 8;

__host__ __device__ __forceinline__ int lds_byte(int r, int c) { const int st = (r >> 4) * 2 + (c >> 5), rr = r & 15, cc = c & 31, ob = rr * 64 + cc * 2; return st * 1024 + (ob ^ (((ob >> 9) & 1) << 5)); }
__host__ __device__ __forceinline__ void stage_rc(int b, int& R, int& C) { const int st = b / 1024, sb = b % 1024, swz = sb ^ (((sb >> 9) & 1) << 5); R = (st >> 1) * 16 + swz / 64; C = (st & 1) * 32 + (swz % 64) / 2; }
__host__ __device__ __forceinline__ int perm32(int rho) { const int n = rho >> 4, i = rho & 15; return 8 * (i >> 2) + 4 * n + (i & 3); }

struct Unit { int pm, pn; long arow; };
struct Gemm { const bf16_t* A; const bf16_t* Bt; int M, N, K; };
template <class Epi, class Sched, bool ALIGN_EPI = false, bool SP2 = false>
__device__ __forceinline__ void gemm_phase(PG8_LAS unsigned char* lds, const Gemm g, const Sched& S, const Epi& E) {
    int tid_ = threadIdx.x; asm volatile("" : "+v"(tid_));
    const int tid = tid_, wid = __builtin_amdgcn_readfirstlane(tid >> 6), lane = tid & 63, wr = wid >> 2, wc = wid & 3, fr = lane & 15, fq = lane >> 4;
    const int K = g.K, nt = K / BK;
    unsigned voffA[2], voffB[2];
#pragma unroll
    for (int i = 0; i < 2; ++i) { int R, C; stage_rc(tid * 16 + i * 8192, R, C); const int Rb = Epi::PERM ? ((R & ~31) + perm32(R & 31)) : R;
        voffA[i] = (unsigned)(R * K + C) * 2u; voffB[i] = (unsigned)(Rb * K + C) * 2u; }
    const size_t kstep = (size_t)(BK * 2);
    const size_t hstep = (size_t)HALF * K * 2;
    const size_t tstep = 2 * hstep;
    const unsigned ldsw = (unsigned)wid * 1024u;
    const int aoff = lds_byte(wr * 64 + fr, fq * 8), boff = lds_byte(wc * 32 + fr, fq * 8);
#define PG8_SA(b, h) (((b) * 2 + (h)) * HTB)
#define PG8_SB(b, h) ((4 + (b) * 2 + (h)) * HTB)
#define PG8_STAGE(bufoff, gbase, voff) do { _Pragma("unroll") for (int _i = 0; _i < 2; ++_i) \
        __builtin_amdgcn_global_load_lds((const unsigned*)((const char*)(gbase) + (voff)[_i]), (PG8_LAS unsigned*)(lds + (bufoff) + ldsw + _i * 8192), 16, 0, 0); } while (0)
#define PG8_LDA(dst, b, h) do { _Pragma("unroll") for (int m = 0; m < 4; ++m) _Pragma("unroll") for (int k = 0; k < 2; ++k) dst[m][k] = *(const PG8_LAS bf16x8*)(lds + PG8_SA(b, h) + aoff + m * 2048 + k * 1024); } while (0)
#define PG8_LDB(dst, b, h) do { _Pragma("unroll") for (int n = 0; n < 2; ++n) _Pragma("unroll") for (int k = 0; k < 2; ++k) dst[n][k] = *(const PG8_LAS bf16x8*)(lds + PG8_SB(b, h) + boff + n * 2048 + k * 1024); } while (0)
#define PG8_MMA(ai, bj, At, Bt) do { __builtin_amdgcn_s_setprio(1); _Pragma("unroll") for (int m = 0; m < 4; ++m) _Pragma("unroll") for (int n = 0; n < 2; ++n) _Pragma("unroll") for (int k = 0; k < 2; ++k) \
        acc[ai][bj][m][n] = __builtin_amdgcn_mfma_f32_16x16x32_bf16(Bt[n][k], At[m][k], acc[ai][bj][m][n], 0, 0, 0); __builtin_amdgcn_s_setprio(0); } while (0)
#define PG8_WAIT_V(n) asm volatile("s_waitcnt vmcnt(" #n ")" ::: "memory")
#define PG8_WAIT_L(n) asm volatile("s_waitcnt lgkmcnt(" #n ")" ::: "memory")
#define PG8_BAR __builtin_amdgcn_s_barrier()
#define PG8_SCHED __builtin_amdgcn_sched_barrier(0)
    Unit cur, nxt; int ui = 0;
    if (!S.next(0, cur)) return;
    f32x4 acc[2][2][4][2];
#pragma unroll
    for (int a = 0; a < 2; ++a)
#pragma unroll
        for (int b = 0; b < 2; ++b)
#pragma unroll
            for (int m = 0; m < 4; ++m)
#pragma unroll
                for (int n = 0; n < 2; ++n) acc[a][b][m][n] = (f32x4){0.f, 0.f, 0.f, 0.f};
    bf16x8 At[4][2], B0[2][2], B1[2][2];
    const char* cA = (const char*)g.A + cur.arow * (long)(K * 2); const char* cB = (const char*)g.Bt + (size_t)cur.pn * tstep;
    S.a_ready(cur);
    if constexpr (SP2) {
        PG8_STAGE(PG8_SB(0, 0), cB, voffB); PG8_STAGE(PG8_SB(0, 1), cB + hstep, voffB); PG8_STAGE(PG8_SA(0, 0), cA, voffA); PG8_STAGE(PG8_SA(0, 1), cA + hstep, voffA);
        if (wr == 1) PG8_BAR;
        PG8_WAIT_V(2); PG8_BAR;
        PG8_STAGE(PG8_SB(1, 0), cB + kstep, voffB); PG8_STAGE(PG8_SA(1, 0), cA + kstep, voffA); PG8_STAGE(PG8_SB(1, 1), cB + hstep + kstep, voffB);
        PG8_WAIT_V(6); PG8_BAR;
    } else {
        PG8_STAGE(PG8_SB(0, 0), cB, voffB); PG8_STAGE(PG8_SA(0, 0), cA, voffA); PG8_STAGE(PG8_SB(0, 1), cB + hstep, voffB); PG8_STAGE(PG8_SA(0, 1), cA + hstep, voffA);
        if (wr == 1) PG8_BAR;
        PG8_WAIT_V(4); PG8_BAR;
        PG8_STAGE(PG8_SB(1, 0), cB + kstep, voffB); PG8_STAGE(PG8_SA(1, 0), cA + kstep, voffA); PG8_STAGE(PG8_SB(1, 1), cB + hstep + kstep, voffB);
        PG8_WAIT_V(6); PG8_BAR;
    }
    for (;;) {
        const bool has_next = S.next(ui + 1, nxt);
        const char* nA = has_next ? (const char*)g.A + nxt.arow * (long)(K * 2) : cA; const char* nB = has_next ? (const char*)g.Bt + (size_t)nxt.pn * tstep : cB;
        for (int t = 0; t < nt; t += 2) {
            const bool last = (t == nt - 2);
            const char* a1 = cA + (size_t)(t + 1) * kstep;
            const char* a2 = last ? nA : cA + (size_t)(t + 2) * kstep; const char* b2 = last ? nB : cB + (size_t)(t + 2) * kstep;
            const char* a3 = a2 + kstep; const char* b3 = b2 + kstep;
            if (last && has_next) S.a_ready(nxt);
            if constexpr (SP2) {
            PG8_LDB(B0, 0, 0); PG8_LDB(B1, 0, 1); PG8_SCHED; PG8_LDA(At, 0, 0); PG8_STAGE(PG8_SA(1, 1), a1 + hstep, voffA);
            PG8_WAIT_V(8); PG8_WAIT_L(0); PG8_BAR; PG8_MMA(0, 0, At, B0); PG8_MMA(0, 1, At, B1); PG8_BAR; PG8_SCHED;
            PG8_LDA(At, 0, 1); PG8_STAGE(PG8_SB(0, 0), b2, voffB); PG8_STAGE(PG8_SB(0, 1), b2 + hstep, voffB); PG8_STAGE(PG8_SA(0, 0), a2, voffA);
            PG8_WAIT_V(8); PG8_WAIT_L(0); PG8_BAR; PG8_MMA(1, 0, At, B0); PG8_MMA(1, 1, At, B1); PG8_BAR; PG8_SCHED;
            PG8_LDB(B0, 1, 0); PG8_LDB(B1, 1, 1); PG8_SCHED; PG8_LDA(At, 1, 0); PG8_STAGE(PG8_SA(0, 1), a2 + hstep, voffA);
            PG8_WAIT_V(8); PG8_WAIT_L(0); PG8_BAR; PG8_MMA(0, 0, At, B0); PG8_MMA(0, 1, At, B1); PG8_BAR; PG8_SCHED;
            PG8_LDA(At, 1, 1); PG8_STAGE(PG8_SB(1, 0), b3, voffB); PG8_STAGE(PG8_SB(1, 1), b3 + hstep, voffB); PG8_STAGE(PG8_SA(1, 0), a3, voffA);
            PG8_WAIT_V(8); PG8_WAIT_L(0); PG8_BAR; PG8_MMA(1, 0, At, B0); PG8_MMA(1, 1, At, B1); PG8_BAR; PG8_SCHED;
            } else {
            PG8_LDB(B0, 0, 0); PG8_SCHED; PG8_LDA(At, 0, 0); PG8_STAGE(PG8_SA(1, 1), a1 + hstep, voffA);
            PG8_WAIT_L(8); PG8_BAR; PG8_WAIT_L(0); PG8_MMA(0, 0, At, B0); PG8_BAR; PG8_SCHED;
            PG8_LDB(B1, 0, 1); PG8_STAGE(PG8_SB(0, 0), b2, voffB);
            PG8_BAR; PG8_WAIT_L(0); PG8_MMA(0, 1, At, B1); PG8_BAR;
            PG8_LDA(At, 0, 1); PG8_STAGE(PG8_SA(0, 0), a2, voffA);
            PG8_BAR; PG8_WAIT_L(0); PG8_MMA(1, 0, At, B0); PG8_BAR; PG8_SCHED;
            PG8_STAGE(PG8_SB(0, 1), b2 + hstep, voffB);
            PG8_WAIT_V(6); PG8_BAR; PG8_MMA(1, 1, At, B1); PG8_BAR;
            PG8_LDB(B0, 1, 0); PG8_SCHED; PG8_LDA(At, 1, 0); PG8_STAGE(PG8_SA(0, 1), a2 + hstep, voffA);
            PG8_WAIT_L(8); PG8_BAR; PG8_WAIT_L(0); PG8_MMA(0, 0, At, B0); PG8_BAR; PG8_SCHED;
            PG8_LDB(B1, 1, 1); PG8_STAGE(PG8_SB(1, 0), b3, voffB);
            PG8_BAR; PG8_WAIT_L(0); PG8_MMA(0, 1, At, B1); PG8_BAR;
            PG8_LDA(At, 1, 1); PG8_STAGE(PG8_SA(1, 0), a3, voffA);
            PG8_BAR; PG8_WAIT_L(0); PG8_MMA(1, 0, At, B0); PG8_BAR; PG8_SCHED;
            PG8_STAGE(PG8_SB(1, 1), b3 + hstep, voffB);
            PG8_WAIT_V(6); PG8_BAR; PG8_MMA(1, 1, At, B1); PG8_BAR;
            }
        }
        if constexpr (ALIGN_EPI) { if (wr == 0) PG8_BAR; }
        if constexpr (!Epi::AFTER_DRAIN) { E(acc, cur, wr, wc, fr, fq); S.done(cur); }
        if (!has_next) break;
#pragma unroll
        for (int a = 0; a < 2; ++a)
#pragma unroll
            for (int b = 0; b < 2; ++b)
#pragma unroll
                for (int m = 0; m < 4; ++m)
#pragma unroll
                    for (int n = 0; n < 2; ++n) acc[a][b][m][n] = (f32x4){0.f, 0.f, 0.f, 0.f};
        cur = nxt; cA = nA; cB = nB; ++ui;
        if constexpr (ALIGN_EPI) { if (wr == 1) PG8_BAR; }
    }
    PG8_WAIT_V(0);
    if constexpr (!ALIGN_EPI) { if (wr == 0) PG8_BAR; }
    PG8_BAR;
    if constexpr (Epi::AFTER_DRAIN) { E.fused(acc, cur, wr, wc, fr, fq, lds, wid, lane); S.done(cur); }
#undef PG8_SA
#undef PG8_SB
#undef PG8_STAGE
#undef PG8_LDA
#undef PG8_LDB
#undef PG8_MMA
#undef PG8_WAIT_V
#undef PG8_WAIT_L
#undef PG8_BAR
#undef PG8_SCHED
}
}

DI int swz(int row, int ch) { return row * 128 + ((ch ^ ((row >> 1) & 7)) << 4); }
template <int AI> DI void stage_t(char* lds, const pg8::f32x4 (&acc)[2][2][4][2], int wr, int wc, int fr, int fq, int shift) {
  float* sC = (float*)lds;
#pragma unroll
  for (int bj = 0; bj < 2; ++bj)
#pragma unroll
    for (int m = 0; m < 4; ++m)
#pragma unroll
      for (int n = 0; n < 2; ++n) *(pg8::f32x4*)(sC + (64 * wr + 16 * m + fr + shift) * CST + 128 * bj + 32 * wc + 16 * n + 4 * fq) = acc[AI][bj][m][n];
}
DI void ld8(const float* p, float (&v)[8]) { const f32x4 a = *(const f32x4*)p, b = *(const f32x4*)(p + 4); v[0] = a[0]; v[1] = a[1]; v[2] = a[2]; v[3] = a[3]; v[4] = b[0]; v[5] = b[1]; v[6] = b[2]; v[7] = b[3]; }
DI u32x4 pack8(const float (&v)[8]) { u32x4 w; w[0] = cvtpk(v[0], v[1]); w[1] = cvtpk(v[2], v[3]); w[2] = cvtpk(v[4], v[5]); w[3] = cvtpk(v[6], v[7]); return w; }

enum { EPI_PLAIN = 0, EPI_ROPEA = 1, EPI_NRB = 2 };
DI void ld4(const float* p, float (&v)[4]) { const f32x4 a = *(const f32x4*)p; v[0] = a[0]; v[1] = a[1]; v[2] = a[2]; v[3] = a[3]; }
DI void epi_rows(char* lds, int tid, int kind, int tok0, int sc0, bf16_t* dst, int pitch, int col0, float scale, const float* gain, const char* tab) {
  const float* sC = (const float*)lds + sc0;
  const int lane = tid & 63, w = tid >> 6, j = lane & 31, jj = j & 15;
#pragma unroll 2
  for (int pass = 0; pass < 8; ++pass) {
    const int row = pass * 16 + w * 2 + (lane >> 5);
    const int tok = tok0 + row;
    float v[4]; ld4(sC + row * CST + 4 * j, v);
    if (kind == EPI_ROPEA) {
      if (jj < 4) {
        const int pos = (tok < MP) ? (tok & 8191) : (tok & 4095);
        float o[4]; ld4(sC + row * CST + 4 * (j ^ 2), o);
        float cs[4], sn[4]; ld4((const float*)(tab + T_ROPET_C) + pos * 8 + 4 * (jj & 1), cs); ld4((const float*)(tab + T_ROPET_S) + pos * 8 + 4 * (jj & 1), sn);
#pragma unroll
        for (int e = 0; e < 4; ++e) v[e] = (jj < 2) ? (v[e] * cs[e] - o[e] * sn[e]) : (v[e] * cs[e] + o[e] * sn[e]);
      }
    } else if (kind == EPI_NRB) {
      float ss = v[0] * v[0] + v[1] * v[1] + v[2] * v[2] + v[3] * v[3];
      ss += __shfl_xor(ss, 1); ss += __shfl_xor(ss, 2); ss += __shfl_xor(ss, 4); ss += __shfl_xor(ss, 8);
      const float rr = rsqrtf(ss * (1.0f / 64.0f) + EPS);
      float o[4]; ld4(sC + row * CST + 4 * (j ^ 4), o);
      float go[4], gp[4]; ld4(gain + 4 * jj, go); ld4(gain + 4 * (jj ^ 4), gp);
      const int pos = (tok < MP) ? (tok & 8191) : (tok & 4095);
      const float* tc = (jj < 8) ? ((const float*)(tab + T_ROPER_C) + (pos >> 6) * 16) : ((const float*)(tab + T_ROPEC_C) + (pos & 63) * 16);
      const float* ts = (jj < 8) ? ((const float*)(tab + T_ROPER_S) + (pos >> 6) * 16) : ((const float*)(tab + T_ROPEC_S) + (pos & 63) * 16);
      float cs[4], sn[4]; ld4(tc + 4 * (jj & 3), cs); ld4(ts + 4 * (jj & 3), sn);
#pragma unroll
      for (int e = 0; e < 4; ++e) { const float yo = v[e] * rr * go[e], yp = o[e] * rr * gp[e]; v[e] = ((jj & 4) == 0) ? (yo * cs[e] - yp * sn[e]) : (yo * cs[e] + yp * sn[e]); }
    }
    u32x2 wv; wv[0] = cvtpk(v[0] * scale, v[1] * scale); wv[1] = cvtpk(v[2] * scale, v[3] * scale);
    *(u32x2*)(dst + (size_t)tok * pitch + col0 + 4 * j) = wv;
  }
}

DI float gelu_tanh(float x) { const float u = x * x; const float t = x * (-2.302208198f + -0.1029432397f * u); return x * __builtin_amdgcn_rcpf(1.0f + fexp2(t)); }

constexpr float ATT_THR = 6.0f;
template <bool MASKED>
DI void flash_core(char* lds, int tid, const bf16_t* Qp, int qpitch, const bf16_t* Kp, int kpitch, const bf16_t* Vp, int vpitch,
                   int base, int dil, int L, int iq0, int kt0, int ntiles, f32x16 (&O)[2], float& m_run, float& l_run) {
  const int lane = tid & 63, w = tid >> 6, r32 = lane & 31, h = lane >> 5;
  const int iq = iq0 + 32 * w + r32;
  bf16x8 qf[4];
  { const bf16_t* qrow = Qp + (size_t)(base + dil * iq) * qpitch;
#pragma unroll
    for (int ks = 0; ks < 4; ++ks) qf[ks] = *(const bf16x8*)(qrow + 16 * ks + 8 * h); }
  const int lrow = tid >> 3, lch = tid & 7;
  const int kso = swz(lrow, lch), vso = 8192 + (lch >> 2) * 4096 + lrow * 64 + (lch & 3) * 16;
  u32x4 kreg, vreg;
#define FA_GLOAD(t) do { int ik = kt0 + 64 * (t) + lrow; ik = ik < 0 ? 0 : (ik > L - 1 ? L - 1 : ik); const size_t tok = (size_t)(base + dil * ik); \
    kreg = *(const u32x4*)(Kp + tok * kpitch + lch * 8); vreg = *(const u32x4*)(Vp + tok * vpitch + lch * 8); } while (0)
#define FA_LSTORE(b) do { *(u32x4*)(lds + (b) * 16384 + kso) = kreg; *(u32x4*)(lds + (b) * 16384 + vso) = vreg; } while (0)
  FA_GLOAD(0); FA_LSTORE(0); __syncthreads();
  O[0] = zero16(); O[1] = zero16(); m_run = 0.f; l_run = 0.f;
  f32x16 negm = zero16();
  const int iqw = iq0 + 32 * w;
  for (int t = 0; t < ntiles; ++t) {
    const bool more = (t + 1 < ntiles);
    if (more) FA_GLOAD(t + 1);
    const char* kb = lds + (t & 1) * 16384; const char* vb = kb + 8192;
    bool need = true;
    if (MASKED) { const int k_lo = kt0 + 64 * t; need = (k_lo + 63 >= iqw - 64) && (k_lo <= iqw + 31 + 64); }
    if (need) {
      f32x16 S0 = negm, S1 = negm;
#pragma unroll
      for (int ks = 0; ks < 4; ++ks) {
        const bf16x8 k0 = *(const bf16x8*)(kb + swz(r32, 2 * ks + h));
        const bf16x8 k1 = *(const bf16x8*)(kb + swz(32 + r32, 2 * ks + h));
        S0 = mfma32(k0, qf[ks], S0); S1 = mfma32(k1, qf[ks], S1);
      }
      if (MASKED) {
#pragma unroll
        for (int r = 0; r < 16; ++r) { const int ik0 = kt0 + 64 * t + crow(r, h), ik1 = ik0 + 32; const int d0 = ik0 - iq, d1 = ik1 - iq;
          const bool v0 = (ik0 >= 0) && (ik0 < L) && (d0 <= 64) && (d0 >= -64); const bool v1 = (ik1 >= 0) && (ik1 < L) && (d1 <= 64) && (d1 >= -64);
          S0[r] = v0 ? S0[r] : -1e30f; S1[r] = v1 ? S1[r] : -1e30f; }
      }
      float mx = __builtin_fmaxf(__builtin_fmaxf(S0[0], S0[1]), S1[0]);
      mx = __builtin_fmaxf(__builtin_fmaxf(mx, S1[1]), S0[2]);
#pragma unroll
      for (int r = 2; r < 16; r += 2) { mx = __builtin_fmaxf(__builtin_fmaxf(mx, S1[r]), S1[r + 1]); if (r + 2 < 16) mx = __builtin_fmaxf(__builtin_fmaxf(mx, S0[r + 1]), S0[r + 2]); else mx = __builtin_fmaxf(mx, S0[r + 1]); }
      mx = __builtin_fmaxf(mx, __shfl_xor(mx, 32));
      if (__builtin_amdgcn_ballot_w64(mx > ATT_THR) != 0ull) {
        const float dl = __builtin_fmaxf(mx, 0.f); m_run += dl; const float alpha = fexp2(-dl); l_run *= alpha;
#pragma unroll
        for (int r = 0; r < 16; ++r) { O[0][r] *= alpha; O[1][r] *= alpha; S0[r] -= dl; S1[r] -= dl; negm[r] = -m_run; }
      }
      float ps0 = 0.f, ps1 = 0.f;
#pragma unroll
      for (int r = 0; r < 16; ++r) { S0[r] = fexp2(S0[r]); S1[r] = fexp2(S1[r]); ps0 += S0[r]; ps1 += S1[r]; }
      l_run += ps0 + ps1;
#pragma unroll
      for (int s = 0; s < 4; ++s) {
        const int kvb = s >> 1, sp = s & 1;
        u32x4 pw;
        if (kvb == 0) { pw[0] = cvtpk(S0[8 * sp], S0[8 * sp + 1]); pw[1] = cvtpk(S0[8 * sp + 2], S0[8 * sp + 3]); pw[2] = cvtpk(S0[8 * sp + 4], S0[8 * sp + 5]); pw[3] = cvtpk(S0[8 * sp + 6], S0[8 * sp + 7]); }
        else          { pw[0] = cvtpk(S1[8 * sp], S1[8 * sp + 1]); pw[1] = cvtpk(S1[8 * sp + 2], S1[8 * sp + 3]); pw[2] = cvtpk(S1[8 * sp + 4], S1[8 * sp + 5]); pw[3] = cvtpk(S1[8 * sp + 6], S1[8 * sp + 7]); }
        const bf16x8 xs = __builtin_bit_cast(bf16x8, pw);
        const int rowA = 32 * kvb + 16 * sp + 4 * h;
#pragma unroll
        for (int db = 0; db < 2; ++db) { const bf16x8 vf = tr_frag(vb + db * 4096, 64, rowA, rowA + 8, 0, lane); O[db] = mfma32(vf, xs, O[db]); }
      }
    }
    if (more) FA_LSTORE((t + 1) & 1);
    __syncthreads();
  }
#undef FA_GLOAD
#undef FA_LSTORE
}

DI void flash_grid(char* lds, int tid, const bf16_t* Qp, const bf16_t* Kp, const bf16_t* Vp, int base, int iq0, int ntiles, float kbound, f32x16 (&O)[2], float& l_out) {
  const int lane = tid & 63, w = tid >> 6, r32 = lane & 31, h = lane >> 5;
  bf16x8 qf[4];
  { const bf16_t* qrow = Qp + (size_t)(base + iq0 + 32 * w + r32) * 512;
#pragma unroll
    for (int ks = 0; ks < 4; ++ks) qf[ks] = *(const bf16x8*)(qrow + 16 * ks + 8 * h); }
  float qn2 = 0.f;
#pragma unroll
  for (int ks = 0; ks < 4; ++ks)
#pragma unroll
    for (int e = 0; e < 8; ++e) { const float qv = __uint_as_float(((unsigned)(unsigned short)qf[ks][e]) << 16); qn2 += qv * qv; }
  qn2 += __shfl_xor(qn2, 32);
  const float m_row = __builtin_sqrtf(qn2) * kbound;
  const int lrow = tid >> 3, lch = tid & 7;
  const int kso = swz(lrow, lch), vso = 16384 + (lch >> 2) * 4096 + lrow * 64 + (lch & 3) * 16;
  const unsigned goff = (unsigned)(((base + lrow) * 128 + lch * 8) * 2);
#define KG(t) ((const char*)Kp + (size_t)(goff + (unsigned)(t) * (64u * 128u * 2u)))
#define VG(t) ((const char*)Vp + (size_t)(goff + (unsigned)(t) * (64u * 128u * 2u)))
  u32x4 kreg, vreg;
  int kfo[4];
#pragma unroll
  for (int ks = 0; ks < 4; ++ks) kfo[ks] = r32 * 128 + (((2 * ks + h) ^ ((r32 >> 1) & 7)) << 4);
  float l_run = 0.f;
  f32x16 negm;
#pragma unroll
  for (int r = 0; r < 16; ++r) negm[r] = -m_row;
  O[0] = zero16(); O[1] = zero16();
#define SB() __builtin_amdgcn_sched_barrier(0)
#define FG_QK(SN0, SN1, kb) do { bf16x8 kf[8]; \
    _Pragma("unroll") for (int ks = 0; ks < 4; ++ks) { kf[2 * ks] = *(const bf16x8*)((kb) + kfo[ks]); kf[2 * ks + 1] = *(const bf16x8*)((kb) + 4096 + kfo[ks]); } \
    SN0 = mfma32(kf[0], qf[0], negm); SN1 = mfma32(kf[1], qf[0], negm); \
    _Pragma("unroll") for (int ks = 1; ks < 4; ++ks) { SN0 = mfma32(kf[2 * ks], qf[ks], SN0); SN1 = mfma32(kf[2 * ks + 1], qf[ks], SN1); } } while (0)
  kreg = *(const u32x4*)KG(0); vreg = *(const u32x4*)VG(0);
  *(u32x4*)(lds + kso) = kreg; *(u32x4*)(lds + vso) = vreg;
  kreg = *(const u32x4*)KG(1);
  __syncthreads();
  f32x16 SA0, SA1, SB0, SB1;
  FG_QK(SA0, SA1, lds);
#pragma unroll
  for (int r = 0; r < 16; ++r) { SA0[r] = fexp2(SA0[r]); SA1[r] = fexp2(SA1[r]); }
  *(u32x4*)(lds + 8192 + kso) = kreg;
  __syncthreads();
#define FG_STEP(SC0, SC1, SN0, SN1, t, HASN, HASK) do { \
    const int cur_ = (t) & 1; \
    if (HASK) kreg = *(const u32x4*)KG((t) + 2); \
    if (HASN) vreg = *(const u32x4*)VG((t) + 1); \
    const char* kb_ = lds + (cur_ ^ 1) * 8192; const char* vb_ = lds + 16384 + cur_ * 8192; \
    bf16x8 kf_[8]; \
    if (HASN) { _Pragma("unroll") for (int ks = 0; ks < 2; ++ks) { kf_[2 * ks] = *(const bf16x8*)(kb_ + kfo[ks]); kf_[2 * ks + 1] = *(const bf16x8*)(kb_ + 4096 + kfo[ks]); } } \
    SB(); \
      \
    float ps_ = 0.f; u32x4 pw_[4]; \
    _Pragma("unroll") for (int g = 0; g < 8; ++g) { \
      if (HASN && g == 2) { _Pragma("unroll") for (int ks = 2; ks < 4; ++ks) { kf_[2 * ks] = *(const bf16x8*)(kb_ + kfo[ks]); kf_[2 * ks + 1] = *(const bf16x8*)(kb_ + 4096 + kfo[ks]); } } \
      if (HASN) { __builtin_amdgcn_s_setprio(1); if (g == 0) SN0 = mfma32(kf_[0], qf[0], negm); else if (g == 1) SN1 = mfma32(kf_[1], qf[0], negm); \
                  else if ((g & 1) == 0) SN0 = mfma32(kf_[g], qf[g >> 1], SN0); else SN1 = mfma32(kf_[g], qf[g >> 1], SN1); __builtin_amdgcn_s_setprio(0); } \
      if (g < 4) { ps_ += (SC0[4 * g] + SC0[4 * g + 1]) + (SC0[4 * g + 2] + SC0[4 * g + 3]); pw_[g >> 1][2 * (g & 1)] = cvtpk(SC0[4 * g], SC0[4 * g + 1]); pw_[g >> 1][2 * (g & 1) + 1] = cvtpk(SC0[4 * g + 2], SC0[4 * g + 3]); } \
      else { const int g2 = g - 4; ps_ += (SC1[4 * g2] + SC1[4 * g2 + 1]) + (SC1[4 * g2 + 2] + SC1[4 * g2 + 3]); pw_[2 + (g2 >> 1)][2 * (g2 & 1)] = cvtpk(SC1[4 * g2], SC1[4 * g2 + 1]); pw_[2 + (g2 >> 1)][2 * (g2 & 1) + 1] = cvtpk(SC1[4 * g2 + 2], SC1[4 * g2 + 3]); } \
      asm volatile("" : "+v"(ps_)); asm volatile("" : "+v"(pw_[g >> 1])); \
      SB(); } \
    l_run += ps_; \
      \
    bf16x8 vf_[8]; \
    _Pragma("unroll") for (int s = 0; s < 2; ++s) { const int rowA = 16 * s + 4 * h; \
      vf_[2 * s] = tr_frag(vb_, 64, rowA, rowA + 8, 0, lane); vf_[2 * s + 1] = tr_frag(vb_ + 4096, 64, rowA, rowA + 8, 0, lane); } \
    SB(); \
      \
    _Pragma("unroll") for (int g = 0; g < 8; ++g) { \
      if (g == 2) { _Pragma("unroll") for (int s = 2; s < 4; ++s) { const int rowA = 16 * s + 4 * h; \
        vf_[2 * s] = tr_frag(vb_, 64, rowA, rowA + 8, 0, lane); vf_[2 * s + 1] = tr_frag(vb_ + 4096, 64, rowA, rowA + 8, 0, lane); } } \
      __builtin_amdgcn_s_setprio(1); O[g & 1] = mfma32(vf_[g], __builtin_bit_cast(bf16x8, pw_[g >> 1]), O[g & 1]); __builtin_amdgcn_s_setprio(0); \
      if (HASN) { if (g < 4) { SN0[4 * g] = fexp2(SN0[4 * g]); SN0[4 * g + 1] = fexp2(SN0[4 * g + 1]); SN0[4 * g + 2] = fexp2(SN0[4 * g + 2]); SN0[4 * g + 3] = fexp2(SN0[4 * g + 3]); } \
                  else { const int g2 = g - 4; SN1[4 * g2] = fexp2(SN1[4 * g2]); SN1[4 * g2 + 1] = fexp2(SN1[4 * g2 + 1]); SN1[4 * g2 + 2] = fexp2(SN1[4 * g2 + 2]); SN1[4 * g2 + 3] = fexp2(SN1[4 * g2 + 3]); } \
                  if (g < 4) asm volatile("" : "+v"(SN0)); else asm volatile("" : "+v"(SN1)); } \
      SB(); } \
    if (HASK) *(u32x4*)(lds + cur_ * 8192 + kso) = kreg; \
    if (HASN) *(u32x4*)(lds + (cur_ ^ 1) * 8192 + vso) = vreg; \
    __syncthreads(); } while (0)
  int t = 0;
  for (; t + 3 < ntiles; t += 2) { FG_STEP(SA0, SA1, SB0, SB1, t, true, true); FG_STEP(SB0, SB1, SA0, SA1, t + 1, true, true); }
  FG_STEP(SA0, SA1, SB0, SB1, t, true, false);
  FG_STEP(SB0, SB1, SA0, SA1, t + 1, false, false);
#undef KG
#undef VG
#undef FG_STEP
#undef FG_QK
#undef SB
  l_out = l_run;
}

DI void flash_dil(char* lds, int tid, const bf16_t* Qp, const bf16_t* Kp, const bf16_t* Vp, int base, int dil, int L, int i0, f32x16 (&O)[2], float& m_out, float& l_out) {
  const int lane = tid & 63, w = tid >> 6, r32 = lane & 31, h = lane >> 5;
  const int kt0 = i0 - 64;
#pragma unroll
  for (int i = 0; i < 6; ++i) { const int c = tid + 512 * i, row = c >> 3, ch = c & 7; int ik = kt0 + row; ik = ik < 0 ? 0 : (ik > L - 1 ? L - 1 : ik);
    const size_t tok = (size_t)(base + dil * ik);
    const u32x4 kreg = *(const u32x4*)(Kp + tok * 256 + ch * 8), vreg = *(const u32x4*)(Vp + tok * 256 + ch * 8);
    *(u32x4*)(lds + swz(row, ch)) = kreg;
    *(u32x4*)(lds + 49152 + (ch >> 2) * 24576 + row * 64 + (ch & 3) * 16) = vreg; }
  const int iq = i0 + 32 * w + r32;
  bf16x8 qf[4];
  { const bf16_t* qrow = Qp + (size_t)(base + dil * iq) * 256;
#pragma unroll
    for (int ks = 0; ks < 4; ++ks) qf[ks] = *(const bf16x8*)(qrow + 16 * ks + 8 * h); }
  __syncthreads();
  O[0] = zero16(); O[1] = zero16();
  float m_run = -1e30f, l_run = 0.f;
#pragma unroll
  for (int b = 0; b < 5; ++b) {
    const int rb = 32 * w + 32 * b;
    f32x16 S = zero16();
#pragma unroll
    for (int ks = 0; ks < 4; ++ks) { const bf16x8 kf = *(const bf16x8*)(lds + swz(rb + r32, 2 * ks + h)); S = mfma32(kf, qf[ks], S); }
#pragma unroll
    for (int r = 0; r < 16; ++r) { const int ik = kt0 + rb + crow(r, h); const int d = ik - iq; const bool v = (ik >= 0) && (ik < L) && (d <= 64) && (d >= -64); S[r] = v ? S[r] : -1e30f; }
    float mx = S[0];
#pragma unroll
    for (int r = 1; r < 16; ++r) mx = __builtin_fmaxf(mx, S[r]);
    mx = __builtin_fmaxf(mx, __shfl_xor(mx, 32));
    const float m_new = __builtin_fmaxf(m_run, mx); const float alpha = fexp2(m_run - m_new); m_run = m_new;
    float ps = 0.f;
#pragma unroll
    for (int r = 0; r < 16; ++r) { S[r] = fexp2(S[r] - m_new); ps += S[r]; }
    l_run = l_run * alpha + ps;
#pragma unroll
    for (int r = 0; r < 16; ++r) { O[0][r] *= alpha; O[1][r] *= alpha; }
#pragma unroll
    for (int sp = 0; sp < 2; ++sp) {
      u32x4 pw; pw[0] = cvtpk(S[8 * sp], S[8 * sp + 1]); pw[1] = cvtpk(S[8 * sp + 2], S[8 * sp + 3]); pw[2] = cvtpk(S[8 * sp + 4], S[8 * sp + 5]); pw[3] = cvtpk(S[8 * sp + 6], S[8 * sp + 7]);
      const bf16x8 xs = __builtin_bit_cast(bf16x8, pw);
      const int rowA = rb + 16 * sp + 4 * h;
#pragma unroll
      for (int db = 0; db < 2; ++db) { const bf16x8 vf = tr_frag(lds + 49152 + db * 24576, 64, rowA, rowA + 8, 0, lane); O[db] = mfma32(vf, xs, O[db]); }
    }
  }
  m_out = m_run; l_out = l_run;
  __syncthreads();
}

struct OneUnit { long arow; int pn;
  DI bool next(int i, pg8::Unit& u) const { if (i != 0) return false; u.pm = 0; u.pn = pn; u.arow = arow; return true; }
  DI void a_ready(const pg8::Unit&) const {}
  DI void done(const pg8::Unit&) const {} };
struct EpiP1 { static constexpr bool PERM = false, AFTER_DRAIN = true;
  int tid, tok_tile0, nt; char* ws; const float* gq; const float* gk;
  template <int AI> DI void pass(char* lds, const pg8::f32x4 (&acc)[2][2][4][2], int wr, int wc, int fr, int fq) const {
    stage_t<AI>(lds, acc, wr, wc, fr, fq, 0); __syncthreads();
    int tid = this->tid; asm volatile("" : "+v"(tid));
    const int tok0 = tok_tile0 + AI * 128;
    const char* tab = ws + WS_TAB;
    bf16_t* QA = (bf16_t*)(ws + WS_QA); bf16_t* KA = (bf16_t*)(ws + WS_KA); bf16_t* VA = (bf16_t*)(ws + WS_VA);
    bf16_t* QB = (bf16_t*)(ws + WS_QB); bf16_t* KB = (bf16_t*)(ws + WS_KB); bf16_t* VB = (bf16_t*)(ws + WS_VB); bf16_t* ZC = (bf16_t*)(ws + WS_ZC);
    for (int hf = 0; hf < 2; ++hf) { const int c128 = nt * 2 + hf;
      int kind = EPI_PLAIN; bf16_t* dst = ZC; int pitch = 256, col0 = (c128 - 12) * 128; float scale = 1.0f; const float* gain = nullptr;
      if (c128 < 2) { kind = EPI_ROPEA; dst = QA; pitch = 256; col0 = c128 * 128; scale = QSCALE; }
      else if (c128 < 4) { kind = EPI_ROPEA; dst = KA; pitch = 256; col0 = (c128 - 2) * 128; }
      else if (c128 < 6) { dst = VA; pitch = 256; col0 = (c128 - 4) * 128; }
      else if (c128 < 10) { kind = EPI_NRB; dst = QB; pitch = 512; col0 = (c128 - 6) * 128; scale = QSCALE; gain = gq; }
      else if (c128 == 10) { kind = EPI_NRB; dst = KB; pitch = 128; col0 = 0; gain = gk; }
      else if (c128 == 11) { dst = VB; pitch = 128; col0 = 0; }
      epi_rows(lds, tid, kind, tok0, hf * 128, dst, pitch, col0, scale, gain, tab); }
    __syncthreads();
  }
  DI void fused(pg8::f32x4 (&acc)[2][2][4][2], const pg8::Unit&, int wr, int wc, int fr, int fq, PG8_LAS unsigned char* lds3, int, int) const {
    char* lds = (char*)lds3; pass<0>(lds, acc, wr, wc, fr, fq); pass<1>(lds, acc, wr, wc, fr, fq); }
};
struct EpiPlain { static constexpr bool PERM = false, AFTER_DRAIN = true;
  int tid, tok_tile0, col_tile0; bf16_t* dst; const char* tab;
  template <int AI> DI void pass(char* lds, const pg8::f32x4 (&acc)[2][2][4][2], int wr, int wc, int fr, int fq) const {
    stage_t<AI>(lds, acc, wr, wc, fr, fq, 0); __syncthreads();
    int tid = this->tid; asm volatile("" : "+v"(tid));
    for (int hf = 0; hf < 2; ++hf) epi_rows(lds, tid, EPI_PLAIN, tok_tile0 + AI * 128, hf * 128, dst, DM, col_tile0 + hf * 128, 1.0f, nullptr, tab);
    __syncthreads();
  }
  DI void fused(pg8::f32x4 (&acc)[2][2][4][2], const pg8::Unit&, int wr, int wc, int fr, int fq, PG8_LAS unsigned char* lds3, int, int) const {
    char* lds = (char*)lds3; pass<0>(lds, acc, wr, wc, fr, fq); pass<1>(lds, acc, wr, wc, fr, fq); }
};
struct EpiP4 { static constexpr bool PERM = false, AFTER_DRAIN = true;
  int tid, p0, nt; const float* cw; const float* cb; bf16_t* ACT;
  template <int PS> DI void pass(char* lds, const pg8::f32x4 (&acc)[2][2][4][2], int wr, int wc, int fr, int fq) const {
    float* sCw = (float*)lds;
    stage_t<PS>(lds, acc, wr, wc, fr, fq, PS);
    if (PS == 0) { if (wr == 0 && fr == 0) {
#pragma unroll
        for (int bj = 0; bj < 2; ++bj)
#pragma unroll
          for (int n = 0; n < 2; ++n) *(pg8::f32x4*)(sCw + 128 * CST + 128 * bj + 32 * wc + 16 * n + 4 * fq) = acc[1][bj][0][n]; } }
    else { if (wr == 1 && fr == 15) {
#pragma unroll
        for (int bj = 0; bj < 2; ++bj)
#pragma unroll
          for (int n = 0; n < 2; ++n) *(pg8::f32x4*)(sCw + 128 * bj + 32 * wc + 16 * n + 4 * fq) = acc[0][bj][3][n]; } }
    __syncthreads();
    const float* sC = (const float*)lds;
    int tid = this->tid; asm volatile("" : "+v"(tid));
    const int lane = tid & 63, w = tid >> 6, jj = lane & 15; const int f0 = nt * 128 + 8 * jj;
    float c0[8], c1[8], c2[8], bb[8]; ld8(cw + f0, c0); ld8(cw + DFF + f0, c1); ld8(cw + 2 * DFF + f0, c2); ld8(cb + f0, bb);
#pragma unroll 2
    for (int ps = 0; ps < 4; ++ps) {
      const int q = ps * 32 + w * 4 + (lane >> 4);
      const int i = 1 + q;
      const int tok = p0 + 127 * PS + i;
      if (q < 127 && tok < MT) {
        const int pos = (tok < MP) ? (tok & 8191) : (tok & 4095); const int S = (tok < MP) ? 8192 : 4096;
        float gm[8], gc[8], gp[8], up[8];
        ld8(sC + (i - 1) * CST + 8 * jj, gm); ld8(sC + i * CST + 8 * jj, gc); ld8(sC + (i + 1) * CST + 8 * jj, gp); ld8(sC + i * CST + 128 + 8 * jj, up);
        if (pos - 1 < 0) {
#pragma unroll
          for (int e = 0; e < 8; ++e) gm[e] = 0.f; }
        if (pos + 1 >= S) {
#pragma unroll
          for (int e = 0; e < 8; ++e) gp[e] = 0.f; }
        float o[8];
#pragma unroll
        for (int e = 0; e < 8; e += 2) {
          const f32x2 a = {gm[e], gm[e + 1]}, b = {gc[e], gc[e + 1]}, c = {gp[e], gp[e + 1]};
          const f32x2 k0 = {c0[e], c0[e + 1]}, k1 = {c1[e], c1[e + 1]}, k2 = {c2[e], c2[e + 1]}, kb = {bb[e], bb[e + 1]}, uu = {up[e], up[e + 1]};
          const f32x2 x = k0 * a + (k1 * b + (k2 * c + kb));
          const f32x2 u = x * x;
          const f32x2 t = x * (u * -0.1029432397f + -2.302208198f);
          f32x2 d; d.x = fexp2(t.x); d.y = fexp2(t.y); d = d + 1.0f;
          f32x2 r; r.x = __builtin_amdgcn_rcpf(d.x); r.y = __builtin_amdgcn_rcpf(d.y);
          const f32x2 y = (x * r) * uu;
          o[e] = y.x; o[e + 1] = y.y; }
        *(u32x4*)(ACT + (size_t)tok * DFF + f0) = pack8(o);
      }
    }
    __syncthreads();
  }
  DI void fused(pg8::f32x4 (&acc)[2][2][4][2], const pg8::Unit&, int wr, int wc, int fr, int fq, PG8_LAS unsigned char* lds3, int, int) const {
    char* lds = (char*)lds3; pass<0>(lds, acc, wr, wc, fr, fq); pass<1>(lds, acc, wr, wc, fr, fq); }
};

#define XB_TMO      128
#define XB_XCNT(j)  (256  + 64 * (j))
#define XB_XSUB(j)  (1280 + 64 * (j))
#define XB_XGEN(j)  (2304 + 64 * (j))
#define XB_TOP      3328
#define XB_TOPGEN   3392
#define XCD_BAR_WORDS 3456
#define XB_SPIN_CAP (1u << 22)

__device__ __forceinline__ unsigned xb_ld(unsigned* p)              { return __hip_atomic_load(p, __ATOMIC_RELAXED, __HIP_MEMORY_SCOPE_AGENT); }
__device__ __forceinline__ unsigned xb_add(unsigned* p, unsigned v) { return __hip_atomic_fetch_add(p, v, __ATOMIC_RELAXED, __HIP_MEMORY_SCOPE_AGENT); }
__device__ __forceinline__ unsigned xb_xcc_id() { return (unsigned)__builtin_amdgcn_s_getreg((3 << 11) | 20) & 0xFu; }
#define XB_SPIN(cond, bar) do { unsigned _sp = 0; while (cond) { __builtin_amdgcn_s_sleep(1); \
    if ((++_sp & 255u) == 0u) { if (xb_ld(&(bar)[XB_TMO])) break; if (_sp > XB_SPIN_CAP) { atomicAdd(&(bar)[XB_TMO], 1u); break; } } } } while (0)

struct XcdBarrier {
    unsigned* bar; unsigned x;
    volatile __attribute__((address_space(3))) unsigned* st;
};

__device__ __forceinline__ XcdBarrier xcd_barrier_post(unsigned* bar, volatile __attribute__((address_space(3))) unsigned* st) {
    XcdBarrier b; b.bar = bar; b.x = xb_xcc_id(); b.st = st;
    if (threadIdx.x == 0) (void)xb_add(&bar[XB_XCNT(b.x)], 1u);
    return b;
}
__device__ __forceinline__ void xcd_barrier_complete(unsigned* bar, unsigned x, unsigned& nloc, unsigned& nx) {
    const unsigned G = gridDim.x * gridDim.y * gridDim.z;
    unsigned sum, cnt, mine, sp = 0u;
    for (;;) {
        sum = 0u; cnt = 0u; mine = 0u;
#pragma unroll
        for (unsigned j = 0; j < 16; ++j) { const unsigned c = xb_ld(&bar[XB_XCNT(j)]); sum += c; cnt += (c > 0u) ? 1u : 0u; mine = (j == x) ? c : mine; }
        if (sum == G) break;
        __builtin_amdgcn_s_sleep(1);
        if ((++sp & 255u) == 0u) { if (xb_ld(&bar[XB_TMO])) break; if (sp > XB_SPIN_CAP) { atomicAdd(&bar[XB_TMO], 1u); break; } }
    }
    nloc = mine > 0u ? mine : 1u; nx = cnt > 0u ? cnt : 1u;
}

__device__ __forceinline__ void xcd_barrier(const XcdBarrier& b) {
    asm volatile("s_waitcnt vmcnt(0)" ::: "memory");
    __syncthreads();
    if (threadIdx.x == 0) {
        unsigned* bar = b.bar;
        __builtin_amdgcn_s_waitcnt(0);
        unsigned nloc = b.st[0], nx = b.st[1];
        if (nloc == 0u) { xcd_barrier_complete(bar, b.x, nloc, nx); b.st[0] = nloc; b.st[1] = nx; }
        const unsigned old = xb_add(&bar[XB_XSUB(b.x)], 1u);
        const unsigned gen = old / nloc;
        if (old + 1u == (gen + 1u) * nloc) {
            __builtin_amdgcn_fence(__ATOMIC_RELEASE, "agent");
            asm volatile("s_waitcnt vmcnt(0)" ::: "memory");
            const unsigned og = xb_add(&bar[XB_TOP], 1u);
            const unsigned tg = og / nx;
            if (og + 1u == (tg + 1u) * nx) xb_add(&bar[XB_TOPGEN], 1u);
            else XB_SPIN(xb_ld(&bar[XB_TOPGEN]) == tg, bar);
            __builtin_amdgcn_fence(__ATOMIC_ACQUIRE, "agent");
            xb_add(&bar[XB_XGEN(b.x)], 1u);
            asm volatile("s_waitcnt vmcnt(0)" ::: "memory");
        } else {
            XB_SPIN(xb_ld(&bar[XB_XGEN(b.x)]) == gen, bar);
            __builtin_amdgcn_fence(__ATOMIC_ACQUIRE, "agent");
            asm volatile("s_waitcnt vmcnt(0)" ::: "memory");
        }
    }
    __syncthreads();
}

DI bool tile_map(int round, int blk, int MTn, int NTn, int gm, int gn, int& mt, int& nt) {
  const int xcd = blk & 7, slot = blk >> 3, ngn = NTn / gn;
  const int gidx = round * 8 + xcd, mg = gidx / ngn, ng = gidx % ngn;
  mt = mg * gm + slot / gn; nt = ng * gn + slot % gn;
  return mt < MTn;
}
__global__ void __launch_bounds__(NTHREADS, 2) mega(Params p) {
  __shared__ __attribute__((aligned(16))) char lds[LDS_BYTES];
  __shared__ int s_item;
  __shared__ unsigned s_xb[2];
  const int nblk = gridDim.x, blk = blockIdx.x;
  if (threadIdx.x < 2) s_xb[threadIdx.x] = 0u;
  __syncthreads();
  const XcdBarrier xbar = xcd_barrier_post((unsigned*)(p.ws + WS_CTL) + 4096, (volatile __attribute__((address_space(3))) unsigned*)s_xb);
  for (int step = p.plo; step <= p.phi; ++step) {
  const int ph = p.seq[step];
  int tid = threadIdx.x; asm volatile("" : "+v"(tid));
  const int lane = tid & 63, w = tid >> 6, r32 = lane & 31, h = lane >> 5;
  size_t zoff = 0; asm volatile("" : "+s"(zoff));
  char* ws = p.ws + zoff;
  const char* tab = ws + WS_TAB;
  bf16_t* XN = (bf16_t*)(ws + WS_XN); bf16_t* OB = (bf16_t*)(ws + WS_O);
  bf16_t* QA = (bf16_t*)(ws + WS_QA); bf16_t* KA = (bf16_t*)(ws + WS_KA); bf16_t* VA = (bf16_t*)(ws + WS_VA);
  bf16_t* QB = (bf16_t*)(ws + WS_QB); bf16_t* KB = (bf16_t*)(ws + WS_KB); bf16_t* VB = (bf16_t*)(ws + WS_VB);
  bf16_t* ZC = (bf16_t*)(ws + WS_ZC); bf16_t* BF = (bf16_t*)(ws + WS_BF); bf16_t* PART = (bf16_t*)(ws + WS_PART); float* LSE = (float*)(ws + WS_LSE);
  bf16_t* MIX = (bf16_t*)(ws + WS_MIX); bf16_t* ACT = (bf16_t*)(ws + WS_ACT); bf16_t* FF = (bf16_t*)(ws + WS_FF); float* RS = (float*)(ws + WS_RS);
  unsigned* ctl = (unsigned*)(ws + WS_CTL);
  {
    if (ph == 0) { if (PHEN(0)) {
      const int gt = blk * NTHREADS + tid, gn = nblk * NTHREADS;
      for (int i = gt; i < 8192 * 8; i += gn) { const int pos = i >> 3, f = i & 7;
        const float inv[8] = {1.0f, 0.1939227432012558f, 0.03760603070259094f, 0.007292664609849453f, 0.0014142135623842478f, 0.00027424818836152554f, 5.3182957344688475e-05f, 1.0313385246263351e-05f};
        float iv = inv[0];
#pragma unroll
        for (int q = 1; q < 8; ++q) iv = (f == q) ? inv[q] : iv;
        const float ang = (float)pos * iv; float s, c; sincos_d((double)ang, s, c);
        ((float*)(tab + T_ROPET_C))[i] = c; ((float*)(tab + T_ROPET_S))[i] = s; }
      for (int i = gt; i < 192 * 16; i += gn) { const int pr = i >> 4, f = i & 15;
        const float inv[16] = {1.0f, 0.5623413324356079f, 0.3162277638912201f, 0.17782793939113617f, 0.10000000149011612f, 0.05623413249850273f, 0.03162277489900589f, 0.017782794311642647f,
                               0.009999999776482582f, 0.005623413249850273f, 0.003162277629598975f, 0.0017782794311642647f, 0.0010000000474974513f, 0.000562341301701963f, 0.0003162277571391314f, 0.00017782794020604342f};
        float iv = inv[0];
#pragma unroll
        for (int q = 1; q < 16; ++q) iv = (f == q) ? inv[q] : iv;
        const int pos = pr < 128 ? pr : pr - 128; const float ang = (float)pos * iv; float s, c; sincos_d((double)ang, s, c);
        if (pr < 128) { ((float*)(tab + T_ROPER_C))[pos * 16 + f] = c; ((float*)(tab + T_ROPER_S))[pos * 16 + f] = s; }
        else { ((float*)(tab + T_ROPEC_C))[pos * 16 + f] = c; ((float*)(tab + T_ROPEC_S))[pos * 16 + f] = s; } }
      for (int i = gt; i < 8192; i += gn) { float s, c; sincos_d(6.283185307179586476925286766559 * (double)i / 8192.0, s, c); ((float*)(tab + T_TW_C))[i] = c; ((float*)(tab + T_TW_S))[i] = s; }
      for (int i = gt; i < 128 * 128; i += gn) { const int a = i >> 7, b = i & 127; float s, c; sincos_d(6.283185307179586476925286766559 * (double)((a * b) & 127) / 128.0, s, c);
        ((bf16_t*)(tab + T_C128))[i] = (bf16_t)cvtpk(c, 0.f); ((bf16_t*)(tab + T_S128))[i] = (bf16_t)cvtpk(s, 0.f); }
      for (int i = gt; i < 64 * 64; i += gn) { const int a = i >> 6, b = i & 63; float s, c; sincos_d(6.283185307179586476925286766559 * (double)((a * b) & 63) / 64.0, s, c);
        ((bf16_t*)(tab + T_C64))[i] = (bf16_t)cvtpk(c, 0.f); ((bf16_t*)(tab + T_S64))[i] = (bf16_t)cvtpk(s, 0.f); }
      for (int i = gt; i < 32 * 32; i += gn) { const int a = i >> 5, b = i & 31; float s, c; sincos_d(6.283185307179586476925286766559 * (double)((a * b) & 31) / 32.0, s, c);
        ((bf16_t*)(tab + T_C32))[i] = (bf16_t)cvtpk(c, 0.f); ((bf16_t*)(tab + T_S32))[i] = (bf16_t)cvtpk(s, 0.f); }
      float* tl = (float*)lds;
      float* ctab = tl + 64 * 65;
      for (int it = blk; it < 2 * 3776; it += nblk) {
        const int l = it / 3776; int r = it % 3776;
        int mat, kt_, nt_;
        if (r < 384) { mat = 0; kt_ = r / 24; nt_ = r % 24; }
        else if (r < 640) { r -= 384; mat = 1; kt_ = r / 16; nt_ = r % 16; }
        else if (r < 1664) { r -= 640; mat = 2; kt_ = r / 64; nt_ = r % 64; }
        else if (r < 2688) { r -= 1664; mat = 3; kt_ = r / 64; nt_ = r % 64; }
        else if (r < 3712) { r -= 2688; mat = 4; kt_ = r / 16; nt_ = r % 16; }
        else { r -= 3712; mat = 5; kt_ = r / 4; nt_ = r % 4; }
        const float* src; int ld; const float* gain; bf16_t* dst; int dld;
        char* wl = ws + WS_W + (size_t)l * W_LAYER;
        int scol0 = nt_ * 64;
        if (mat == 0) { src = p.w_in + (size_t)l * DM * 1792; ld = 1792; gain = p.g_mix_pre + l * DM; dst = (bf16_t*)(wl + W_IN); dld = DM; }
        else if (mat == 1) { src = p.w_out + (size_t)l * DM * DM; ld = DM; gain = p.g_heads + l * DM; dst = (bf16_t*)(wl + W_OUT); dld = DM; }
        else if (mat == 2) { src = p.w_gate + (size_t)l * DM * DFF; ld = DFF; gain = p.g_ffn_pre + l * DM; dst = (bf16_t*)(wl + W_GU); dld = DM; }
        else if (mat == 3) { src = p.w_up + (size_t)l * DM * DFF; ld = DFF; gain = p.g_ffn_pre + l * DM; dst = (bf16_t*)(wl + W_GU); dld = DM; }
        else if (mat == 4) { src = p.w_down + (size_t)l * DFF * DM; ld = DM; gain = nullptr; dst = (bf16_t*)(wl + W_DOWN); dld = DFF; }
        else { src = p.w_in + (size_t)l * DM * 1792; ld = 1792; gain = p.g_mix_pre + l * DM; dst = (bf16_t*)(wl + W_IN); dld = DM; scol0 = 1536 + nt_ * 64; }
        const int k0 = kt_ * 64;
#pragma unroll
        for (int i = 0; i < 2; ++i) { const int kk = (tid >> 4) + 32 * i, n4 = (tid & 15) * 4; const f32x4 v = *(const f32x4*)(src + (size_t)(k0 + kk) * ld + scol0 + n4);
          tl[kk * 65 + n4] = v[0]; tl[kk * 65 + n4 + 1] = v[1]; tl[kk * 65 + n4 + 2] = v[2]; tl[kk * 65 + n4 + 3] = v[3]; }
        if (mat == 5 && tid < 64) { float s, c; sincos_d(6.283185307179586476925286766559 * (double)tid / 64.0, s, c); ctab[tid] = c; ctab[64 + tid] = s; }
        __syncthreads();
        if (mat != 5) {
          { const int nn = tid >> 3, k8 = (tid & 7) * 8;
            float v[8];
#pragma unroll
            for (int e = 0; e < 8; ++e) v[e] = tl[(k8 + e) * 65 + nn] * (gain ? gain[k0 + k8 + e] : 1.0f);
            int drow = nt_ * 64 + nn;
            if (mat == 2) drow = (nt_ >> 1) * 256 + (nt_ & 1) * 64 + nn; else if (mat == 3) drow = (nt_ >> 1) * 256 + 128 + (nt_ & 1) * 64 + nn;
            *(u32x4*)(dst + (size_t)drow * dld + k0 + k8) = pack8(v); }
        } else {
          for (int i = 0; i < 8; ++i) { const int idx = tid + 512 * i, np = idx >> 6, kk = idx & 63;
            const int ri = np > 32, cp = ri ? np - 32 : np; float a = 0.f;
            for (int c = 0; c < 64; ++c) { const int m = (c * cp) & 63; const float t = ri ? -ctab[64 + m] : ctab[m]; a += tl[kk * 65 + c] * t; }
            dst[(size_t)(1536 + nt_ * 64 + np) * dld + k0 + kk] = (bf16_t)cvtpk(a * gain[k0 + kk], 0.f); }
        }
        __syncthreads();
      }
#pragma unroll 2
      for (int row = blk * 8 + w; row < MT; row += nblk * 8) {
        const float* xr = row < MP ? p.x_prompt + (size_t)row * DM : p.x_sample + (size_t)(row - MP) * DM;
        rowpass(lane, nullptr, 0.f, xr, nullptr, nullptr, nullptr, XN + (size_t)row * DM, RS + row);
      }
    } } else {
      const int l = (ph - 1) >> 3, sub = (ph - 1) & 7;
      char* wl = ws + WS_W + (size_t)l * W_LAYER;
      if (sub == 0 && PHEN(1)) {
        const bf16_t* Bt = (const bf16_t*)(wl + W_IN);
        for (int vr = blk; vr < 256 * 9; vr += nblk) { const int rnd = vr >> 8, vb = vr & 255;
          const int li = (vb >> 3) + 32 * rnd; if (li >= 280) continue;
          const int mt = 8 * (li / 7) + (vb & 7), nt = li % 7;
          const pg8::Gemm g{XN, Bt, MT, NIN, DM};
          const OneUnit S1{(long)mt * 256, nt};
          const EpiP1 E{tid, mt * 256, nt, ws, p.g_q + l * 64, p.g_k + l * 64};
          pg8::gemm_phase<EpiP1, OneUnit, false, true>((PG8_LAS unsigned char*)lds, g, S1, E);
        }
      } else if (sub == 1 && PHEN(2)) {
        unsigned* ctr = ctl + 64 * (1 + step);
        for (;;) {
          if (tid == 0) s_item = (int)atomicAdd(ctr, 1u);
          __syncthreads();
          const int it = s_item;
          __syncthreads();
          if (it >= 8960) break;
          int tid_item = tid; asm volatile("" : "+v"(tid_item));
          { const int tid = tid_item, lane = tid & 63, w = tid >> 6, r32 = lane & 31, h = lane >> 5;
          if (it < 2560) {
            int seq, kvh, qblk, rh;
            if (it < 2048) { const int combo = it >> 7, wi = it & 127; seq = combo >> 1; kvh = combo & 1; qblk = wi >> 2; rh = wi & 3; }
            else { const int i2 = it - 2048; const int combo = i2 >> 6, wi = i2 & 63; seq = 8 + (combo >> 1); kvh = combo & 1; qblk = wi >> 2; rh = wi & 3; }
            int base, S; seq_info(seq, base, S);
            const int hq = kvh * 4 + rh;
            f32x16 O[2]; float m_run, l_run;
            float gk = __builtin_fabsf(p.g_k[l * 64 + lane]);
#pragma unroll
            for (int o = 32; o >= 1; o >>= 1) gk = __builtin_fmaxf(gk, __shfl_xor(gk, o));
            flash_grid(lds, tid, QB + hq * 64, KB + kvh * 64, VB + kvh * 64, base, qblk * 256, S >> 6, gk * 8.0f * 1.01f, O, l_run); m_run = 0.f;
            const float lt = l_run + __shfl_xor(l_run, 32); const float inv = 1.0f / lt;
            float ss = 0.f;
#pragma unroll
            for (int r = 0; r < 16; ++r) { O[0][r] *= inv; O[1][r] *= inv; ss += O[0][r] * O[0][r] + O[1][r] * O[1][r]; }
            ss += __shfl_xor(ss, 32);
            const float rr = rsqrtf(ss * (1.0f / 64.0f) + EPS);
            const int tok = base + qblk * 256 + 32 * w + r32;
            bf16_t* orow = OB + (size_t)tok * DM + 256 + hq * 64;
#pragma unroll
            for (int db = 0; db < 2; ++db)
#pragma unroll
              for (int g4 = 0; g4 < 4; ++g4) { u32x2 wv; wv[0] = cvtpk(O[db][4 * g4] * rr, O[db][4 * g4 + 1] * rr); wv[1] = cvtpk(O[db][4 * g4 + 2] * rr, O[db][4 * g4 + 3] * rr);
                *(u32x2*)(orow + 32 * db + 8 * g4 + 4 * h) = wv; }
          } else if (it < 6400) {
            const int i2 = it - 2560; const int pat = i2 / 1280; const int rem = i2 % 1280; const int head = rem & 3; const int tb = rem >> 2;
            int seq, ub; if (tb < 256) { seq = tb >> 5; ub = tb & 31; } else { seq = 8 + ((tb - 256) >> 4); ub = (tb - 256) & 15; }
            int base, S; seq_info(seq, base, S);
            const int dil = pat == 0 ? 1 : (pat == 1 ? 4 : 16); const int L = S / dil;
            const int u0 = ub * 256; const int res = u0 / L; const int i0 = u0 % L;
            f32x16 O[2]; float m_run, l_run;
            flash_dil(lds, tid, QA + head * 64, KA + head * 64, VA + head * 64, base + res, dil, L, i0, O, m_run, l_run);
            const float lt = l_run + __shfl_xor(l_run, 32); const float inv = 1.0f / lt;
            const int tok = base + res + dil * (i0 + 32 * w + r32);
            bf16_t* orow = PART + ((size_t)pat * MT + tok) * 256 + head * 64;
#pragma unroll
            for (int db = 0; db < 2; ++db)
#pragma unroll
              for (int g4 = 0; g4 < 4; ++g4) { u32x2 wv; wv[0] = cvtpk(O[db][4 * g4] * inv, O[db][4 * g4 + 1] * inv); wv[1] = cvtpk(O[db][4 * g4 + 2] * inv, O[db][4 * g4 + 3] * inv);
                *(u32x2*)(orow + 32 * db + 8 * g4 + 4 * h) = wv; }
            if (h == 0) LSE[((size_t)pat * MT + tok) * 4 + head] = m_run + __log2f(lt);
          } else {
            const int i2 = it - 6400; const int g = i2 & 3; const int mt = i2 >> 2;
            int seq, s2, S2; if (mt < 512) { seq = mt >> 6; s2 = mt & 63; S2 = 64; } else { seq = 8 + ((mt - 512) >> 5); s2 = (mt - 512) & 31; S2 = 32; }
            int base, S; seq_info(seq, base, S);
            { const int row = tid >> 2, q4 = tid & 3;
              const bf16_t* src = ZC + (size_t)(base + S2 * row + s2) * 256 + g * 64 + 16 * q4;
              const u32x4 v0 = *(const u32x4*)src, v1 = *(const u32x4*)(src + 8);
              bf16_t* trow = (bf16_t*)(lds + row * 320);
#pragma unroll
              for (int k = 0; k < 16; ++k) { const unsigned wd = (k < 8) ? v0[k >> 1] : v1[(k - 8) >> 1]; const bf16_t v = (bf16_t)((k & 1) ? (wd >> 16) : (wd & 0xffffu));
                const int j = 16 * q4 + k;
                if (j <= 32) { trow[j] = v; if (j >= 1 && j <= 31) trow[64 - j] = v; if (j == 0) trow[64] = 0; if (j == 32) trow[96] = 0; }
                else { const int cp = j - 32; trow[64 + cp] = v; trow[128 - cp] = (bf16_t)(v ^ 0x8000u); } } }
            __syncthreads();
            const int kb1 = w & 3, nb = w >> 2;
            f32x16 Ar = zero16(), Ai = zero16();
            const bf16_t* C1 = (const bf16_t*)(tab + T_C128) + (32 * kb1 + r32) * 128 + 8 * h; const bf16_t* S1t = (const bf16_t*)(tab + T_S128) + (32 * kb1 + r32) * 128 + 8 * h;
#pragma unroll
            for (int ks = 0; ks < 8; ++ks) {
              const bf16x8 aC = *(const bf16x8*)(C1 + 16 * ks), aS = *(const bf16x8*)(S1t + 16 * ks);
              const int rowA = 16 * ks + 8 * h;
              const bf16x8 zr = tr_frag(lds, 320, rowA, rowA + 4, nb * 32, lane), zi = tr_frag(lds, 320, rowA, rowA + 4, 64 + nb * 32, lane);
              const bf16x8 zrn = zr ^ (short)0x8000;
              Ar = mfma32(aC, zr, Ar); Ar = mfma32(aS, zi, Ar);
              Ai = mfma32(aC, zi, Ai); Ai = mfma32(aS, zrn, Ai);
            }
            const int twm = 8192 / S;
#pragma unroll
            for (int r = 0; r < 16; ++r) { const int k1 = 32 * kb1 + crow(r, h); const int ai = ((k1 * s2) & (S - 1)) * twm;
              const float cs = ((const float*)(tab + T_TW_C))[ai], sn = ((const float*)(tab + T_TW_S))[ai];
              bf16_t* orow = BF + (size_t)(base + k1 * S2 + s2) * 512 + g * 128;
              const float br = Ar[r] * cs + Ai[r] * sn, bi = Ai[r] * cs - Ar[r] * sn;
              orow[nb * 32 + r32] = (bf16_t)cvtpk(br, 0.f); orow[64 + nb * 32 + r32] = (bf16_t)cvtpk(bi, 0.f); }
            __syncthreads();
          }
          }
        }
      } else if (sub == 2 && PHEN(3)) {
        for (int it = blk; it < 1536 + 1280; it += nblk) {
          if (it < 1536) {
            int seq, kq, g, S2;
            if (it < 1024) { seq = it >> 7; kq = (it >> 2) & 31; g = it & 3; S2 = 64; } else { const int i2 = it - 1024; seq = 8 + (i2 >> 7); kq = (i2 >> 2) & 31; g = i2 & 3; S2 = 32; }
            int base, S; seq_info(seq, base, S);
            const int nch = 4 * S2 * 16;
            for (int c = tid; c < nch; c += 512) { const int sb = c / (S2 * 16), rc = c % (S2 * 16), row = rc >> 4, ch = rc & 15;
              *(u32x4*)(lds + sb * 20480 + row * 320 + ch * 16) = *(const u32x4*)(BF + (size_t)(base + (4 * kq + sb) * S2 + row) * 512 + g * 128 + ch * 8); }
            __syncthreads();
            const bool act = (S2 == 64) || (w < 4);
            if (act) {
              const int sb = (S2 == 64) ? (w >> 1) : w, mb = (S2 == 64) ? (w & 1) : 0;
              const char* tile = lds + sb * 20480;
              const bf16_t* Ct = (const bf16_t*)(tab + (S2 == 64 ? T_C64 : T_C32)) + (32 * mb + r32) * S2 + 8 * h;
              const bf16_t* St = (const bf16_t*)(tab + (S2 == 64 ? T_S64 : T_S32)) + (32 * mb + r32) * S2 + 8 * h;
              f32x16 Y[2]; Y[0] = zero16(); Y[1] = zero16();
              const int nks = S2 >> 4;
#pragma unroll 2
              for (int ks = 0; ks < nks; ++ks) {
                const bf16x8 aC = *(const bf16x8*)(Ct + 16 * ks), aS = *(const bf16x8*)(St + 16 * ks);
                const int rowA = 16 * ks + 8 * h;
#pragma unroll
                for (int nb = 0; nb < 2; ++nb) { const bf16x8 br = tr_frag(tile, 320, rowA, rowA + 4, nb * 32, lane), bi = tr_frag(tile, 320, rowA, rowA + 4, 64 + nb * 32, lane);
                  Y[nb] = mfma32(aC, br, Y[nb]); Y[nb] = mfma32(aS, bi, Y[nb]); }
              }
              const int k1 = 4 * kq + sb;
#pragma unroll
              for (int r = 0; r < 16; ++r) { float ss = Y[0][r] * Y[0][r] + Y[1][r] * Y[1][r];
                ss += __shfl_xor(ss, 1); ss += __shfl_xor(ss, 2); ss += __shfl_xor(ss, 4); ss += __shfl_xor(ss, 8); ss += __shfl_xor(ss, 16);
                const float rr = rsqrtf(ss * (1.0f / 64.0f) + EPS);
                const int tok = base + k1 + 128 * (32 * mb + crow(r, h));
                bf16_t* orow = OB + (size_t)tok * DM + 768 + g * 64;
                orow[r32] = (bf16_t)cvtpk(Y[0][r] * rr, 0.f); orow[32 + r32] = (bf16_t)cvtpk(Y[1][r] * rr, 0.f); }
            }
            __syncthreads();
          } else {
            const int t0 = (it - 1536) * 64;
#pragma unroll 2
            for (int pp = 0; pp < 4; ++pp) { const int idx = pp * 512 + tid; const int tok = t0 + (idx >> 5), head = (idx >> 3) & 3, dch = idx & 7;
              float ls[3]; u32x4 pv[3];
#pragma unroll
              for (int q = 0; q < 3; ++q) { ls[q] = LSE[((size_t)q * MT + tok) * 4 + head]; pv[q] = *(const u32x4*)(PART + ((size_t)q * MT + tok) * 256 + head * 64 + dch * 8); }
              const float mx = fmaxf(ls[0], fmaxf(ls[1], ls[2]));
              float wq[3]; float wsum = 0.f;
#pragma unroll
              for (int q = 0; q < 3; ++q) { wq[q] = fexp2(ls[q] - mx); wsum += wq[q]; }
              const float iw = 1.0f / wsum;
              float o[8];
#pragma unroll
              for (int e = 0; e < 8; ++e) o[e] = 0.f;
#pragma unroll
              for (int q = 0; q < 3; ++q) { const float ww = wq[q] * iw;
#pragma unroll
                for (int e2 = 0; e2 < 4; ++e2) { o[2 * e2] += ww * bflo(pv[q][e2]); o[2 * e2 + 1] += ww * bfhi(pv[q][e2]); } }
              float ss = 0.f;
#pragma unroll
              for (int e = 0; e < 8; ++e) ss += o[e] * o[e];
              ss += __shfl_xor(ss, 1); ss += __shfl_xor(ss, 2); ss += __shfl_xor(ss, 4);
              const float rr = rsqrtf(ss * (1.0f / 64.0f) + EPS);
#pragma unroll
              for (int e = 0; e < 8; ++e) o[e] *= rr;
              *(u32x4*)(OB + (size_t)tok * DM + head * 64 + dch * 8) = pack8(o); }
          }
        }
      } else if ((sub == 3 || sub == 6) && PHEN(4)) {
        const bf16_t* A = (sub == 3) ? OB : ACT; const int K = (sub == 3) ? DM : DFF;
        const bf16_t* Bt = (const bf16_t*)(wl + (sub == 3 ? W_OUT : W_DOWN));
        bf16_t* dst = (sub == 3) ? MIX : FF;
        for (int vr = blk; vr < 256 * 5; vr += nblk) { const int rnd = vr >> 8, vb = vr & 255;
          int mt, nt; if (!tile_map(rnd, vb, 320, 4, 8, 4, mt, nt)) continue;
          const pg8::Gemm g{A, Bt, MT, DM, K};
          const OneUnit S1{(long)mt * 256, nt};
          const EpiPlain E{tid, mt * 256, nt * 256, dst, tab};
          pg8::gemm_phase<EpiPlain, OneUnit, false, true>((PG8_LAS unsigned char*)lds, g, S1, E);
        }
      } else if ((sub == 4 || sub == 7) && PHEN(5)) {
        const bool first = (sub == 4);
        const float* gpost = (first ? p.g_mix_post : p.g_ffn_post) + l * DM;
        const bf16_t* add = first ? MIX : FF;
        const bool need_xn = !(l == 1 && sub == 7);
#pragma unroll 4
      for (int row = blk * 8 + w; row < MT; row += nblk * 8) {
          const bool last = (l == 1 && sub == 7);
          rowpass(lane, XN + (size_t)row * DM, RS[row], nullptr, add + (size_t)row * DM, gpost, last ? p.out + (size_t)row * DM : nullptr, last ? nullptr : XN + (size_t)row * DM, RS + row);
        }
      } else if (sub == 5 && PHEN(6)) {
        const bf16_t* Bt = (const bf16_t*)(wl + W_GU);
        const float* cw = p.conv_w + (size_t)l * 3 * DFF; const float* cb = p.conv_b + (size_t)l * DFF;
        for (int vr = blk; vr < 256 * 41; vr += nblk) { const int rnd = vr >> 8, vb = vr & 255;
          int mt, nt; if (!tile_map(rnd, vb, 323, 32, 4, 8, mt, nt)) continue;
          const int p0 = 254 * mt - 1;
          const pg8::Gemm g{XN, Bt, MT, 2 * DFF, DM};
          const OneUnit S1{(long)p0, nt};
          const EpiP4 E{tid, p0, nt, cw, cb, ACT};
          pg8::gemm_phase<EpiP4, OneUnit, false, true>((PG8_LAS unsigned char*)lds, g, S1, E);
        }
      }
    }
  }
    if (step < p.phi) { if (p.plo < 0) cg::this_grid().sync(); else xcd_barrier(xbar); }
  }
}

extern "C" void kernel_launch(void* const* d_in, const int* in_sizes, int n_in, void* d_out, int out_size, void* d_ws, size_t ws_size, hipStream_t stream) {
  (void)in_sizes; (void)n_in; (void)out_size; (void)ws_size;
  static int grid_blocks = 0;
  if (!grid_blocks) {
    int dev = 0, cus = 0, per_cu = 0;
    hipGetDevice(&dev);
    hipDeviceGetAttribute(&cus, hipDeviceAttributeMultiprocessorCount, dev);
    hipOccupancyMaxActiveBlocksPerMultiprocessor(&per_cu, mega, NTHREADS, 0);
    if (per_cu > 1) per_cu = 1;
    if (per_cu < 1) per_cu = 1;
    grid_blocks = cus * per_cu; if (grid_blocks > 256) grid_blocks = 256;
  }
  Params p{};
  p.x_prompt = (const float*)d_in[0]; p.x_sample = (const float*)d_in[1];
  p.g_mix_pre = (const float*)d_in[2]; p.g_mix_post = (const float*)d_in[3]; p.w_in = (const float*)d_in[4]; p.g_q = (const float*)d_in[5]; p.g_k = (const float*)d_in[6];
  p.g_heads = (const float*)d_in[7]; p.w_out = (const float*)d_in[8]; p.g_ffn_pre = (const float*)d_in[9]; p.g_ffn_post = (const float*)d_in[10];
  p.w_gate = (const float*)d_in[11]; p.w_up = (const float*)d_in[12]; p.conv_w = (const float*)d_in[13]; p.conv_b = (const float*)d_in[14]; p.w_down = (const float*)d_in[15];
  p.out = (float*)d_out; p.ws = (char*)d_ws;
  hipMemsetAsync(d_ws, 0, 65536, stream);
#if MULTI_LAUNCH
  for (int ph = 0; ph <= 16; ++ph) p.seq[ph] = ph;
  for (int ph = 0; ph <= 16; ++ph) { p.plo = ph; p.phi = ph; hipLaunchKernelGGL(mega, dim3(grid_blocks), dim3(NTHREADS), 0, stream, p); }
#else
  int ns = 0;
  for (int ph = 0; ph <= 16; ++ph) { p.seq[ns++] = ph; if (ph >= 1 && ((ph - 1) & 7) == DUPSUB) p.seq[ns++] = ph; if (ph == DUPPH) p.seq[ns++] = ph; }
  p.plo = 0; p.phi = ns - 1;
  void* args[] = {&p};
  hipError_t e = hipLaunchCooperativeKernel((void*)mega, dim3(grid_blocks), dim3(NTHREADS), args, 0, stream);
  if (e != hipSuccess) fprintf(stderr, "cooperative launch failed: %s (grid %d)\n", hipGetErrorString(e), grid_blocks);
#endif
}
```
